# Optimizing an MI355X kernel written in HIP

```python
import jax, jax.numpy as jnp
from jax import lax
import numpy as np

D_MODEL = 2048
BATCH = 4
SEQ = 4096
DEPTH = 4
DEC_BATCH = 8
DEC_SEQ = 32
PAST_LEN = 1024

CHUNK = 64
LEFT_CHUNKS = 8
BAND_LEFT = LEFT_CHUNKS * CHUNK
BAND_KEYS = BAND_LEFT + CHUNK
N_HEADS = 16
HEAD_DIM = D_MODEL // N_HEADS
REL_CLIP = 2 * CHUNK
N_REL = 2 * REL_CLIP + 1
POOL_WINDOWS = (2, 4, 8, 16)
N_POOL_GROUPS = len(POOL_WINDOWS)
POOL_GROUP = D_MODEL // N_POOL_GROUPS
POOL_HIST = max(POOL_WINDOWS) - 1
N_MEM = 256
MEM_HEADS = 4
MEM_HEAD_DIM = D_MODEL // MEM_HEADS
D_FF = -(-8 * D_MODEL // (3 * 256)) * 256
N_ATTN_LAYERS = (DEPTH + 1) // 2
N_POOL_LAYERS = DEPTH // 2
ALPHA = (2.0 * DEPTH) ** 0.25
BETA = (8.0 * DEPTH) ** -0.25
LN_EPS = 1e-5
NEG_BIG = -1e30

kernel_name = 'streaming_band_attn_pool_hybrid_step'


def post_ln(x, g, b):
    xf = x.astype(jnp.float32)
    mu = jnp.mean(xf, axis=-1, keepdims=True)
    xc = xf - mu
    var = jnp.mean(xc * xc, axis=-1, keepdims=True)
    return (xc * lax.rsqrt(var + LN_EPS) * g.astype(jnp.float32) + b.astype(jnp.float32)).astype(x.dtype)


def split_qkv(x, w_qkv):
    B, T, _ = x.shape
    qkv = (x @ w_qkv).reshape(B, T, 3, N_HEADS, HEAD_DIM)
    return qkv[:, :, 0], qkv[:, :, 1], qkv[:, :, 2]


def rel_bias_matrix(table, qpos, kpos):
    idx = jnp.clip(qpos[:, None] - kpos[None, :], -REL_CLIP, REL_CLIP) + REL_CLIP
    return table[:, idx].astype(jnp.float32)


def band_attn_prompt(x, w_qkv, w_o, table):
    B, S, _ = x.shape
    q, k, v = split_qkv(x, w_qkv)
    pad = ((0, 0), (BAND_LEFT, 0), (0, 0), (0, 0))
    kp = jnp.pad(k, pad)
    vp = jnp.pad(v, pad)
    n_chunks = S // CHUNK
    band_idx = jnp.arange(BAND_KEYS)
    bias = rel_bias_matrix(table, jnp.arange(CHUNK), band_idx - BAND_LEFT)
    scale = HEAD_DIM ** -0.5

    def one_chunk(c):
        start = c * CHUNK
        qc = lax.dynamic_slice_in_dim(q, start, CHUNK, axis=1)
        kc = lax.dynamic_slice_in_dim(kp, start, BAND_KEYS, axis=1)
        vc = lax.dynamic_slice_in_dim(vp, start, BAND_KEYS, axis=1)
        valid = (start - BAND_LEFT + band_idx) >= 0
        s = jnp.einsum('bqhd,bkhd->bhqk', qc, kc).astype(jnp.float32) * scale + bias[None]
        s = jnp.where(valid[None, None, None, :], s, NEG_BIG)
        p = jax.nn.softmax(s, axis=-1).astype(vc.dtype)
        return jnp.einsum('bhqk,bkhd->bqhd', p, vc)

    o = lax.map(one_chunk, jnp.arange(n_chunks))
    o = jnp.transpose(o, (1, 0, 2, 3, 4)).reshape(B, S, D_MODEL)
    return o @ w_o, k, v


def band_attn_sample(x, ck, cv, w_qkv, w_o, table):
    B, T, _ = x.shape
    P = ck.shape[1]
    q, k, v = split_qkv(x, w_qkv)
    keys = jnp.concatenate([ck, k], axis=1)
    vals = jnp.concatenate([cv, v], axis=1)
    kpos = jnp.concatenate([jnp.arange(P) - P, jnp.arange(T)])
    bias = rel_bias_matrix(table, jnp.arange(T), kpos)
    s = jnp.einsum('bqhd,bkhd->bhqk', q, keys).astype(jnp.float32) * (HEAD_DIM ** -0.5) + bias[None]
    p = jax.nn.softmax(s, axis=-1).astype(vals.dtype)
    o = jnp.einsum('bhqk,bkhd->bqhd', p, vals).reshape(B, T, D_MODEL)
    return o @ w_o, k, v


def pool_mix(x_ext, n_hist, w_pool, scale):
    B, L, _ = x_ext.shape
    T = L - n_hist
    xf = x_ext.astype(jnp.float32)
    cs = jnp.concatenate([jnp.zeros((B, 1, D_MODEL), jnp.float32), jnp.cumsum(xf, axis=1)], axis=1)
    hi = n_hist + jnp.arange(T) + 1
    outs = []
    for g, w in enumerate(POOL_WINDOWS):
        sl = slice(g * POOL_GROUP, (g + 1) * POOL_GROUP)
        lo = jnp.maximum(hi - w, 0)
        cs_g = cs[:, :, sl]
        cnt = (hi - lo).astype(jnp.float32)
        mean = (cs_g[:, hi] - cs_g[:, lo]) / cnt[None, :, None]
        outs.append(mean - xf[:, n_hist:, sl])
    u = jnp.stack(outs, axis=2).astype(x_ext.dtype)
    y = jnp.einsum('btgc,gcd->btgd', u, w_pool).reshape(B, T, D_MODEL)
    return y * scale


def mem_kv(mem, w_kv):
    B, M, _ = mem.shape
    kv = (mem @ w_kv).reshape(B, M, 2, MEM_HEADS, MEM_HEAD_DIM)
    return kv[:, :, 0], kv[:, :, 1]


def mem_cross_attn(x, mk, mv, w_q, w_o):
    B, T, _ = x.shape
    q = (x @ w_q).reshape(B, T, MEM_HEADS, MEM_HEAD_DIM)
    s = jnp.einsum('bqhd,bkhd->bhqk', q, mk).astype(jnp.float32) * (MEM_HEAD_DIM ** -0.5)
    p = jax.nn.softmax(s, axis=-1).astype(mv.dtype)
    o = jnp.einsum('bhqk,bkhd->bqhd', p, mv).reshape(B, T, D_MODEL)
    return o @ w_o


def swiglu(x, w_in, w_out):
    h = x @ w_in
    gate, up = h[..., :D_FF], h[..., D_FF:]
    return (jax.nn.silu(gate) * up) @ w_out


def setup_inputs(seed: int = 0) -> dict:
    key = jax.random.key(seed)
    ks = jax.random.split(key, 24)
    f32 = jnp.float32

    def nrm(k, shape, s):
        return jax.random.normal(k, shape, f32) * s

    D = D_MODEL
    past_band = min(BAND_LEFT, PAST_LEN)
    w_qk = nrm(ks[8], (N_ATTN_LAYERS, D, 2 * D), D ** -0.5)
    w_v = nrm(ks[9], (N_ATTN_LAYERS, D, D), D ** -0.5 * BETA)
    w_mk = nrm(ks[15], (DEPTH, D, D), D ** -0.5)
    w_mv = nrm(ks[16], (DEPTH, D, D), D ** -0.5 * BETA)
    return {
        'x_prompt': nrm(ks[0], (BATCH, SEQ, D), 1.0),
        'x_sample': nrm(ks[1], (DEC_BATCH, DEC_SEQ, D), 1.0),
        'cache_attn_k': nrm(ks[2], (N_ATTN_LAYERS, DEC_BATCH, past_band, N_HEADS, HEAD_DIM), 1.0),
        'cache_attn_v': nrm(ks[3], (N_ATTN_LAYERS, DEC_BATCH, past_band, N_HEADS, HEAD_DIM), 1.0),
        'state_pool': nrm(ks[4], (N_POOL_LAYERS, DEC_BATCH, POOL_HIST, D), 1.0),
        'cache_mem_k': nrm(ks[5], (DEPTH, DEC_BATCH, N_MEM, MEM_HEADS, MEM_HEAD_DIM), 1.0),
        'cache_mem_v': nrm(ks[6], (DEPTH, DEC_BATCH, N_MEM, MEM_HEADS, MEM_HEAD_DIM), 1.0),
        'mem_prompt': nrm(ks[7], (BATCH, N_MEM, D), 1.0),
        'w_qkv': jnp.concatenate([w_qk, w_v], axis=-1),
        'w_attn_o': nrm(ks[10], (N_ATTN_LAYERS, D, D), D ** -0.5 * BETA),
        'rel_bias': nrm(ks[11], (N_ATTN_LAYERS, N_HEADS, N_REL), 0.5),
        'w_pool': nrm(ks[12], (N_POOL_LAYERS, N_POOL_GROUPS, POOL_GROUP, POOL_GROUP), POOL_GROUP ** -0.5 * BETA),
        'pool_scale': 1.0 + nrm(ks[13], (N_POOL_LAYERS, D), 0.02),
        'w_mem_q': nrm(ks[14], (DEPTH, D, D), D ** -0.5),
        'w_mem_kv': jnp.concatenate([w_mk, w_mv], axis=-1),
        'w_mem_o': nrm(ks[17], (DEPTH, D, D), D ** -0.5 * BETA),
        'w_ffn_in': nrm(ks[18], (DEPTH, D, 2 * D_FF), D ** -0.5 * BETA),
        'w_ffn_out': nrm(ks[19], (DEPTH, D_FF, D), D_FF ** -0.5 * BETA),
        'ln_g': 1.0 + nrm(ks[20], (DEPTH, 3, D), 0.02),
        'ln_b': nrm(ks[21], (DEPTH, 3, D), 0.02),
    }


def reference(x_prompt, x_sample, cache_attn_k, cache_attn_v, state_pool, cache_mem_k, cache_mem_v,
              mem_prompt, w_qkv, w_attn_o, rel_bias, w_pool, pool_scale, w_mem_q, w_mem_kv, w_mem_o,
              w_ffn_in, w_ffn_out, ln_g, ln_b):
    S = x_prompt.shape[1]
    keep_prompt = min(BAND_LEFT, S)
    yp, ys = x_prompt, x_sample
    ak_p, av_p, pool_p, mk_p, mv_p = [], [], [], [], []
    ak_s, av_s, pool_s = [], [], []
    for i in range(DEPTH):
        if i % 2 == 0:
            a = i // 2
            mp, kp_, vp_ = band_attn_prompt(yp, w_qkv[a], w_attn_o[a], rel_bias[a])
            ms, ks_, vs_ = band_attn_sample(ys, cache_attn_k[a], cache_attn_v[a], w_qkv[a], w_attn_o[a], rel_bias[a])
            ak_p.append(kp_[:, S - keep_prompt:])
            av_p.append(vp_[:, S - keep_prompt:])
            ak_s.append(ks_)
            av_s.append(vs_)
        else:
            p = i // 2
            mp = pool_mix(yp, 0, w_pool[p], pool_scale[p])
            ext = jnp.concatenate([state_pool[p], ys], axis=1)
            ms = pool_mix(ext, POOL_HIST, w_pool[p], pool_scale[p])
            pool_p.append(yp[:, S - POOL_HIST:])
            pool_s.append(ext[:, ext.shape[1] - POOL_HIST:])
        yp = post_ln(ALPHA * yp + mp, ln_g[i, 0], ln_b[i, 0])
        ys = post_ln(ALPHA * ys + ms, ln_g[i, 0], ln_b[i, 0])
        mk, mv = mem_kv(mem_prompt, w_mem_kv[i])
        mk_p.append(mk)
        mv_p.append(mv)
        yp = post_ln(ALPHA * yp + mem_cross_attn(yp, mk, mv, w_mem_q[i], w_mem_o[i]), ln_g[i, 1], ln_b[i, 1])
        ys = post_ln(ALPHA * ys + mem_cross_attn(ys, cache_mem_k[i], cache_mem_v[i], w_mem_q[i], w_mem_o[i]), ln_g[i, 1], ln_b[i, 1])
        yp = post_ln(ALPHA * yp + swiglu(yp, w_ffn_in[i], w_ffn_out[i]), ln_g[i, 2], ln_b[i, 2])
        ys = post_ln(ALPHA * ys + swiglu(ys, w_ffn_in[i], w_ffn_out[i]), ln_g[i, 2], ln_b[i, 2])
    new_attn_k_prompt = jnp.stack(ak_p)
    new_attn_v_prompt = jnp.stack(av_p)
    new_pool_prompt = jnp.stack(pool_p)
    new_mem_k_prompt = jnp.stack(mk_p)
    new_mem_v_prompt = jnp.stack(mv_p)
    new_attn_k_sample = jnp.stack(ak_s)
    new_attn_v_sample = jnp.stack(av_s)
    new_pool_sample = jnp.stack(pool_s)
    return (yp, ys, new_attn_k_prompt, new_attn_v_prompt, new_pool_prompt, new_mem_k_prompt,
            new_mem_v_prompt, new_attn_k_sample, new_attn_v_sample, new_pool_sample)
```

```cpp
#include <hip/hip_runtime.h>
#include <cstdio>
#include <cstdint>

#define LAS __attribute__((address_space(3)))
#define GAS __attribute__((address_space(1)))
typedef unsigned short bf16_t;
typedef short bf16x8 __attribute__((ext_vector_type(8)));
typedef short s16x4 __attribute__((ext_vector_type(4)));
typedef float f32x4 __attribute__((ext_vector_type(4)));
typedef float f32x2 __attribute__((ext_vector_type(2)));
typedef float f32x16 __attribute__((ext_vector_type(16)));
typedef unsigned u32x4 __attribute__((ext_vector_type(4)));
typedef unsigned u32x2 __attribute__((ext_vector_type(2)));
typedef int i32x8 __attribute__((ext_vector_type(8)));
typedef int i32x4 __attribute__((ext_vector_type(4)));

constexpr int D = 2048, NB = 4, SEQ = 4096, DEPTH = 4, SBAT = 8, ST = 32, DFF = 5632;
constexpr int MP = NB * SEQ, MS = SBAT * ST, M = MP + MS, MPAD = M + 256;
constexpr int NHEAD = 16, HD = 128, NREL = 257, NMEM = 256, MHD = 512;
constexpr int KVROWS = 576;
constexpr float ALPHA = 1.6817928305074290f;
constexpr float LN_EPS = 1e-5f;
constexpr float LOG2E = 1.4426950408889634f;
constexpr int NWAVES = 8, NTHR = 512;
#ifndef ONLY
#define ONLY -1
#endif
#define PH(k) (ONLY < 0 || ONLY == (k))
#ifndef PROBE_ID
#define PROBE_ID 0
#endif
#define NREP(k) ((PROBE_ID == (k) || (PROBE_ID == 130 && ((k) == 108 || (k) == 110)) || (PROBE_ID == 131 && ((k) == 101 || (k) == 114))) ? 2 : 1)

constexpr size_t O_YP = 0, O_YS = O_YP + (size_t)MP * D, O_AKP = O_YS + (size_t)MS * D, O_AVP = O_AKP + (size_t)2 * NB * 512 * D,
                 O_PP = O_AVP + (size_t)2 * NB * 512 * D, O_MKP = O_PP + (size_t)2 * NB * 15 * D, O_MVP = O_MKP + (size_t)DEPTH * NB * NMEM * D,
                 O_AKS = O_MVP + (size_t)DEPTH * NB * NMEM * D, O_AVS = O_AKS + (size_t)2 * MS * D, O_PS = O_AVS + (size_t)2 * MS * D,
                 O_END = O_PS + (size_t)2 * SBAT * 15 * D;

constexpr size_t al256(size_t x) { return (x + 255) & ~(size_t)255; }
constexpr size_t WS_CTL = 0, CTL_BYTES = 2u << 20;
constexpr size_t WS_WQKV = WS_CTL + CTL_BYTES;
constexpr size_t WS_WQKV8 = WS_WQKV + (size_t)2 * 6144 * D * 2;
constexpr size_t WS_WAO  = WS_WQKV8 + (size_t)2 * 6144 * D;
constexpr size_t WS_WPOOL= WS_WAO + (size_t)2 * D * D;
constexpr size_t WS_WMQ  = WS_WPOOL + (size_t)2 * D * 512 * 2;
constexpr size_t WS_WMKV = WS_WMQ + (size_t)4 * D * D;
constexpr size_t WS_WMO  = WS_WMKV + (size_t)4 * 4096 * D * 2;
constexpr size_t WS_WFI  = WS_WMO + (size_t)4 * D * D;
constexpr size_t WS_WFO  = WS_WFI + (size_t)4 * 2 * DFF * D;
constexpr size_t WS_Z8   = WS_WFO + (size_t)4 * D * DFF;
constexpr size_t WS_ZF   = WS_Z8 + (size_t)MPAD * D;
constexpr size_t WS_ZB   = WS_ZF + (size_t)M * D * 2;
constexpr size_t WS_BIG  = WS_ZB + (size_t)MPAD * D * 2;
constexpr size_t BIG_BYTES = (size_t)MPAD * 6144 * 2;
constexpr size_t WS_QM   = WS_BIG;
constexpr size_t WS_S    = WS_QM + (size_t)MPAD * D * 2;
constexpr size_t WS_P    = WS_S + (size_t)MP * 1024 * 4;
constexpr size_t WS_H    = WS_BIG;
static_assert(WS_P + (size_t)MP * 1024 * 2 <= WS_BIG + BIG_BYTES && (size_t)M * DFF * 2 <= BIG_BYTES, "overlays");
constexpr size_t WS_OB   = WS_BIG + BIG_BYTES;
constexpr size_t WS_KVS  = WS_OB + (size_t)MPAD * D * 2;
constexpr size_t WS_MKS  = WS_KVS + (size_t)2 * 2 * SBAT * KVROWS * D * 2;
constexpr size_t WS_MVTS = WS_MKS + (size_t)4 * SBAT * NMEM * D * 2;
constexpr size_t WS_MEMB = WS_MVTS + (size_t)4 * SBAT * NMEM * D * 2;
constexpr size_t WS_MKP  = WS_MEMB + (size_t)NB * NMEM * D * 2;
constexpr size_t WS_MK8 = WS_MKP, WS_MV8 = WS_MKP + (size_t)4 * NB * NMEM * D;
constexpr size_t WS_MVTP = WS_MKP + (size_t)4 * NB * NMEM * D * 2;
constexpr size_t WS_WQR8 = WS_MVTP;
constexpr size_t WS_ST   = WS_MVTP + (size_t)4 * NB * NMEM * D * 2;
constexpr size_t ST_BYTES = (size_t)M * 16 * 4;
constexpr size_t WS_SST  = WS_ST + 2 * ST_BYTES;
constexpr size_t SST_BYTES = (size_t)MS * 64 * 4;
constexpr size_t WS_W1   = WS_SST + 2 * SST_BYTES;
constexpr size_t WS_W2   = WS_W1 + (size_t)4 * NB * 1024 * D;
constexpr size_t WS_END  = WS_W2 + (size_t)4 * NB * D * 1024;
constexpr size_t WS_DUMMY = WS_END;
constexpr size_t WS_END_PROBE = WS_DUMMY + (size_t)M * D * 4 + (size_t)MPAD * D * 2 + ST_BYTES + SST_BYTES;
constexpr int CW_BAR = 1024;
constexpr int CW_VEC = 8192;
constexpr int V_QKV_U = CW_VEC, V_QKV_C = V_QKV_U + 6144;
constexpr int V_MQ_U = V_QKV_C + 6144, V_MQ_C = V_MQ_U + 4 * D;
constexpr int V_FI_U = V_MQ_C + 4 * D, V_FI_C = V_FI_U + 4 * 2 * DFF, V_QKV8_U = V_FI_C + 4 * 2 * DFF, V_S1_U = V_QKV8_U + 6144, V_S1_C = V_S1_U + 4 * NB * 1024, V_END = V_S1_C + 4 * NB * 1024;
static_assert((size_t)V_END * 4 <= CTL_BYTES, "CTL");

constexpr int RING_BYTES = 131072, MISC_OFF = 135168  , RED_OFF = MISC_OFF + 1024, LDS_BYTES = 147456;
static_assert(8 * 16640 <= MISC_OFF && RED_OFF + 8192 <= LDS_BYTES, "LDS map");

__device__ __forceinline__ unsigned cvt_pk_bf16(float lo, float hi) { unsigned r; asm volatile("v_cvt_pk_bf16_f32 %0, %1, %2" : "=v"(r) : "v"(lo), "v"(hi)); return r; }
__device__ __forceinline__ u32x4 pack8(const float (&v)[8]) { u32x4 w; w.x = cvt_pk_bf16(v[0], v[1]); w.y = cvt_pk_bf16(v[2], v[3]); w.z = cvt_pk_bf16(v[4], v[5]); w.w = cvt_pk_bf16(v[6], v[7]); return w; }
__device__ __forceinline__ unsigned f2bf(float f) { unsigned u = __builtin_bit_cast(unsigned, f); return (u + 0x7fffu + ((u >> 16) & 1u)) >> 16; }
__device__ __forceinline__ float bf2f(unsigned b) { return __builtin_bit_cast(float, b << 16); }
__device__ __forceinline__ unsigned pk2(float lo, float hi) { return f2bf(lo) | (f2bf(hi) << 16); }
__device__ __forceinline__ int lane_id() { int l; asm volatile("v_mbcnt_lo_u32_b32 %0, -1, 0\n\tv_mbcnt_hi_u32_b32 %0, -1, %0" : "=v"(l)); return l; }
__device__ __forceinline__ float shx(float v, int mask) { const int l = lane_id(); return __builtin_bit_cast(float, __builtin_amdgcn_ds_bpermute((l ^ mask) << 2, __builtin_bit_cast(int, v))); }
__device__ __forceinline__ int shx(int v, int mask) { const int l = lane_id(); return __builtin_amdgcn_ds_bpermute((l ^ mask) << 2, v); }
__device__ __forceinline__ float shl(float v, int src) { return __builtin_bit_cast(float, __builtin_amdgcn_ds_bpermute(src << 2, __builtin_bit_cast(int, v))); }
__device__ __forceinline__ float wave_sum(float v) {
#pragma unroll
    for (int o = 1; o < 64; o <<= 1) v += shx(v, o);
    return v;
}
__device__ __forceinline__ float wave_max(float v) {
#pragma unroll
    for (int o = 1; o < 64; o <<= 1) v = fmaxf(v, shx(v, o));
    return v;
}
typedef _Float16 h16x2 __attribute__((ext_vector_type(2)));
typedef _Float16 h16x8 __attribute__((ext_vector_type(8)));
typedef unsigned short half_t;
__device__ __forceinline__ unsigned pk2h(float a, float b) { const h16x2 v = {(_Float16)a, (_Float16)b}; return __builtin_bit_cast(unsigned, v); }
__device__ __forceinline__ u32x4 pack8h(const float (&v)[8]) { u32x4 w; w.x = pk2h(v[0], v[1]); w.y = pk2h(v[2], v[3]); w.z = pk2h(v[4], v[5]); w.w = pk2h(v[6], v[7]); return w; }
__device__ __forceinline__ void unpack8h(u32x4 w, float (&v)[8]) { const h16x8 h = __builtin_bit_cast(h16x8, w);
#pragma unroll
    for (int i = 0; i < 8; ++i) v[i] = (float)h[i]; }
__device__ __forceinline__ f32x4 unpack4h(u32x2 w) { typedef _Float16 h16x4 __attribute__((ext_vector_type(4))); const h16x4 h = __builtin_bit_cast(h16x4, w); return (f32x4){(float)h[0], (float)h[1], (float)h[2], (float)h[3]}; }
constexpr float W8_SCALE = 1024.f, W8_INV = 1.f / 1024.f;
constexpr float H8_SCALE = 32.f, H8_INV = 1.f / 32.f;
constexpr float QSCALE = 0.08838834764831845f * 1.4426950408889634f;
constexpr float O8_SCALE = 64.f, O8_INV = 1.f / 64.f;
constexpr float WQR_SCALE = 64.f, MV8_SCALE = 8.f, W1_SCALE = 16.f, W2_SCALE = 64.f, P8_SCALE = 256.f;
__device__ __forceinline__ unsigned pk4_fp8(float a, float b, float c, float d) { int w = 0; w = __builtin_amdgcn_cvt_pk_fp8_f32(a, b, w, false); w = __builtin_amdgcn_cvt_pk_fp8_f32(c, d, w, true); return (unsigned)w; }
__device__ __forceinline__ u32x2 pack8_fp8(const float (&v)[8]) { u32x2 w; w.x = pk4_fp8(v[0], v[1], v[2], v[3]); w.y = pk4_fp8(v[4], v[5], v[6], v[7]); return w; }
__device__ __forceinline__ u32x4 widen8(u32x2 p0, u32x2 p1) {
    const auto x = __builtin_amdgcn_permlane16_swap(p0.x, p1.x, false, false); const auto y = __builtin_amdgcn_permlane16_swap(p0.y, p1.y, false, false);
    return (u32x4){x[0], y[0], x[1], y[1]};
}
__device__ __forceinline__ float sum4_fp8(unsigned w) { return (__builtin_amdgcn_cvt_f32_fp8((int)w, 0) + __builtin_amdgcn_cvt_f32_fp8((int)w, 1)) + (__builtin_amdgcn_cvt_f32_fp8((int)w, 2) + __builtin_amdgcn_cvt_f32_fp8((int)w, 3)); }
#define LDS_WAIT() asm volatile("s_waitcnt lgkmcnt(0)" ::: "memory")
#define VM_WAIT() asm volatile("s_waitcnt vmcnt(0)" ::: "memory")

#define XB_TMO      128
#define XB_XCNT(j)  (256  + 64 * (j))
#define XB_XSUB(j)  (1280 + 64 * (j))
#define XB_XGEN(j)  (2304 + 64 * (j))
#define XB_TOP      3328
#define XB_TOPGEN   3392
#define XCD_BAR_WORDS 3456
#define XB_SPIN_CAP (1u << 18)
static_assert(CW_BAR + XCD_BAR_WORDS <= CW_VEC, "CTL map");
__device__ __forceinline__ unsigned xb_ld(unsigned* p)              { return __hip_atomic_load(p, __ATOMIC_RELAXED, __HIP_MEMORY_SCOPE_AGENT); }
__device__ __forceinline__ unsigned xb_add(unsigned* p, unsigned v) { return __hip_atomic_fetch_add(p, v, __ATOMIC_RELAXED, __HIP_MEMORY_SCOPE_AGENT); }
__device__ __forceinline__ unsigned xb_xcc_id() { return (unsigned)__builtin_amdgcn_s_getreg((3 << 11) | 20) & 0xFu; }
#define XB_SPIN(cond, bar) do { unsigned _sp = 0; while (cond) { __builtin_amdgcn_s_sleep(1); \
    if ((++_sp & 255u) == 0u) { if (xb_ld(&(bar)[XB_TMO])) break; if (_sp > XB_SPIN_CAP) { atomicAdd(&(bar)[XB_TMO], 1u); break; } } } } while (0)
struct XcdBarrier { unsigned* bar; unsigned x; volatile LAS unsigned* st; };
__device__ __forceinline__ XcdBarrier xcd_barrier_post(unsigned* bar, volatile LAS unsigned* st) {
    XcdBarrier b; b.bar = bar; b.x = xb_xcc_id(); b.st = st;
    if (threadIdx.x == 0) (void)xb_add(&bar[XB_XCNT(b.x)], 1u);
    return b;
}
__device__ __forceinline__ void xcd_barrier_complete(unsigned* bar, unsigned x, unsigned& nloc, unsigned& nx) {
    const unsigned G = gridDim.x * gridDim.y * gridDim.z;
    unsigned sum, cnt, mine, sp = 0u;
    for (;;) {
        sum = 0u; cnt = 0u; mine = 0u;
#pragma unroll
        for (unsigned j = 0; j < 16; ++j) { const unsigned c = xb_ld(&bar[XB_XCNT(j)]); sum += c; cnt += (c > 0u) ? 1u : 0u; mine = (j == x) ? c : mine; }
        if (sum == G) break;
        __builtin_amdgcn_s_sleep(1);
        if ((++sp & 255u) == 0u) { if (xb_ld(&bar[XB_TMO])) break; if (sp > XB_SPIN_CAP) { atomicAdd(&bar[XB_TMO], 1u); break; } }
    }
    nloc = mine > 0u ? mine : 1u; nx = cnt > 0u ? cnt : 1u;
}
__device__ __forceinline__ void xcd_barrier(const XcdBarrier& b, const int wv) {
    asm volatile("s_waitcnt vmcnt(0)" ::: "memory");
    __syncthreads();
    if (wv == 0 && lane_id() == 0) {
        unsigned* bar = b.bar; unsigned bx_ = b.x;
        asm volatile("" : "+s"(bar), "+s"(bx_));
        __builtin_amdgcn_s_waitcnt(0);
        unsigned nloc = b.st[0], nx = b.st[1];
        if (nloc == 0u) { xcd_barrier_complete(bar, bx_, nloc, nx); b.st[0] = nloc; b.st[1] = nx; }
        const unsigned old = xb_add(&bar[XB_XSUB(bx_)], 1u);
        const unsigned gen = old / nloc;
        if (old + 1u == (gen + 1u) * nloc) {
            __builtin_amdgcn_fence(__ATOMIC_RELEASE, "agent");
            asm volatile("s_waitcnt vmcnt(0)" ::: "memory");
            const unsigned og = xb_add(&bar[XB_TOP], 1u);
            const unsigned tg = og / nx;
            if (og + 1u == (tg + 1u) * nx) xb_add(&bar[XB_TOPGEN], 1u);
            else XB_SPIN(xb_ld(&bar[XB_TOPGEN]) == tg, bar);
            __builtin_amdgcn_fence(__ATOMIC_ACQUIRE, "agent");
            xb_add(&bar[XB_XGEN(bx_)], 1u);
            asm volatile("s_waitcnt vmcnt(0)" ::: "memory");
        } else {
            XB_SPIN(xb_ld(&bar[XB_XGEN(bx_)]) == gen, bar);
            __builtin_amdgcn_fence(__ATOMIC_ACQUIRE, "agent");
            asm volatile("s_waitcnt vmcnt(0)" ::: "memory");
        }
    }
    __syncthreads();
}

__device__ __forceinline__ void xcd_barrier_arrive(const XcdBarrier& b, const int wv) {
    asm volatile("s_waitcnt vmcnt(0)" ::: "memory");
    __syncthreads();
    if (wv == 0 && lane_id() == 0) {
        unsigned* bar = b.bar; unsigned bx_ = b.x;
        asm volatile("" : "+s"(bar), "+s"(bx_));
        __builtin_amdgcn_s_waitcnt(0);
        unsigned nloc = b.st[0], nx = b.st[1];
        if (nloc == 0u) { xcd_barrier_complete(bar, bx_, nloc, nx); b.st[0] = nloc; b.st[1] = nx; }
        const unsigned old = xb_add(&bar[XB_XSUB(bx_)], 1u);
        const unsigned gen = old / nloc;
        unsigned role = 0u, tg = 0u;
        if (old + 1u == (gen + 1u) * nloc) {
            __builtin_amdgcn_fence(__ATOMIC_RELEASE, "agent");
            asm volatile("s_waitcnt vmcnt(0)" ::: "memory");
            const unsigned og = xb_add(&bar[XB_TOP], 1u);
            tg = og / nx;
            if (og + 1u == (tg + 1u) * nx) { xb_add(&bar[XB_TOPGEN], 1u); role = 2u; } else role = 1u;
        }
        b.st[4] = gen; b.st[5] = role; b.st[6] = tg;
    }
}
__device__ __forceinline__ void xcd_barrier_wait(const XcdBarrier& b, const int wv) {
    if (wv == 0 && lane_id() == 0) {
        unsigned* bar = b.bar; unsigned bx_ = b.x;
        asm volatile("" : "+s"(bar), "+s"(bx_));
        const unsigned gen = b.st[4], role = b.st[5], tg = b.st[6];
        if (role) {
            if (role == 1u) XB_SPIN(xb_ld(&bar[XB_TOPGEN]) == tg, bar);
            __builtin_amdgcn_fence(__ATOMIC_ACQUIRE, "agent");
            xb_add(&bar[XB_XGEN(bx_)], 1u);
            asm volatile("s_waitcnt vmcnt(0)" ::: "memory");
        } else {
            XB_SPIN(xb_ld(&bar[XB_XGEN(bx_)]) == gen, bar);
            __builtin_amdgcn_fence(__ATOMIC_ACQUIRE, "agent");
            asm volatile("s_waitcnt vmcnt(0)" ::: "memory");
        }
    }
    __syncthreads();
}

namespace pg8 {
constexpr int BM = 256, BK = 64, HALF = 128, HTB = HALF * BK * 2, STAGE_BYTES = 8 * HTB, NXCD = 8, WGM = 8;
__host__ __device__ __forceinline__ int lds_byte(int r, int c) { const int st = (r >> 4) * 2 + (c >> 5), rr = r & 15, cc = c & 31, ob = rr * 64 + cc * 2; return st * 1024 + (ob ^ (((ob >> 9) & 1) << 5)); }
__host__ __device__ __forceinline__ void stage_rc(int b, int& R, int& C) { const int st = b / 1024, sb = b % 1024, swz = sb ^ (((sb >> 9) & 1) << 5); R = (st >> 1) * 16 + swz / 64; C = (st & 1) * 32 + (swz % 64) / 2; }
__host__ __device__ __forceinline__ int perm32(int rho) { const int n = rho >> 4, i = rho & 15; return 8 * (i >> 2) + 4 * n + (i & 3); }

struct Unit { int pm, pn; const char* A; const char* B; };

__device__ __forceinline__ void tile_of(int L, int nM, int nN, int& pm, int& pn) {
    const int nwg = nM * nN; int wgid = L;
    { const int q = nwg / NXCD, r = nwg % NXCD, xcd = wgid % NXCD, off = wgid / NXCD; wgid = (xcd < r ? xcd * (q + 1) : r * (q + 1) + (xcd - r) * q) + off; }
    const int nig = WGM * nN, gid = wgid / nig, fm = gid * WGM, gsz = (nM - fm) < WGM ? (nM - fm) : WGM;
    pm = fm + ((wgid % nig) % gsz); pn = (wgid % nig) / gsz;
}

template <class T, class = void> struct HasPre { static constexpr bool value = false; };
template <class T> struct HasPre<T, decltype((void)T::kPre)> { static constexpr bool value = true; };
template <bool FP8 = false, class Epi, class Sched>
__device__ __forceinline__ void gemm_phase(LAS unsigned char* lds, const int wv, const int K, const int lda, const int ldb, const Sched& S, const Epi& E) {
    int tid = wv * 64 + lane_id(); asm volatile("" : "+v"(tid));
    const int wid = __builtin_amdgcn_readfirstlane(tid >> 6), lane = tid & 63, wr = wid >> 2, wc = wid & 3, fr = lane & 15, fq = lane >> 4;
    const int nt = K / BK;
    unsigned voffA, voffB;
    { int R, C; stage_rc(tid * 16, R, C); const int Rb = 64 * (R >> 5) + 8 * ((R >> 2) & 3) + 4 * ((R >> 4) & 1) + (R & 3); voffA = (unsigned)(R * lda + C) * 2u; voffB = (unsigned)(Rb * ldb + C) * 2u; }
    const size_t qstepA = (size_t)64 * lda * 2, qstepB = (size_t)128 * ldb * 2;
    const size_t kstep = (size_t)(BK * 2);
    const size_t hstepA = (size_t)HALF * lda * 2, hstepB = (size_t)32 * ldb * 2;
    const unsigned ldsw = (unsigned)wid * 1024u;
    const unsigned ldsbase = (unsigned)(uintptr_t)lds + ldsw;
    const int aoff = lds_byte(wr * 64 + fr, fq * 8), boff = lds_byte(wc * 32 + fr, fq * 8);
#define PG8_SA(b, h) (((b) * 2 + (h)) * HTB)
#define PG8_SB(b, h) ((4 + (b) * 2 + (h)) * HTB)
#define PG8_STAGE_(bufoff, gbase, voff, qstep) do { _Pragma("unroll") for (int _i = 0; _i < 2; ++_i) { \
        asm volatile("s_mov_b32 m0, %2\n\ts_nop 0\n\tglobal_load_lds_dwordx4 %0, %1" \
            :: "v"(voff), "s"((const char*)(gbase) + (_i ? (qstep) : (size_t)0)), "s"(ldsbase + (unsigned)((bufoff) + _i * 8192)) : "memory", "m0"); } } while (0)
#define PG8_STAGE(bufoff, gbase, voff) PG8_STAGE_(bufoff, gbase, voff, voff##_q)
#define voffA_q qstepA
#define voffB_q qstepB
#define PG8_LDA(dst, b, h) do { _Pragma("unroll") for (int m = 0; m < 4; ++m) _Pragma("unroll") for (int k = 0; k < 2; ++k) dst[m][k] = *(const LAS bf16x8*)(lds + PG8_SA(b, h) + aoff + m * 2048 + k * 1024); } while (0)
#define PG8_LDB(dst, b, h) do { _Pragma("unroll") for (int n = 0; n < 2; ++n) _Pragma("unroll") for (int k = 0; k < 2; ++k) dst[n][k] = *(const LAS bf16x8*)(lds + PG8_SB(b, h) + boff + n * 2048 + k * 1024); } while (0)
#define PG8_CAT8(x0, x1) __builtin_shufflevector(__builtin_bit_cast(i32x4, x0), __builtin_bit_cast(i32x4, x1), 0, 1, 2, 3, 4, 5, 6, 7)
#define PG8_MMA(ai, bj, At, Bt) do { __builtin_amdgcn_s_setprio(1); _Pragma("unroll") for (int m = 0; m < 4; ++m) _Pragma("unroll") for (int n = 0; n < 2; ++n) { \
        if constexpr (FP8) acc[ai][bj][m][n] = __builtin_amdgcn_mfma_scale_f32_16x16x128_f8f6f4(PG8_CAT8(Bt[n][0], Bt[n][1]), PG8_CAT8(At[m][0], At[m][1]), acc[ai][bj][m][n], 0, 0, 0, 0x7f7f7f7f, 0, 0x7f7f7f7f); \
        else { _Pragma("unroll") for (int k = 0; k < 2; ++k) acc[ai][bj][m][n] = __builtin_amdgcn_mfma_f32_16x16x32_bf16(Bt[n][k], At[m][k], acc[ai][bj][m][n], 0, 0, 0); } } \
        __builtin_amdgcn_s_setprio(0); } while (0)
#define PG8_WAIT_V(n) asm volatile("s_waitcnt vmcnt(" #n ")" ::: "memory")
#define PG8_WAIT_L(n) asm volatile("s_waitcnt lgkmcnt(" #n ")" ::: "memory")
#define PG8_BAR __builtin_amdgcn_s_barrier()
#define PG8_SCHED __builtin_amdgcn_sched_barrier(0)
    Unit cur, nxt; int ui = 0;
    if (!S.next(0, cur)) return;
    if constexpr (HasPre<Epi>::value) E.prefetch(cur, wid, lane);
    f32x4 acc[2][2][4][2];
#pragma unroll
    for (int a = 0; a < 2; ++a)
#pragma unroll
        for (int b = 0; b < 2; ++b)
#pragma unroll
            for (int m = 0; m < 4; ++m)
#pragma unroll
                for (int n = 0; n < 2; ++n) acc[a][b][m][n] = (f32x4){0.f, 0.f, 0.f, 0.f};
    bf16x8 At[4][2], B0[2][2], B1[2][2];
    const char* cA = cur.A; const char* cB = cur.B;
    PG8_STAGE(PG8_SB(0, 0), cB, voffB); PG8_STAGE(PG8_SB(0, 1), cB + hstepB, voffB); PG8_STAGE(PG8_SA(0, 0), cA, voffA); PG8_STAGE(PG8_SA(0, 1), cA + hstepA, voffA);
    if (wr == 1) PG8_BAR;
    PG8_WAIT_V(2); PG8_BAR;
    PG8_STAGE(PG8_SB(1, 0), cB + kstep, voffB); PG8_STAGE(PG8_SA(1, 0), cA + kstep, voffA); PG8_STAGE(PG8_SB(1, 1), cB + hstepB + kstep, voffB);
    PG8_WAIT_V(6); PG8_BAR;
    for (;;) {
        const bool has_next = S.next(ui + 1, nxt);
        const char* nA = has_next ? nxt.A : cA; const char* nB = has_next ? nxt.B : cB;
#pragma unroll 1
        for (int t = 0; t < nt; t += 2) {
            const bool last = (t == nt - 2);
            const char* a1 = cA + (size_t)(t + 1) * kstep;
            const char* a2 = last ? nA : cA + (size_t)(t + 2) * kstep; const char* b2 = last ? nB : cB + (size_t)(t + 2) * kstep;
            const char* a3 = a2 + kstep; const char* b3 = b2 + kstep;
            PG8_LDB(B0, 0, 0); PG8_LDB(B1, 0, 1); PG8_SCHED; PG8_LDA(At, 0, 0); PG8_STAGE(PG8_SA(1, 1), a1 + hstepA, voffA);
            PG8_WAIT_V(8); PG8_WAIT_L(0); PG8_BAR; PG8_MMA(0, 0, At, B0); PG8_MMA(0, 1, At, B1); PG8_BAR; PG8_SCHED;
            PG8_LDA(At, 0, 1); PG8_STAGE(PG8_SB(0, 0), b2, voffB); PG8_STAGE(PG8_SB(0, 1), b2 + hstepB, voffB); PG8_STAGE(PG8_SA(0, 0), a2, voffA);
            PG8_WAIT_V(8); PG8_WAIT_L(0); PG8_BAR; PG8_MMA(1, 0, At, B0); PG8_MMA(1, 1, At, B1); PG8_BAR; PG8_SCHED;
            PG8_LDB(B0, 1, 0); PG8_LDB(B1, 1, 1); PG8_SCHED; PG8_LDA(At, 1, 0); PG8_STAGE(PG8_SA(0, 1), a2 + hstepA, voffA);
            PG8_WAIT_V(8); PG8_WAIT_L(0); PG8_BAR; PG8_MMA(0, 0, At, B0); PG8_MMA(0, 1, At, B1); PG8_BAR; PG8_SCHED;
            PG8_LDA(At, 1, 1); PG8_STAGE(PG8_SB(1, 0), b3, voffB); PG8_STAGE(PG8_SB(1, 1), b3 + hstepB, voffB); PG8_STAGE(PG8_SA(1, 0), a3, voffA);
            PG8_WAIT_V(8); PG8_WAIT_L(0); PG8_BAR; PG8_MMA(1, 0, At, B0); PG8_MMA(1, 1, At, B1); PG8_BAR; PG8_SCHED;
        }
        if (wr == 0) PG8_BAR;
        E(acc, cur, wr, wc, fr, fq, lane);
        if constexpr (HasPre<Epi>::value) { if (has_next) E.prefetch(nxt, wid, lane); }
        if (!has_next) break;
#pragma unroll
        for (int a = 0; a < 2; ++a)
#pragma unroll
            for (int b = 0; b < 2; ++b)
#pragma unroll
                for (int m = 0; m < 4; ++m)
#pragma unroll
                    for (int n = 0; n < 2; ++n) acc[a][b][m][n] = (f32x4){0.f, 0.f, 0.f, 0.f};
        cur = nxt; cA = nA; cB = nB; ++ui;
        if (wr == 1) PG8_BAR;
    }
    PG8_WAIT_V(0);
    PG8_BAR;
#undef PG8_SA
#undef PG8_SB
#undef PG8_STAGE
#undef PG8_STAGE_
#undef voffA_q
#undef voffB_q
#undef PG8_LDA
#undef PG8_LDB
#undef PG8_MMA
#undef PG8_CAT8
#undef PG8_WAIT_V
#undef PG8_WAIT_L
#undef PG8_BAR
#undef PG8_SCHED
}

struct OrdStd {
    int nM, nN, G, c; const char* A; const char* B; size_t astep, bstep; int ashift, acolb;
    __device__ __forceinline__ bool next(int i, Unit& u) const { const int L = i * G + c; if (L >= nM * nN) return false; tile_of(L, nM, nN, u.pm, u.pn);
        u.A = A + (size_t)u.pm * astep + (size_t)((u.pn >> ashift) * acolb); u.B = B + (size_t)u.pn * bstep; return true; }
};
struct OrdQKV8 {
    int G, c; const char* A; const char* B;
    __device__ __forceinline__ bool next(int i, Unit& u) const { const int x = c & 7, e = (c >> 3) + i * (G >> 3); int j, n;
        if (x & 1) { if (e < 144) { j = e % 6; n = e / 6; } else if (e < 160) { j = 6 + ((e - 144) & 1); n = (e - 144) >> 1; } else return false; }
        else { if (e >= 192) return false; j = e & 7; n = e >> 3; }
        u.pm = 8 * x + j; u.pn = n; u.A = A + (size_t)u.pm * (256 * D) + 0; u.B = B + (size_t)n * (256 * D); return true; }
};
struct OrdQKVTail {
    int G, c; const char* A; const char* B;
    __device__ __forceinline__ bool next(int i, Unit& u) const { const int x = c & 7, r = c >> 3; if (i > 0 || !(x & 1) || r >= 32) return false;
        u.pm = 8 * x + 6 + (r & 1); u.pn = 8 + (r >> 1); u.A = A + (size_t)u.pm * (256 * D * 2); u.B = B + (size_t)u.pn * (256 * D * 2); return true; }
};
struct OrdS {
    int G, c; const char* A; const char* B;
    __device__ __forceinline__ bool next(int i, Unit& u) const { const int L = i * G + c; if (L >= 256) return false; tile_of(L, 64, 4, u.pm, u.pn);
        u.A = A + (size_t)u.pm * (256 * D * 2) + (size_t)u.pn * 1024; u.B = B + (size_t)(u.pm >> 4) * (256 * D * 2) + (size_t)u.pn * 1024; return true; }
};
struct OrdPV {
    int G, c; const char* A; const char* B;
    __device__ __forceinline__ bool next(int i, Unit& u) const { const int L = i * G + c; if (L >= 512) return false; tile_of(L, 64, 8, u.pm, u.pn);
        u.A = A + (size_t)u.pm * (256 * 1024 * 2) + (size_t)(u.pn >> 1) * 512; u.B = B + (size_t)(u.pm >> 4) * (D * 256 * 2) + (size_t)u.pn * (256 * 256 * 2); return true; }
};
struct OrdPV2 {
    int G, c; const char* A; const char* B;
    __device__ __forceinline__ bool next(int i, Unit& u) const { if (c >= 256 || i >= 2) return false; int h; tile_of(c, 64, 4, u.pm, h); u.pn = 2 * h + i;
        u.A = A + (size_t)u.pm * (256 * 1024 * 2) + (size_t)h * 512; u.B = B + (size_t)(u.pm >> 4) * (D * 256 * 2) + (size_t)u.pn * (256 * 256 * 2); return true; }
};
struct OrdMemKV {
    int G, c; const char* memb; const char* wt;
    __device__ __forceinline__ bool next(int i, Unit& u) const { const int L = i * G + c; if (L >= 256) return false; const int layer = L >> 6, r = L & 63;
        const char* w = wt + (size_t)layer * (4096 * (size_t)D * 2);
        if (r < 32) { const int tp = r & 3, pn = r >> 2; u.pm = layer * 64 + tp; u.pn = pn; u.A = memb + (size_t)tp * (256 * D * 2); u.B = w + (size_t)pn * (256 * D * 2); }
        else { const int q = r - 32, b = q & 3, vp = q >> 2; u.pm = layer * 64 + 32 + vp; u.pn = b; u.A = w + (size_t)(D + 256 * vp) * (D * 2); u.B = memb + (size_t)b * (256 * D * 2); }
        return true; }
};

__device__ __forceinline__ void wave_stats_load(const float* st, int row0, int lane, bool idn, f32x4 (&v)[2][4]) {
    if (idn) return;
#pragma unroll
    for (int j = 0; j < 2; ++j)
#pragma unroll
        for (int m = 0; m < 4; ++m) v[j][m] = *(const f32x4*)(st + (size_t)((unsigned)(row0 + 128 * j + 16 * m + (lane >> 2)) * 16u + (unsigned)(4 * (lane & 3))));
}
__device__ __forceinline__ void wave_stats_fin(const f32x4 (&v)[2][4], int lane, bool idn, float (&mu)[2][4], float (&rs)[2][4]) {
    if (idn) {
#pragma unroll
        for (int j = 0; j < 2; ++j)
#pragma unroll
            for (int m = 0; m < 4; ++m) { mu[j][m] = 0.f; rs[j][m] = 1.f; }
        return; }
    float invd = 1.f / D, eps = LN_EPS; asm volatile("" : "+s"(invd), "+s"(eps));
    const int a1 = (lane ^ 1) << 2, a2 = (lane ^ 2) << 2;
#pragma unroll
    for (int j = 0; j < 2; ++j)
#pragma unroll
        for (int m = 0; m < 4; ++m) {
            float s = v[j][m][0] + v[j][m][2], q = v[j][m][1] + v[j][m][3];
            s += __builtin_bit_cast(float, __builtin_amdgcn_ds_bpermute(a1, __builtin_bit_cast(int, s))); q += __builtin_bit_cast(float, __builtin_amdgcn_ds_bpermute(a1, __builtin_bit_cast(int, q)));
            s += __builtin_bit_cast(float, __builtin_amdgcn_ds_bpermute(a2, __builtin_bit_cast(int, s))); q += __builtin_bit_cast(float, __builtin_amdgcn_ds_bpermute(a2, __builtin_bit_cast(int, q)));
            const float mm = s * invd, var = q * invd - mm * mm;
            mu[j][m] = mm; rs[j][m] = __builtin_amdgcn_rsqf(var + eps);
        }
}
#define EPI_OPAQUE int pm = u.pm, pn = u.pn, ln_ = lane_id(); (void)lane; asm volatile("" : "+s"(pm), "+s"(pn), "+v"(ln_)); const int fr = ln_ & 15, fq = ln_ >> 4; (void)fr_; (void)fq_; \
        int rl = 64 * wr + fr;
#define EPI_ROWLOOP_BEGIN _Pragma("unroll") for (int ai = 0; ai < 2; ++ai) _Pragma("unroll") for (int m = 0; m < 4; ++m) { \
        asm volatile("" : "+v"(rl)); const float mr = shl(mu[ai][m], 4 * fr), rr = shl(rs[ai][m], 4 * fr);
#define EPI_ROWLOOP_END asm volatile("" ::: "memory"); rl += (m == 3) ? 80 : 16; }

struct EpiQKV {
    const float* st; bool idn; const float* uvec; const float* cvec;
    bf16_t* qkv; bf16_t* kvs; float* okp; float* oks;
    __device__ __forceinline__ void operator()(const f32x4 (&acc)[2][2][4][2], const Unit& u, int wr, int wc, int fr_, int fq_, int lane) const {
        EPI_OPAQUE
        const int which = pn >> 3; const bool smp = (pm == 64), tail = (!smp) && ((pm & 15) >= 14);
        f32x4 sv_[2][4]; wave_stats_load(st, pm * 256 + wr * 64, ln_, idn, sv_);
#define STATS_FIN float mu[2][4], rs[2][4]; wave_stats_fin(sv_, ln_, idn, mu, rs);
        const int colb = pn * 256 + wc * 64 + 8 * fq;
        f32x4 uu[2][2], cc[2][2];
#pragma unroll
        for (int bj = 0; bj < 2; ++bj)
#pragma unroll
            for (int n = 0; n < 2; ++n) { if (idn) { uu[bj][n] = (f32x4){0.f, 0.f, 0.f, 0.f}; cc[bj][n] = uu[bj][n]; }
                else { uu[bj][n] = *(const f32x4*)(uvec + colb + 32 * bj + 4 * n); cc[bj][n] = *(const f32x4*)(cvec + colb + 32 * bj + 4 * n); } }
        STATS_FIN
#undef STATS_FIN
        EPI_ROWLOOP_BEGIN
            const unsigned r = (unsigned)pm * 256u + (unsigned)rl;
            const float nrm = -rr * mr;
#pragma unroll
            for (int bj = 0; bj < 2; ++bj) {
                float v[8];
#pragma unroll
                for (int n = 0; n < 2; ++n)
#pragma unroll
                    for (int e = 0; e < 4; ++e) v[4 * n + e] = __builtin_fmaf(rr, acc[ai][bj][m][n][e], __builtin_fmaf(nrm, uu[bj][n][e], cc[bj][n][e]));
                const int col = colb + 32 * bj;
                *(u32x4*)(qkv + (size_t)(r * 6144u + (unsigned)col)) = pack8(v);
                if (which) {
                    const int colh = col - 2048 * which;
                    if (smp) { const int b = rl >> 5, t = rl & 31;
                        *(u32x4*)(kvs + (size_t)((unsigned)(((which - 1) * SBAT + b) * KVROWS + 512 + t) * (unsigned)D + (unsigned)colh)) = pack8(v);
                        float* o = oks + (size_t)(which - 1) * (O_AVS - O_AKS) + (size_t)((unsigned)rl * (unsigned)D + (unsigned)colh);
                        *(f32x4*)o = (f32x4){v[0], v[1], v[2], v[3]}; *(f32x4*)(o + 4) = (f32x4){v[4], v[5], v[6], v[7]}; }
                    else if (tail) { const int b = pm >> 4, pos = (pm & 15) * 256 + rl - 3584;
                        float* o = okp + (size_t)(which - 1) * (O_AVP - O_AKP) + (size_t)((unsigned)(b * 512 + pos) * (unsigned)D + (unsigned)colh);
                        *(f32x4*)o = (f32x4){v[0], v[1], v[2], v[3]}; *(f32x4*)(o + 4) = (f32x4){v[4], v[5], v[6], v[7]}; }
                }
            }
        EPI_ROWLOOP_END
    }
};
struct EpiNone { __device__ __forceinline__ void operator()(const f32x4 (&acc)[2][2][4][2], const Unit& u, int wr, int wc, int fr_, int fq_, int lane) const {
#pragma unroll
        for (int a = 0; a < 2; ++a)
#pragma unroll
            for (int b = 0; b < 2; ++b)
#pragma unroll
                for (int m = 0; m < 4; ++m)
#pragma unroll
                    for (int n = 0; n < 2; ++n) asm volatile("" :: "v"(acc[a][b][m][n])); } };
struct EpiQKV8 {
    const float* st; bool idn; const float* uvec; const float* cvec; bf16_t* qkv;
    __device__ __forceinline__ void operator()(const f32x4 (&acc)[2][2][4][2], const Unit& u, int wr, int wc, int fr_, int fq_, int lane) const {
        EPI_OPAQUE
        float kw = W8_INV; asm volatile("" : "+s"(kw));
        const float qs = 1.0f + (QSCALE - 1.0f) * (float)(pn < 8 ? 1 : 0);
        f32x4 sv_[2][4]; wave_stats_load(st, pm * 256 + wr * 64, ln_, idn, sv_);
        const int colb = pn * 256 + wc * 64 + 8 * fq;
        f32x4 uu[2][2], cc[2][2];
#pragma unroll
        for (int bj = 0; bj < 2; ++bj)
#pragma unroll
            for (int n = 0; n < 2; ++n) { if (idn) { uu[bj][n] = (f32x4){0.f, 0.f, 0.f, 0.f}; cc[bj][n] = uu[bj][n]; }
                else { uu[bj][n] = *(const f32x4*)(uvec + colb + 32 * bj + 4 * n); cc[bj][n] = *(const f32x4*)(cvec + colb + 32 * bj + 4 * n); } }
        float mu[2][4], rs[2][4]; wave_stats_fin(sv_, ln_, idn, mu, rs);
        EPI_ROWLOOP_BEGIN
            const unsigned r = (unsigned)pm * 256u + (unsigned)rl;
            const float rw = rr * kw * qs, nrm = -rr * mr * qs;
#pragma unroll
            for (int bj = 0; bj < 2; ++bj) {
                float v[8];
#pragma unroll
                for (int n = 0; n < 2; ++n)
#pragma unroll
                    for (int e = 0; e < 4; ++e) v[4 * n + e] = __builtin_fmaf(rw, acc[ai][bj][m][n][e], __builtin_fmaf(nrm, uu[bj][n][e], cc[bj][n][e] * qs));
                *(u32x4*)(qkv + (size_t)(r * 6144u + (unsigned)(colb + 32 * bj))) = pack8(v);
            }
        EPI_ROWLOOP_END
    }
};
struct EpiLinBf16 {
    const float* st; const float* uvec; const float* cvec; bf16_t* out; float ascale;
    __device__ __forceinline__ void operator()(const f32x4 (&acc)[2][2][4][2], const Unit& u, int wr, int wc, int fr_, int fq_, int lane) const {
        EPI_OPAQUE
        float as_ = ascale; asm volatile("" : "+s"(as_));
        f32x4 sv_[2][4]; wave_stats_load(st, pm * 256 + wr * 64, ln_, false, sv_);
#define STATS_FIN float mu[2][4], rs[2][4]; wave_stats_fin(sv_, ln_, false, mu, rs);
        const int colb = pn * 256 + wc * 64 + 8 * fq;
        f32x4 uu[2][2], cc[2][2];
#pragma unroll
        for (int bj = 0; bj < 2; ++bj)
#pragma unroll
            for (int n = 0; n < 2; ++n) { uu[bj][n] = *(const f32x4*)(uvec + colb + 32 * bj + 4 * n); cc[bj][n] = *(const f32x4*)(cvec + colb + 32 * bj + 4 * n); }
        STATS_FIN
#undef STATS_FIN
        EPI_ROWLOOP_BEGIN
            const unsigned eo = ((unsigned)pm * 256u + (unsigned)rl) * (unsigned)D + (unsigned)colb;
            const float rw = rr * as_, rm = rr * mr;
#pragma unroll
            for (int bj = 0; bj < 2; ++bj) {
                float v[8];
#pragma unroll
                for (int n = 0; n < 2; ++n)
#pragma unroll
                    for (int e = 0; e < 4; ++e) v[4 * n + e] = __builtin_fmaf(rw, acc[ai][bj][m][n][e], __builtin_fmaf(-rm, uu[bj][n][e], cc[bj][n][e]));
                *(u32x4*)(out + (size_t)(eo + 32u * bj)) = pack8(v);
            }
        EPI_ROWLOOP_END
    }
};
struct EpiFfnIn {
    static constexpr bool kPre = true;
    const float* st; const float* uvec; const float* cvec; unsigned char* H; LAS char* lv; mutable int wpar, rpar, cpm;
    __device__ __forceinline__ void prefetch(const Unit& u, int wid, int lane) const {
        const float* src = wid < 4 ? uvec : cvec;
        const unsigned vo = (unsigned)(u.pn * 256 + (wid & 3) * 64 + lane) * 4u;
        const unsigned dst = (unsigned)(uintptr_t)lv + (unsigned)wpar * 2048u + (unsigned)wid * 256u;
        asm volatile("s_mov_b32 m0, %2\n\ts_nop 0\n\tglobal_load_lds_dword %0, %1" :: "v"(vo), "s"(src), "s"(dst) : "memory", "m0");
        wpar ^= 1;
    }
    __device__ __forceinline__ void operator()(const f32x4 (&acc)[2][2][4][2], const Unit& u, int wr, int wc, int fr_, int fq_, int lane) const {
        EPI_OPAQUE
        float kw = W8_INV, kh = H8_SCALE, lim = 448.f; asm volatile("" : "+s"(kw), "+s"(kh), "+v"(lim));
        const float nlim = -lim; float nl2e = -LOG2E; asm volatile("" : "+s"(nl2e));
        LAS f32x2* tabs = (LAS f32x2*)(lv + 4096);
        if (cpm != pm) {
            f32x4 sv_[2][4]; wave_stats_load(st, pm * 256 + wr * 64, ln_, false, sv_);
            float mu[2][4], rs[2][4]; wave_stats_fin(sv_, ln_, false, mu, rs);
            asm volatile("s_waitcnt lgkmcnt(0)" ::: "memory"); __builtin_amdgcn_s_barrier();
            if (wc == 0 && (ln_ & 3) == 0) {
#pragma unroll
                for (int j = 0; j < 2; ++j)
#pragma unroll
                    for (int m = 0; m < 4; ++m) tabs[128 * j + 64 * wr + 16 * m + (ln_ >> 2)] = (f32x2){mu[j][m], rs[j][m]}; }
            asm volatile("s_waitcnt lgkmcnt(0)" ::: "memory"); __builtin_amdgcn_s_barrier(); asm volatile("" ::: "memory");
            cpm = pm;
        }
        LAS const f32x4* vb = (LAS const f32x4*)(lv + rpar * 2048); rpar ^= 1;
        const int cq = wc * 16 + 2 * fq;
        f32x4 uu[2][2], cc[2][2];
#pragma unroll
        for (int bj = 0; bj < 2; ++bj)
#pragma unroll
            for (int n = 0; n < 2; ++n) { uu[bj][n] = vb[cq + 8 * bj + n]; cc[bj][n] = vb[64 + cq + 8 * bj + n]; }
#pragma unroll
        for (int n = 0; n < 2; ++n) cc[1][n] = cc[1][n] * kh;
#pragma unroll
        for (int ai = 0; ai < 2; ++ai)
#pragma unroll
            for (int m = 0; m < 4; ++m) { asm volatile("" : "+v"(rl));
            const f32x2 ms_ = tabs[128 * ai + 64 * wr + 16 * m + fr]; const float mr = ms_[0], rr = ms_[1];
            const float rw = rr * kw, rm = rr * mr, rwu = rw * kh, rmu = rm * kh;
            float v[8];
#pragma unroll
            for (int n = 0; n < 2; ++n) {
#pragma unroll
                for (int e = 0; e < 4; ++e) { const float g = __builtin_fmaf(rw, acc[ai][0][m][n][e], __builtin_fmaf(-rm, uu[0][n][e], cc[0][n][e]));
                    const float inv = __builtin_amdgcn_rcpf(1.0f + __builtin_amdgcn_exp2f(g * nl2e));
                    const float up = __builtin_fmaf(rwu, acc[ai][1][m][n][e], __builtin_fmaf(-rmu, uu[1][n][e], cc[1][n][e]));
                    v[4 * n + e] = __builtin_amdgcn_fmed3f(g * up * inv, nlim, lim); }
            }
            if (PROBE_ID != 413 || H) *(u32x2*)(H + (size_t)(((unsigned)pm * 256u + (unsigned)rl) * (unsigned)DFF + (unsigned)(pn * 128 + wc * 32 + 8 * fq))) = pack8_fp8(v);
            else asm volatile("" :: "v"(v[0]), "v"(v[1]), "v"(v[2]), "v"(v[3]), "v"(v[4]), "v"(v[5]), "v"(v[6]), "v"(v[7]));
        EPI_ROWLOOP_END
    }
};
template <bool POOL, bool Z8 = false> struct EpiRes {
    const float* st_old; float* st_new; bool idn; const float* xp; const float* xs; half_t* zf; bf16_t* zb; const float* g; const float* b; const float* psc; LAS f32x2* red; float ascale; half_t* zfo; unsigned char* z8x;
    __device__ __forceinline__ void operator()(const f32x4 (&acc)[2][2][4][2], const Unit& u, int wr, int wc, int fr_, int fq_, int lane) const {
        EPI_OPAQUE
        float as_ = ascale; asm volatile("" : "+s"(as_));
        f32x4 sv_[2][4]; wave_stats_load(st_old, pm * 256 + wr * 64, ln_, idn, sv_);
#define STATS_FIN float mu[2][4], rs[2][4]; wave_stats_fin(sv_, ln_, idn, mu, rs);
        const float* zo = pm < 64 ? xp + (size_t)pm * 256 * D : xs;
        const half_t* zoh = zf + (size_t)pm * 256 * D;
        const int colb = pn * 256 + wc * 64 + 8 * fq;
        f32x4 gA[2][2], bA[2][2], ps[2][2];
#pragma unroll
        for (int bj = 0; bj < 2; ++bj)
#pragma unroll
            for (int n = 0; n < 2; ++n) { const int c = colb + 32 * bj + 4 * n;
                if (idn) { gA[bj][n] = (f32x4){ALPHA, ALPHA, ALPHA, ALPHA}; bA[bj][n] = (f32x4){0.f, 0.f, 0.f, 0.f}; }
                else { gA[bj][n] = *(const f32x4*)(g + c) * ALPHA; bA[bj][n] = *(const f32x4*)(b + c) * ALPHA; }
                if (POOL) ps[bj][n] = *(const f32x4*)(psc + c); }
        u32x4 zq[8][2];
#define EPIRES_ZLOAD(gi) do { if (!idn) { _Pragma("unroll") for (int bj_ = 0; bj_ < 2; ++bj_) \
            zq[gi][bj_] = *(const u32x4*)(zoh + (size_t)((unsigned)(128 * ((gi) >> 2) + 64 * wr + 16 * ((gi) & 3) + fr) * (unsigned)D + (unsigned)(colb + 32 * bj_))); } } while (0)
        constexpr int ZPD = POOL ? 1 : 2;
        EPIRES_ZLOAD(0); if (ZPD > 1) EPIRES_ZLOAD(1);
        STATS_FIN
#undef STATS_FIN
        EPI_ROWLOOP_BEGIN
            if (4 * ai + m + ZPD < 8) EPIRES_ZLOAD(4 * ai + m + ZPD);
            const unsigned lo = (unsigned)rl * (unsigned)D + (unsigned)colb;
            const unsigned eo = (unsigned)pm * (256u * D) + lo;
            const float nmr = -mr * rr;
            float s = 0.f, q = 0.f;
#pragma unroll
            for (int bj = 0; bj < 2; ++bj) {
                float zz[8];
                if (idn) { const f32x4 z0 = *(const f32x4*)(zo + (size_t)(lo + 32u * bj)), z1 = *(const f32x4*)(zo + (size_t)(lo + 32u * bj + 4u));
#pragma unroll
                    for (int e = 0; e < 4; ++e) { zz[e] = z0[e]; zz[4 + e] = z1[e]; } }
                else unpack8h(zq[4 * ai + m][bj], zz);
                float v[8];
#pragma unroll
                for (int e = 0; e < 4; ++e) {
                    float a0 = acc[ai][bj][m][0][e] * as_, a1 = acc[ai][bj][m][1][e] * as_;
                    if (POOL) { a0 *= ps[bj][0][e]; a1 *= ps[bj][1][e]; }
                    v[e] = __builtin_fmaf(__builtin_fmaf(zz[e], rr, nmr), gA[bj][0][e], bA[bj][0][e] + a0);
                    v[4 + e] = __builtin_fmaf(__builtin_fmaf(zz[4 + e], rr, nmr), gA[bj][1][e], bA[bj][1][e] + a1);
                }
#pragma unroll
                for (int e = 0; e < 8; ++e) { s += v[e]; q += v[e] * v[e]; }
                *(u32x4*)(zfo + (size_t)(eo + 32u * bj)) = pack8h(v);
                if (Z8) *(u32x2*)((unsigned char*)zb + (size_t)(eo + 32u * bj)) = pack8_fp8(v);
                else { if (zb && (pm & 15) >= 14) *(u32x4*)(zb + (size_t)(eo + 32u * bj)) = pack8(v); if (z8x) *(u32x2*)(z8x + (size_t)(eo + 32u * bj)) = pack8_fp8(v); }
            }
            s += shx(s, 16); s += shx(s, 32); q += shx(q, 16); q += shx(q, 32);
            if (fq == 0) red[((wr * 4 + wc) * 128 + 64 * ai + 16 * m + fr)] = (f32x2){s, q};
        EPI_ROWLOOP_END
        asm volatile("s_waitcnt lgkmcnt(0)" ::: "memory"); __builtin_amdgcn_s_barrier(); asm volatile("" ::: "memory");
        if (ln_ < 32) { const int hrow = 32 * wc + ln_; f32x2 t = red[(wr * 4 + 0) * 128 + hrow];
            t += red[(wr * 4 + 1) * 128 + hrow]; t += red[(wr * 4 + 2) * 128 + hrow]; t += red[(wr * 4 + 3) * 128 + hrow];
            const int rrow = 128 * (hrow >> 6) + 64 * wr + (hrow & 63);
            *(f32x2*)(st_new + (size_t)(((unsigned)pm * 256u + (unsigned)rrow) * 16u + (unsigned)(pn * 2))) = t; }
        asm volatile("s_waitcnt lgkmcnt(0)" ::: "memory");
    }
};
#define EPI_PLAINLOOP_BEGIN _Pragma("unroll") for (int ai = 0; ai < 2; ++ai) _Pragma("unroll") for (int m = 0; m < 4; ++m) { asm volatile("" : "+v"(rl));
struct EpiS {
    float* S;
    __device__ __forceinline__ void operator()(const f32x4 (&acc)[2][2][4][2], const Unit& u, int wr, int wc, int fr_, int fq_, int lane) const {
        EPI_OPAQUE
        EPI_PLAINLOOP_BEGIN
            float* o = S + (size_t)(((unsigned)pm * 256u + (unsigned)rl) * 1024u + (unsigned)(pn * 256 + wc * 64 + 8 * fq));
#pragma unroll
            for (int bj = 0; bj < 2; ++bj) { *(f32x4*)(o + 32 * bj) = acc[ai][bj][m][0]; *(f32x4*)(o + 32 * bj + 4) = acc[ai][bj][m][1]; }
        EPI_ROWLOOP_END
    }
};
struct EpiSoftP {
    bf16_t* P; LAS float* tab;
    __device__ __forceinline__ void operator()(f32x4 (&acc)[2][2][4][2], const Unit& u, int wr, int wc, int fr_, int fq_, int lane) const {
        EPI_OPAQUE
        float c2 = 0.04419417382415922f * LOG2E; asm volatile("" : "+s"(c2));
        LAS float* t0 = tab + (wr * 4) * 128; LAS float* t1 = tab + 1024 + (wr * 4) * 128;
#pragma unroll
        for (int ai = 0; ai < 2; ++ai)
#pragma unroll
            for (int m = 0; m < 4; ++m) { float mx = acc[ai][0][m][0][0];
#pragma unroll
                for (int bj = 0; bj < 2; ++bj)
#pragma unroll
                    for (int n = 0; n < 2; ++n)
#pragma unroll
                        for (int e = 0; e < 4; ++e) mx = fmaxf(mx, acc[ai][bj][m][n][e]);
                mx = fmaxf(mx, shx(mx, 16)); mx = fmaxf(mx, shx(mx, 32));
                if (fq == 0) t0[wc * 128 + 64 * ai + 16 * m + fr] = mx; }
        asm volatile("s_waitcnt lgkmcnt(0)" ::: "memory"); __builtin_amdgcn_s_barrier(); asm volatile("" ::: "memory");
#pragma unroll
        for (int ai = 0; ai < 2; ++ai)
#pragma unroll
            for (int m = 0; m < 4; ++m) { const int hr = 64 * ai + 16 * m + fr;
                const float mx = fmaxf(fmaxf(t0[hr], t0[128 + hr]), fmaxf(t0[256 + hr], t0[384 + hr])); float s = 0.f;
#pragma unroll
                for (int bj = 0; bj < 2; ++bj)
#pragma unroll
                    for (int n = 0; n < 2; ++n)
#pragma unroll
                        for (int e = 0; e < 4; ++e) { const float p = __builtin_amdgcn_exp2f((acc[ai][bj][m][n][e] - mx) * c2); acc[ai][bj][m][n][e] = p; s += p; }
                s += shx(s, 16); s += shx(s, 32);
                if (fq == 0) t1[wc * 128 + hr] = s; }
        asm volatile("s_waitcnt lgkmcnt(0)" ::: "memory"); __builtin_amdgcn_s_barrier(); asm volatile("" ::: "memory");
        EPI_PLAINLOOP_BEGIN
            const int hr = 64 * ai + 16 * m + fr;
            const float inv = __builtin_amdgcn_rcpf((t1[hr] + t1[128 + hr]) + (t1[256 + hr] + t1[384 + hr]));
            bf16_t* o = P + (size_t)(((unsigned)pm * 256u + (unsigned)rl) * 1024u + (unsigned)(pn * 256 + wc * 64 + 8 * fq));
#pragma unroll
            for (int bj = 0; bj < 2; ++bj) { const f32x4 a = acc[ai][bj][m][0] * inv, c = acc[ai][bj][m][1] * inv; const float v[8] = {a[0], a[1], a[2], a[3], c[0], c[1], c[2], c[3]};
                *(u32x4*)(o + 32 * bj) = pack8(v); }
        EPI_ROWLOOP_END
    }
};
struct EpiO8 {
    unsigned char* out;
    __device__ __forceinline__ void operator()(const f32x4 (&acc)[2][2][4][2], const Unit& u, int wr, int wc, int fr_, int fq_, int lane) const {
        EPI_OPAQUE
        float ko = O8_SCALE; asm volatile("" : "+s"(ko));
        EPI_PLAINLOOP_BEGIN
            unsigned char* o = out + (size_t)(((unsigned)pm * 256u + (unsigned)rl) * (unsigned)D + (unsigned)(pn * 256 + wc * 64 + 8 * fq));
#pragma unroll
            for (int bj = 0; bj < 2; ++bj) { const f32x4 a = acc[ai][bj][m][0] * ko, c = acc[ai][bj][m][1] * ko; const float v[8] = {a[0], a[1], a[2], a[3], c[0], c[1], c[2], c[3]};
                *(u32x2*)(o + 32 * bj) = pack8_fp8(v); }
        EPI_ROWLOOP_END
    }
};
struct EpiMemKV {
    bf16_t* mkp; bf16_t* mvtp; float* ok; float* ov;
    __device__ __forceinline__ void operator()(const f32x4 (&acc)[2][2][4][2], const Unit& u, int wr, int wc, int fr_, int fq_, int lane) const {
        EPI_OPAQUE
        const int layer = pm >> 6, r6 = pm & 63;
        EPI_PLAINLOOP_BEGIN
#pragma unroll
            for (int bj = 0; bj < 2; ++bj) { const f32x4 a = acc[ai][bj][m][0], c = acc[ai][bj][m][1]; const float v[8] = {a[0], a[1], a[2], a[3], c[0], c[1], c[2], c[3]};
                const int cl = 32 * bj + wc * 64 + 8 * fq;
                if (r6 < 32) { const unsigned eo = (unsigned)(layer * 1024 + r6 * 256 + rl) * (unsigned)D + (unsigned)(pn * 256 + cl);
                    *(u32x4*)(mkp + (size_t)eo) = pack8(v);
                    float* o = ok + (size_t)eo; *(f32x4*)o = a; *(f32x4*)(o + 4) = c; }
                else { const int vcol = (r6 - 32) * 256 + rl, bb = pn;
                    *(u32x4*)(mvtp + (size_t)((unsigned)((layer * NB + bb) * D + vcol) * 256u + (unsigned)cl)) = pack8(v);
                    float* o = ov + (size_t)((unsigned)((layer * NB + bb) * 256 + cl) * (unsigned)D + (unsigned)vcol);
#pragma unroll
                    for (int e = 0; e < 8; ++e) o[(size_t)e * D] = v[e]; }
            }
        EPI_ROWLOOP_END
    }
};

struct OrdMemKV2 {
    int G, c; const char* memb; const char* wt;
    __device__ __forceinline__ bool next(int i, Unit& u) const { const int L = i * G + c; if (L >= 256) return false; const int layer = L >> 6, r = L & 63, tp = r & 3, pn = r >> 2;
        u.pm = layer * 4 + tp; u.pn = pn; u.A = memb + (size_t)tp * (256 * D * 2); u.B = wt + (size_t)layer * (4096 * (size_t)D * 2) + (size_t)pn * (256 * D * 2); return true; }
};
struct EpiMemKV2 {
    unsigned char* k8; unsigned char* v8; float* ok; float* ov;
    __device__ __forceinline__ void operator()(const f32x4 (&acc)[2][2][4][2], const Unit& u, int wr, int wc, int fr_, int fq_, int lane) const {
        EPI_OPAQUE
        const int isv = pn >> 3; const float sc8 = 1.f + (MV8_SCALE - 1.f) * (float)isv;
        float* of = ok + (size_t)isv * (size_t)(ov - ok); unsigned char* o8 = k8 + (size_t)isv * (size_t)(v8 - k8);
        EPI_PLAINLOOP_BEGIN
            const unsigned eo = ((unsigned)pm * 256u + (unsigned)rl) * (unsigned)D + (unsigned)((pn & 7) * 256 + wc * 64 + 8 * fq);
#pragma unroll
            for (int bj = 0; bj < 2; ++bj) { const f32x4 a = acc[ai][bj][m][0], c = acc[ai][bj][m][1];
                float* o = of + (size_t)(eo + 32u * bj); *(f32x4*)o = a; *(f32x4*)(o + 4) = c;
                const float v[8] = {a[0] * sc8, a[1] * sc8, a[2] * sc8, a[3] * sc8, c[0] * sc8, c[1] * sc8, c[2] * sc8, c[3] * sc8};
                *(u32x2*)(o8 + (size_t)(eo + 32u * bj)) = pack8_fp8(v); }
        EPI_ROWLOOP_END
    }
};
struct OrdW12 {
    int G, c; const char* k8; const char* wqr; const char* wmo_; const char* v8;
    __device__ __forceinline__ bool next(int i, Unit& u) const { if (i >= 4) return false; const int v = (c & 7) * 128 + (c >> 3) + (G >> 3) * i; if (v >= 1024) return false;
        const int idx = v & 511, l = idx >> 7, b = (idx >> 5) & 3, h = (idx >> 3) & 3, t = idx & 7; u.pm = v; u.pn = t;
        if (v < 512) { u.A = k8 + ((size_t)(l * 1024 + b * 256) * D) + h * 512; u.B = wqr + ((size_t)(l * 2048 + t * 256) * D) + h * 512; }
        else { u.A = wmo_ + ((size_t)(l * 2048 + t * 256) * D) + h * 512; u.B = v8 + ((size_t)(l * 1024 + b * 256) * D) + h * 512; }
        return true; }
};
struct EpiW12 {
    unsigned char* w1_; unsigned char* w2_; float* u1; float* c1; const float* lg; const float* lb;
    __device__ __forceinline__ void operator()(const f32x4 (&acc)[2][2][4][2], const Unit& u, int wr, int wc, int fr_, int fq_, int lane) const {
        EPI_OPAQUE
        const int idx = pm & 511, l = idx >> 7, b = (idx >> 5) & 3, h = (idx >> 3) & 3, t = pn;
        if (pm < 512) {
            float k1 = W1_SCALE / WQR_SCALE, ki = 1.f / W1_SCALE; asm volatile("" : "+s"(k1), "+s"(ki));
            const int colb = t * 256 + wc * 64 + 8 * fq;
            f32x4 bg[2][2];
#pragma unroll
            for (int bj = 0; bj < 2; ++bj)
#pragma unroll
                for (int n = 0; n < 2; ++n) { const f32x4 gg = *(const f32x4*)(lg + (size_t)(l * 3) * D + colb + 32 * bj + 4 * n), bb = *(const f32x4*)(lb + (size_t)(l * 3) * D + colb + 32 * bj + 4 * n);
#pragma unroll
                    for (int e = 0; e < 4; ++e) bg[bj][n][e] = bb[e] * __builtin_amdgcn_rcpf(gg[e]) * ki; }
            EPI_PLAINLOOP_BEGIN
                const unsigned nrow = (unsigned)((l * NB + b) * 1024 + h * 256) + (unsigned)rl; float su = 0.f, sc = 0.f;
#pragma unroll
                for (int bj = 0; bj < 2; ++bj) { const f32x4 a = acc[ai][bj][m][0] * k1, c = acc[ai][bj][m][1] * k1; const float v[8] = {a[0], a[1], a[2], a[3], c[0], c[1], c[2], c[3]};
                    const u32x2 w = pack8_fp8(v); *(u32x2*)(w1_ + (size_t)(nrow * (unsigned)D + (unsigned)(colb + 32 * bj))) = w;
                    su += sum4_fp8(w.x) + sum4_fp8(w.y);
#pragma unroll
                    for (int e = 0; e < 4; ++e) sc += a[e] * bg[bj][0][e] + c[e] * bg[bj][1][e]; }
                su += shx(su, 16); su += shx(su, 32); sc += shx(sc, 16); sc += shx(sc, 32);
                if (fq == 0) { atomicAdd(u1 + nrow, su * ki); atomicAdd(c1 + nrow, sc); }
            EPI_ROWLOOP_END
        } else {
            float k2 = W2_SCALE / (W8_SCALE * MV8_SCALE); asm volatile("" : "+s"(k2));
            EPI_PLAINLOOP_BEGIN
                unsigned char* o = w2_ + (size_t)(((unsigned)((l * NB + b) * D + t * 256) + (unsigned)rl) * 1024u + (unsigned)(h * 256 + wc * 64 + 8 * fq));
#pragma unroll
                for (int bj = 0; bj < 2; ++bj) { const f32x4 a = acc[ai][bj][m][0] * k2, c = acc[ai][bj][m][1] * k2; const float v[8] = {a[0], a[1], a[2], a[3], c[0], c[1], c[2], c[3]};
                    *(u32x2*)(o + 32 * bj) = pack8_fp8(v); }
            EPI_ROWLOOP_END
        }
    }
};
struct OrdS8 {
    int G, c; const char* A; const char* B;
    __device__ __forceinline__ bool next(int i, Unit& u) const { const int L = i * G + c; if (L >= 256) return false; tile_of(L, 64, 4, u.pm, u.pn);
        u.A = A + (size_t)u.pm * (256 * D); u.B = B + ((size_t)((u.pm >> 4) * 1024 + u.pn * 256) * D); return true; }
};
struct OrdG2 {
    int G, c; const char* A; const char* B;
    __device__ __forceinline__ bool next(int i, Unit& u) const { const int L = i * G + c; if (L >= 512) return false; tile_of(L, 64, 8, u.pm, u.pn);
        u.A = A + (size_t)u.pm * (256 * 1024); u.B = B + ((size_t)((u.pm >> 4) * D + u.pn * 256) * 1024); return true; }
};
struct EpiSoftP8 {
    const float* st; const float* uvec; const float* cvec; unsigned char* P; LAS float* tab;
    __device__ __forceinline__ void operator()(f32x4 (&acc)[2][2][4][2], const Unit& u, int wr, int wc, int fr_, int fq_, int lane) const {
        EPI_OPAQUE
        float c2 = 0.04419417382415922f * LOG2E, ki = 1.f / W1_SCALE, kp = P8_SCALE; asm volatile("" : "+s"(c2), "+s"(ki), "+s"(kp));
        f32x4 sv_[2][4]; wave_stats_load(st, pm * 256 + wr * 64, ln_, false, sv_);
        const int colb = pn * 256 + wc * 64 + 8 * fq;
        const float* ub = uvec + (size_t)(pm >> 4) * 1024; const float* cb = cvec + (size_t)(pm >> 4) * 1024;
        f32x4 uu[2][2], cc[2][2];
#pragma unroll
        for (int bj = 0; bj < 2; ++bj)
#pragma unroll
            for (int n = 0; n < 2; ++n) { uu[bj][n] = *(const f32x4*)(ub + colb + 32 * bj + 4 * n); cc[bj][n] = *(const f32x4*)(cb + colb + 32 * bj + 4 * n); }
        float mu[2][4], rs[2][4]; wave_stats_fin(sv_, ln_, false, mu, rs);
        LAS float* t0 = tab + (wr * 4) * 128; LAS float* t1 = tab + 1024 + (wr * 4) * 128;
#pragma unroll
        for (int ai = 0; ai < 2; ++ai)
#pragma unroll
            for (int m = 0; m < 4; ++m) { const float mr = shl(mu[ai][m], 4 * fr), rr = shl(rs[ai][m], 4 * fr); const float rw = rr * ki * c2, nrm = -rr * mr * c2;
                float mx = -3.0e38f;
#pragma unroll
                for (int bj = 0; bj < 2; ++bj)
#pragma unroll
                    for (int n = 0; n < 2; ++n)
#pragma unroll
                        for (int e = 0; e < 4; ++e) { const float s = __builtin_fmaf(rw, acc[ai][bj][m][n][e], __builtin_fmaf(nrm, uu[bj][n][e], cc[bj][n][e] * c2)); acc[ai][bj][m][n][e] = s; mx = fmaxf(mx, s); }
                mx = fmaxf(mx, shx(mx, 16)); mx = fmaxf(mx, shx(mx, 32));
                if (fq == 0) t0[wc * 128 + 64 * ai + 16 * m + fr] = mx; }
        asm volatile("s_waitcnt lgkmcnt(0)" ::: "memory"); __builtin_amdgcn_s_barrier(); asm volatile("" ::: "memory");
#pragma unroll
        for (int ai = 0; ai < 2; ++ai)
#pragma unroll
            for (int m = 0; m < 4; ++m) { const int hr = 64 * ai + 16 * m + fr;
                const float mx = fmaxf(fmaxf(t0[hr], t0[128 + hr]), fmaxf(t0[256 + hr], t0[384 + hr])); float s = 0.f;
#pragma unroll
                for (int bj = 0; bj < 2; ++bj)
#pragma unroll
                    for (int n = 0; n < 2; ++n)
#pragma unroll
                        for (int e = 0; e < 4; ++e) { const float p = __builtin_amdgcn_exp2f(acc[ai][bj][m][n][e] - mx); acc[ai][bj][m][n][e] = p; s += p; }
                s += shx(s, 16); s += shx(s, 32);
                if (fq == 0) t1[wc * 128 + hr] = s; }
        asm volatile("s_waitcnt lgkmcnt(0)" ::: "memory"); __builtin_amdgcn_s_barrier(); asm volatile("" ::: "memory");
        EPI_PLAINLOOP_BEGIN
            const int hr = 64 * ai + 16 * m + fr;
            const float inv = kp * __builtin_amdgcn_rcpf((t1[hr] + t1[128 + hr]) + (t1[256 + hr] + t1[384 + hr]));
            unsigned char* o = P + (size_t)(((unsigned)pm * 256u + (unsigned)rl) * 1024u + (unsigned)(pn * 256 + wc * 64 + 8 * fq + 24 * (fq & 1)));
            u32x2 p8[2];
#pragma unroll
            for (int bj = 0; bj < 2; ++bj) { const f32x4 a = acc[ai][bj][m][0] * inv, c = acc[ai][bj][m][1] * inv; const float v[8] = {a[0], a[1], a[2], a[3], c[0], c[1], c[2], c[3]};
                p8[bj] = pack8_fp8(v); }
            *(u32x4*)o = widen8(p8[0], p8[1]);
        EPI_ROWLOOP_END
    }
};
}

__device__ __forceinline__ void tr_item(const float* W, int K, int N, int ldw, bf16_t* WT, LAS float* scr, int item, int lane, const float* g, const float* b, float* uv, float* cv, bool ileave, bool f8 = false, unsigned char* WT8 = nullptr, float* uv8 = nullptr, unsigned char* WR8 = nullptr) {
    const int nblk = N / 64, kb = item / nblk, nb = item % nblk, k0 = 64 * kb, n0 = 64 * nb;
#pragma unroll 16
    for (int kk = 0; kk < 64; ++kk) scr[kk * 65 + lane] = __builtin_nontemporal_load(W + (size_t)(k0 + kk) * ldw + n0 + lane);
    LDS_WAIT(); asm volatile("" ::: "memory");
    if (WR8) {
        const float sc = WQR_SCALE * g[k0 + lane]; const LAS float* s = scr + lane * 65; GAS u32x4* o8 = (GAS u32x4*)(WR8 + (size_t)(k0 + lane) * N + n0);
#pragma unroll
        for (int q = 0; q < 4; ++q) { u32x4 w;
#pragma unroll
            for (int e = 0; e < 4; ++e) w[e] = pk4_fp8(s[16 * q + 4 * e] * sc, s[16 * q + 4 * e + 1] * sc, s[16 * q + 4 * e + 2] * sc, s[16 * q + 4 * e + 3] * sc);
            o8[q] = w; } }
    const int c = lane & 7;
    float gk[8], bk[8];
    if (g) {
#pragma unroll
        for (int i = 0; i < 8; ++i) { gk[i] = g[k0 + 8 * c + i]; bk[i] = b[k0 + 8 * c + i]; } }
#pragma unroll
    for (int j = 0; j < 8; ++j) { const int nl = (lane >> 3) + 8 * j; const LAS float* s = scr + (8 * c) * 65 + nl;
        float w[8];
#pragma unroll
        for (int i = 0; i < 8; ++i) w[i] = s[i * 65];
        int n = n0 + nl, dr = n;
        if (ileave) { const int hc = (n < DFF) ? n : n - DFF, j = hc & 127; dr = 256 * (hc >> 7) + 64 * (j >> 5) + (j & 31) + ((n < DFF) ? 0 : 32); }
        float su = 0.f, sc = 0.f;
        if (g) {
#pragma unroll
            for (int i = 0; i < 8; ++i) { sc += bk[i] * w[i]; w[i] *= gk[i]; } }
        if (f8) { u32x2 o8; o8.x = pk4_fp8(w[0] * W8_SCALE, w[1] * W8_SCALE, w[2] * W8_SCALE, w[3] * W8_SCALE); o8.y = pk4_fp8(w[4] * W8_SCALE, w[5] * W8_SCALE, w[6] * W8_SCALE, w[7] * W8_SCALE);
            *(GAS u32x2*)((unsigned char*)WT + (size_t)dr * K + k0 + 8 * c) = o8;
            if (g) su = (sum4_fp8(o8.x) + sum4_fp8(o8.y)) * W8_INV; }
        else { u32x4 o; o.x = pk2(w[0], w[1]); o.y = pk2(w[2], w[3]); o.z = pk2(w[4], w[5]); o.w = pk2(w[6], w[7]);
        *(GAS u32x4*)(WT + (size_t)dr * K + k0 + 8 * c) = o;
        if (g) su = (bf2f(o.x & 0xffffu) + bf2f(o.x >> 16)) + (bf2f(o.y & 0xffffu) + bf2f(o.y >> 16)) + (bf2f(o.z & 0xffffu) + bf2f(o.z >> 16)) + (bf2f(o.w & 0xffffu) + bf2f(o.w >> 16)); }
        if (WT8) { u32x2 o8; o8.x = pk4_fp8(w[0] * W8_SCALE, w[1] * W8_SCALE, w[2] * W8_SCALE, w[3] * W8_SCALE); o8.y = pk4_fp8(w[4] * W8_SCALE, w[5] * W8_SCALE, w[6] * W8_SCALE, w[7] * W8_SCALE);
            *(GAS u32x2*)(WT8 + (size_t)dr * K + k0 + 8 * c) = o8;
            if (g) { float s8 = (sum4_fp8(o8.x) + sum4_fp8(o8.y)) * W8_INV; s8 += shx(s8, 1); s8 += shx(s8, 2); s8 += shx(s8, 4); if (c == 0 && uv8) atomicAdd(uv8 + dr, s8); } }
        if (g) {
            su += shx(su, 1); su += shx(su, 2); su += shx(su, 4);
            sc += shx(sc, 1); sc += shx(sc, 2); sc += shx(sc, 4);
            if (c == 0 && uv) { atomicAdd(uv + dr, su); atomicAdd(cv + dr, sc); }
        }
    }
    LDS_WAIT(); asm volatile("" ::: "memory");
}
__device__ __forceinline__ void cvt_row8(const float* src, unsigned char* dst8, int lane) {
    const GAS f32x4* s = (const GAS f32x4*)src + lane; GAS unsigned* o8 = (GAS unsigned*)dst8 + lane;
    f32x4 v[8];
#pragma unroll
    for (int j = 0; j < 8; ++j) v[j] = __builtin_nontemporal_load(s + 64 * j);
#pragma unroll
    for (int j = 0; j < 8; ++j) o8[64 * j] = pk4_fp8(v[j][0], v[j][1], v[j][2], v[j][3]);
}
__device__ __forceinline__ void cvt_row(const float* src, bf16_t* dst, int lane, unsigned char* dst8 = nullptr) {
    const GAS f32x4* s = (const GAS f32x4*)src + lane; GAS u32x2* o = (GAS u32x2*)dst + lane;
    f32x4 v[8];
#pragma unroll
    for (int j = 0; j < 8; ++j) v[j] = __builtin_nontemporal_load(s + 64 * j);
#pragma unroll
    for (int j = 0; j < 8; ++j) { u32x2 w; w.x = pk2(v[j][0], v[j][1]); w.y = pk2(v[j][2], v[j][3]); o[64 * j] = w; }
    if (dst8) { GAS unsigned* o8 = (GAS unsigned*)dst8 + lane;
#pragma unroll
        for (int j = 0; j < 8; ++j) o8[64 * j] = pk4_fp8(v[j][0], v[j][1], v[j][2], v[j][3]); }
}

namespace att {
constexpr int SHM_V = 64 * 128 * 2, SHM_K = 64 * 128 * 2;
constexpr int OFF_V = 0, OFF_K = 2 * SHM_V, OFF_WS = OFF_K + 2 * SHM_K, OFF_TBL = OFF_WS + NWAVES * 64 * 4, ATT_LDS = OFF_TBL + 1280;
static_assert(ATT_LDS <= RING_BYTES, "attention LDS");
#define KSWZ(row, colB) ((row) * 256 + ((colB) ^ (((row) & 15) << 4)))
__device__ __forceinline__ int v_st(int k, int c) { const int kk = (k & ~0xC) | ((k & 4) << 1) | ((k & 8) >> 1); return ((kk >> 3) * 4 + (c >> 5)) * 512 + ((kk & 7) * 32 + (c & 31)) * 2; }
__device__ __forceinline__ int v_rd_base(int lane) { return ((lane & 3) << 3) | (((lane >> 2) & 3) << 6) | (((lane >> 4) & 1) << 5) | (((lane >> 5) & 1) << 8); }
constexpr int v_rd_off(int d0, int ks, int half) { return d0 * 512 + ks * 4096 + half * 2048; }
__device__ __forceinline__ int crow(int r, int hi) { return (r & 3) + 8 * (r >> 2) + 4 * hi; }

template <int KB>
__device__ __forceinline__ void qkt(f32x16& p0, f32x16& p1, LAS const char* K_lds, int r32, int hi, const bf16x8* qr) {
    p0 = f32x16{}; p1 = f32x16{};
#pragma unroll
    for (int d0 = 0; d0 < 8; ++d0) { LAS const char* a = K_lds + KB * SHM_K + KSWZ(r32, (d0 * 16 + hi * 8) * 2);
        const bf16x8 b0 = *(LAS const bf16x8*)a;
        const bf16x8 b1 = *(LAS const bf16x8*)(a + 32 * 256);
        p0 = __builtin_amdgcn_mfma_f32_32x32x16_bf16(b0, qr[d0], p0, 0, 0, 0);
        p1 = __builtin_amdgcn_mfma_f32_32x32x16_bf16(b1, qr[d0], p1, 0, 0, 0); }
}
template <int VB>
__device__ __forceinline__ void pv_tile(f32x16* o, int vb0, bf16x8 pa0, bf16x8 pa1, bf16x8 pa2, bf16x8 pa3) {
#define TRRD(dst, off) asm volatile("ds_read_b64_tr_b16 %0, %1 offset:%2" : "=&v"(dst) : "v"(vb0), "i"(off) : "memory")
#define PV_D0(d0) do { s16x4 l0, l1, l2, l3, h0, h1, h2, h3; constexpr int b_ = OFF_V + VB * SHM_V + v_rd_off(d0, 0, 0); \
        TRRD(l0, b_); TRRD(h0, b_ + 2048); TRRD(l1, b_ + 4096); TRRD(h1, b_ + 6144); TRRD(l2, b_ + 8192); TRRD(h2, b_ + 10240); TRRD(l3, b_ + 12288); TRRD(h3, b_ + 14336); \
        asm volatile("s_waitcnt lgkmcnt(0)" ::: "memory"); __builtin_amdgcn_sched_barrier(0); \
        o[d0] = __builtin_amdgcn_mfma_f32_32x32x16_bf16((bf16x8){l0[0], l0[1], l0[2], l0[3], h0[0], h0[1], h0[2], h0[3]}, pa0, o[d0], 0, 0, 0);   \
        o[d0] = __builtin_amdgcn_mfma_f32_32x32x16_bf16((bf16x8){l1[0], l1[1], l1[2], l1[3], h1[0], h1[1], h1[2], h1[3]}, pa1, o[d0], 0, 0, 0);   \
        o[d0] = __builtin_amdgcn_mfma_f32_32x32x16_bf16((bf16x8){l2[0], l2[1], l2[2], l2[3], h2[0], h2[1], h2[2], h2[3]}, pa2, o[d0], 0, 0, 0);   \
        o[d0] = __builtin_amdgcn_mfma_f32_32x32x16_bf16((bf16x8){l3[0], l3[1], l3[2], l3[3], h3[0], h3[1], h3[2], h3[3]}, pa3, o[d0], 0, 0, 0); } while (0)
    PV_D0(0); PV_D0(1); PV_D0(2); PV_D0(3);
#undef PV_D0
#undef TRRD
}

__device__ __forceinline__ void attn_unit(LAS char* lds, const bf16_t* Qp, int qstride, const bf16_t* Kp, const bf16_t* Vp, int kvstride, unsigned char* Op,
                                          int T_lo, int T_hi, int cbase, int nact, bool smp, const float* relb, const int wv) {
    int tid = wv * 64 + lane_id(); asm volatile("" : "+v"(tid));
    const int wid = __builtin_amdgcn_readfirstlane(tid >> 6), lane = tid & 63, r32 = lane & 31, hi = lane >> 5;
    const bool wact = wid < nact;
    const int cw = cbase + (wid >> 1);
    LAS char* V_lds = lds + OFF_V; LAS char* K_lds = lds + OFF_K;
    LAS float* wsc = (LAS float*)(lds + OFF_WS) + wid * 64; LAS float* li_l = wsc; LAS float* al_l = wsc + 32;
    LAS float* tbl = (LAS float*)(lds + OFF_TBL);
    const int sr = tid >> 4, sc = (tid & 15) * 8, vst0 = v_st(sr, sc), vst1 = v_st(32 + sr, sc), kws = KSWZ(sr, sc * 2);
    const int vb0 = (int)(uintptr_t)lds + v_rd_base(lane);
    bf16x8 qr[8];
    if (wact) {
#pragma unroll
        for (int d0 = 0; d0 < 8; ++d0) qr[d0] = *(const bf16x8*)(Qp + (size_t)(wid * 32 + r32) * qstride + d0 * 16 + hi * 8);
    } else {
#pragma unroll
        for (int d0 = 0; d0 < 8; ++d0) qr[d0] = bf16x8{};
    }
    float m_reg = -1e30f, l_reg = 0.f; f32x16 o[4] = {};
    bf16x8 st_k0[2], st_k1[2], st_v0[2], st_v1[2];
#define ATT_LOAD(T, S) do { const size_t k0_ = (size_t)(T) * 64; \
        st_k0[S] = *(const bf16x8*)(Kp + (k0_ + sr) * kvstride + sc); st_k1[S] = *(const bf16x8*)(Kp + (k0_ + 32 + sr) * kvstride + sc); \
        st_v0[S] = *(const bf16x8*)(Vp + (k0_ + sr) * kvstride + sc); st_v1[S] = *(const bf16x8*)(Vp + (k0_ + 32 + sr) * kvstride + sc); } while (0)
#define ATT_WRITE(bf, S) do { *(LAS bf16x8*)(K_lds + (bf) * SHM_K + kws) = st_k0[S]; *(LAS bf16x8*)(K_lds + (bf) * SHM_K + kws + 32 * 256) = st_k1[S]; \
        *(LAS bf16x8*)(V_lds + (bf) * SHM_V + vst0) = st_v0[S]; *(LAS bf16x8*)(V_lds + (bf) * SHM_V + vst1) = st_v1[S]; } while (0)
    ATT_LOAD(T_lo, 0);
    if (T_lo + 1 < T_hi) ATT_LOAD(T_lo + 1, 1);
    __syncthreads();
    if (tid < 320) tbl[tid] = tid < NREL ? (relb[tid] - relb[NREL - 1]) * LOG2E : 0.f;
    ATT_WRITE(0, 0);
    __syncthreads();
    const int qi = 32 * (wid & 1) + r32;
#define ATT_STEP(T, BUF) do { \
        if ((T) + 2 < T_hi) ATT_LOAD((T) + 2, BUF); \
        if (wact && (T) >= cw - 8 && (T) <= cw) { \
            const int jt = (T) - (cw - 8); f32x16 p0, p1; \
            qkt<BUF>(p0, p1, K_lds, r32, hi, qr); \
            if (jt >= 6) { LAS const float* tp_ = tbl + (qi + 512 - 64 * jt - 4 * hi + 128 - 59);        \
                _Pragma("unroll") for (int r4 = 0; r4 < 4; ++r4) { \
                    _Pragma("unroll") for (int rr_ = 0; rr_ < 4; ++rr_) { const int r = 4 * r4 + rr_; const int c_ = (r & 3) + 8 * (r >> 2); \
                        p0[r] += tp_[59 - c_]; p1[r] += tp_[27 - c_]; } \
                    asm volatile("" ::: "memory"); } } \
            if (smp && (T) == 8) { asm volatile("" ::: "memory"); _Pragma("unroll") for (int r = 0; r < 16; ++r) p1[r] = -__builtin_inff(); }     \
            float pmax = p0[0]; \
            _Pragma("unroll") for (int r = 1; r < 16; ++r) pmax = fmaxf(pmax, p0[r]); \
            _Pragma("unroll") for (int r = 0; r < 16; ++r) pmax = fmaxf(pmax, p1[r]); \
            pmax = fmaxf(pmax, shx(pmax, 32)); \
            const float mn = (pmax - m_reg > 8.f) ? pmax : m_reg, alpha = __builtin_amdgcn_exp2f(m_reg - mn); m_reg = mn;     \
            float ps = 0.f; \
            _Pragma("unroll") for (int r = 0; r < 16; ++r) { p0[r] = __builtin_amdgcn_exp2f(p0[r] - mn); p1[r] = __builtin_amdgcn_exp2f(p1[r] - mn); ps += p0[r] + p1[r]; } \
            ps += shx(ps, 32); l_reg = l_reg * alpha + ps; \
            bf16x8 pa0, pa1, pa2, pa3; \
            ATT_PK4(p0, 0, pa0); ATT_PK4(p0, 8, pa1); ATT_PK4(p1, 0, pa2); ATT_PK4(p1, 8, pa3); \
            if (__any(alpha < 1.f)) { _Pragma("unroll") for (int d_ = 0; d_ < 4; ++d_) _Pragma("unroll") for (int r = 0; r < 16; ++r) o[d_][r] *= alpha; }     \
            pv_tile<BUF>(o, vb0, pa0, pa1, pa2, pa3); \
        } \
        if ((T) + 1 < T_hi) ATT_WRITE((BUF) ^ 1, (BUF) ^ 1); \
        __syncthreads(); } while (0)
#define ATT_PK4(P, B_, OUT) do { unsigned a0 = cvt_pk_bf16(P[B_+0], P[B_+1]), a1 = cvt_pk_bf16(P[B_+2], P[B_+3]);                          \
        unsigned b0 = cvt_pk_bf16(P[B_+4], P[B_+5]), b1 = cvt_pk_bf16(P[B_+6], P[B_+7]);                                             \
        auto r0 = __builtin_amdgcn_permlane32_swap(a0, b0, false, false); auto r1 = __builtin_amdgcn_permlane32_swap(a1, b1, false, false); \
        u32x4 w = {r0[0], r1[0], r0[1], r1[1]}; OUT = __builtin_bit_cast(bf16x8, w); } while (0)
    for (int T = T_lo; T < T_hi; T += 2) {
        ATT_STEP(T, 0);
        if (T + 1 < T_hi) ATT_STEP(T + 1, 1);
    }
#undef ATT_STEP
#undef ATT_PK4
#undef ATT_LOAD
#undef ATT_WRITE
    if (wact) {
        float ko = O8_SCALE; asm volatile("" : "+s"(ko));
        const float rli = ko * __builtin_amdgcn_rcpf(l_reg);
        int r32o = r32, hio = hi; asm volatile("" : "+v"(r32o), "+v"(hio));
        unsigned char* orow = Op + (size_t)((unsigned)(wid * 32 + r32o) * (unsigned)D + (unsigned)(16 * hio));
#pragma unroll
        for (int d0 = 0; d0 < 4; ++d0) {
            unsigned dw[4];
#pragma unroll
            for (int g = 0; g < 4; ++g) dw[g] = pk4_fp8(o[d0][4 * g] * rli, o[d0][4 * g + 1] * rli, o[d0][4 * g + 2] * rli, o[d0][4 * g + 3] * rli);
            const auto s02 = __builtin_amdgcn_permlane32_swap(dw[0], dw[2], false, false);
            const auto s13 = __builtin_amdgcn_permlane32_swap(dw[1], dw[3], false, false);
            const u32x4 w = {s02[0], s02[1], s13[0], s13[1]};
            *(u32x4*)(orow + d0 * 32) = w;
        }
    }
}
}

__device__ __forceinline__ void smem_attn_unit(LAS char* lds, const bf16_t* Q  , const bf16_t* Kc  ,
                                                const bf16_t* Vt  , unsigned char* O  , const int wv, const int half  ) {
    int tid = wv * 64 + lane_id(); asm volatile("" : "+v"(tid));
    const int wid = __builtin_amdgcn_readfirstlane(tid >> 6), lane = tid & 63, r32 = lane & 31, hi = lane >> 5;
    LAS float* smax = (LAS float*)lds;
    LAS float* ssum = smax + 256;
    LAS bf16_t* Pl = (LAS bf16_t*)(lds + 2048);
    constexpr int PLD = 264;
    LAS char* Ql = lds + 32768;
    f32x16 s = {};
    const bf16_t* kp = Kc + (size_t)(32 * wid + r32) * D + hi * 8;
    bf16x8 kf[32];
#pragma unroll
    for (int ks = 0; ks < 32; ++ks) kf[ks] = *(const bf16x8*)(kp + ks * 16);
    bf16x8 qst[4];
    { const int qr_ = tid >> 4, qc_ = tid & 15;
#pragma unroll
        for (int j = 0; j < 4; ++j) qst[j] = *(const bf16x8*)(Q + (size_t)qr_ * D + (qc_ + 16 * j) * 8);
        __syncthreads();
#pragma unroll
        for (int j = 0; j < 4; ++j) *(LAS bf16x8*)(Ql + qr_ * 1024 + (((qc_ + 16 * j) ^ (qr_ & 15)) << 4)) = qst[j];
    }
    __syncthreads();
#pragma unroll
    for (int ks = 0; ks < 32; ++ks) { const bf16x8 b = *(LAS const bf16x8*)(Ql + r32 * 1024 + (((2 * ks + hi) ^ (r32 & 15)) << 4));
        s = __builtin_amdgcn_mfma_f32_32x32x16_bf16(kf[ks], b, s, 0, 0, 0); }
    const bf16_t* v0 = Vt + (size_t)(256 * half + 32 * wid + r32) * 256 + hi * 8;
    bf16x8 vf0[16];
#pragma unroll
    for (int ks = 0; ks < 16; ++ks) vf0[ks] = *(const bf16x8*)(v0 + ks * 16);
    constexpr float C2 = 0.04419417382415922f * LOG2E;
    float pmax = s[0];
#pragma unroll
    for (int r = 1; r < 16; ++r) pmax = fmaxf(pmax, s[r]);
    pmax = fmaxf(pmax, shx(pmax, 32));
    if (hi == 0) smax[wid * 32 + r32] = pmax;
    __syncthreads();
    float gm = smax[r32];
#pragma unroll
    for (int w = 1; w < 8; ++w) gm = fmaxf(gm, smax[w * 32 + r32]);
    float ps = 0.f;
#pragma unroll
    for (int r = 0; r < 16; ++r) { s[r] = __builtin_amdgcn_exp2f((s[r] - gm) * C2); ps += s[r]; }
    ps += shx(ps, 32);
    if (hi == 0) ssum[wid * 32 + r32] = ps;
    __syncthreads();
    float tot = 0.f;
#pragma unroll
    for (int w = 0; w < 8; ++w) tot += ssum[w * 32 + r32];
    const float inv = 1.0f / tot;
#pragma unroll
    for (int r = 0; r < 16; ++r) Pl[r32 * PLD + 32 * wid + att::crow(r, hi)] = (bf16_t)f2bf(s[r] * inv);
    __syncthreads();
    f32x16 o0 = {};
#pragma unroll
    for (int ks = 0; ks < 16; ++ks) { const bf16x8 a = *(LAS const bf16x8*)(Pl + r32 * PLD + ks * 16 + hi * 8);
        o0 = __builtin_amdgcn_mfma_f32_32x32x16_bf16(vf0[ks], a, o0, 0, 0, 0); }
    {
        unsigned char* orow = O + (size_t)r32 * D + 256 * half + 32 * wid + 16 * hi;
#pragma unroll
        for (int blk = 0; blk < 1; ++blk) { const f32x16& oo = o0; unsigned dw[4];
#pragma unroll
            for (int g = 0; g < 4; ++g) dw[g] = pk4_fp8(oo[4 * g] * O8_SCALE, oo[4 * g + 1] * O8_SCALE, oo[4 * g + 2] * O8_SCALE, oo[4 * g + 3] * O8_SCALE);
            const auto s02 = __builtin_amdgcn_permlane32_swap(dw[0], dw[2], false, false);
            const auto s13 = __builtin_amdgcn_permlane32_swap(dw[1], dw[3], false, false);
            const u32x4 w = {s02[0], s02[1], s13[0], s13[1]};
            *(u32x4*)(orow + 32 * blk) = w; }
    }
}


namespace sk {
struct SUnit { int cb, rb; };
struct SPre { float mu, rs; f32x4 q0, q1, q2, q3; };
template <bool UNEVEN = false>
__device__ __forceinline__ bool next_unit(int i, int ncb, int G, int bx, SUnit& u) {
    const int x = bx & 7, rank = bx >> 3, per = G >> 3, e = rank + i * per;
    if (UNEVEN) { const int j = e >> 3, lim = (x & 1) ? 8 : 16; if (j >= lim) return false; u.cb = 24 * (x >> 1) + ((x & 1) ? 16 : 0) + j; u.rb = e & 7; return true; }
    const int cb = x + 8 * (e >> 3);
    if (cb >= ncb) return false; u.cb = cb; u.rb = e & 7; return true;
}
__device__ __forceinline__ void row_stats(const float* sst, int rl, bool idn, float& mu, float& rs) {
    if (idn) { mu = 0.f; rs = 1.f; return; }
    const f32x4* p = (const f32x4*)(sst + (size_t)rl * 64); float s = 0.f, q = 0.f;
#pragma unroll
    for (int t = 0; t < 16; ++t) { const f32x4 v = p[t]; s += v[0] + v[2]; q += v[1] + v[3]; }
    mu = s * (1.f / D); rs = __builtin_amdgcn_rsqf(q * (1.f / D) - mu * mu + LN_EPS);
}
template <int MODE, bool FP8 = false, bool UNEVEN = false, class Epi>
__device__ __forceinline__ void skinny_phase(LAS char* lds, const int wv, const bf16_t* A  , int lda, const bf16_t* Bt, int ldb, int K, int ncb, int G, int bx, const Epi& E) {
    int tid = wv * 64 + lane_id(); asm volatile("" : "+v"(tid));
    const int wid = __builtin_amdgcn_readfirstlane(tid >> 6), lane = tid & 63, r32 = lane & 31, hi = lane >> 5;
    const int ngrp = K >> 6, g0 = (wid * ngrp) >> 3, g1 = ((wid + 1) * ngrp) >> 3, klo = g0 * 64, ksl = (g1 - g0) * 64;
    LAS f32x4* part = (LAS f32x4*)lds;
    constexpr int PF = FP8 ? 2 : 1;
    bf16x8 pa[PF][4], pb0[PF][4], pb1[PF][4];
#define SK_PTRS(u_) const int j1_ = ((u_).cb & 3) * 32 + r32; const int brow0_ = (MODE == 1) ? (((u_).cb >> 2) * 256 + 64 * (j1_ >> 5) + (j1_ & 31)) : ((u_).cb * 64 + r32), brow1_ = brow0_ + 32; \
        const bf16_t* ap = A + (size_t)((u_).rb * 32 + r32) * lda + klo + 8 * hi + ((MODE == 2) ? 512 * ((u_).cb >> 3) : 0); \
        const bf16_t* b0p = Bt + (size_t)brow0_ * ldb + klo + 8 * hi; const bf16_t* b1p = Bt + (size_t)brow1_ * ldb + klo + 8 * hi;
#define SK_PREFETCH_A() _Pragma("unroll") for (int g = 0; g < PF; ++g) if (g * 64 < ksl) { _Pragma("unroll") for (int s = 0; s < 4; ++s) pa[g][s] = *(const bf16x8*)(ap + g * 64 + 16 * s); }
#define SK_PREFETCH_B() _Pragma("unroll") for (int g = 0; g < PF; ++g) if (g * 64 < ksl) { _Pragma("unroll") for (int s = 0; s < 4; ++s) { \
            pb0[g][s] = *(const bf16x8*)(b0p + g * 64 + 16 * s); pb1[g][s] = *(const bf16x8*)(b1p + g * 64 + 16 * s); } }
    constexpr bool AREG = FP8 && MODE == 1;
#define SK_CAT8(x0, x1) __builtin_shufflevector(__builtin_bit_cast(i32x4, x0), __builtin_bit_cast(i32x4, x1), 0, 1, 2, 3, 4, 5, 6, 7)
#define SK_MMA(a, b0, b1) do { if constexpr (FP8) { _Pragma("unroll") for (int s = 0; s < 4; s += 2) { \
            acc0 = __builtin_amdgcn_mfma_scale_f32_32x32x64_f8f6f4(SK_CAT8(b0[s], b0[s + 1]), SK_CAT8(a[s], a[s + 1]), acc0, 0, 0, 0, 0x7f7f7f7f, 0, 0x7f7f7f7f); \
            acc1 = __builtin_amdgcn_mfma_scale_f32_32x32x64_f8f6f4(SK_CAT8(b1[s], b1[s + 1]), SK_CAT8(a[s], a[s + 1]), acc1, 0, 0, 0, 0x7f7f7f7f, 0, 0x7f7f7f7f); } } \
        else { _Pragma("unroll") for (int s = 0; s < 4; ++s) { acc0 = __builtin_amdgcn_mfma_f32_32x32x16_bf16(b0[s], a[s], acc0, 0, 0, 0); acc1 = __builtin_amdgcn_mfma_f32_32x32x16_bf16(b1[s], a[s], acc1, 0, 0, 0); } } } while (0)
    SUnit u; bool have = next_unit<UNEVEN>(0, ncb, G, bx, u);
    LAS float* stab = (LAS float*)(lds + 65536);
    if (have) { SK_PTRS(u) SK_PREFETCH_A() SK_PREFETCH_B()
        if (tid < 32) { float mu_, rs_; row_stats(E.stat_src(), u.rb * 32 + tid, E.stat_idn(), mu_, rs_); stab[2 * tid] = mu_; stab[2 * tid + 1] = rs_; }
        __syncthreads(); }
    for (int i = 0; have; ++i) {
        SUnit un; const bool hn = next_unit<UNEVEN>(i + 1, ncb, G, bx, un);
        const int n = tid & 31, m4 = (tid >> 5) & 7, blk = tid >> 8;
        const SPre P = E.pre(u, n, m4, blk, stab);
        f32x16 acc0 = {}, acc1 = {};
#pragma unroll
        for (int g = 0; g < PF; ++g) if (g * 64 < ksl) SK_MMA(pa[g], pb0[g], pb1[g]);
        if (!AREG && ksl > PF * 64) { SK_PTRS(u)
#pragma unroll 1
            for (int k = PF * 64; k < ksl; k += PF * 64) {
#pragma unroll
                for (int g = 0; g < PF; ++g) if (g == 0 || k + g * 64 < ksl) {
#pragma unroll
                    for (int s = 0; s < 4; ++s) { pa[g][s] = *(const bf16x8*)(ap + k + g * 64 + 16 * s); pb0[g][s] = *(const bf16x8*)(b0p + k + g * 64 + 16 * s); pb1[g][s] = *(const bf16x8*)(b1p + k + g * 64 + 16 * s); } }
#pragma unroll
                for (int g = 0; g < PF; ++g) if (g == 0 || k + g * 64 < ksl) SK_MMA(pa[g], pb0[g], pb1[g]); } }
        if (hn) { SK_PTRS(un) if (!AREG) { SK_PREFETCH_A() } SK_PREFETCH_B() }
        __syncthreads();
#pragma unroll
        for (int r4 = 0; r4 < 4; ++r4) { const int m4w = 2 * r4 + hi;
            part[((wid * 2 + 0) * 8 + m4w) * 32 + r32] = (f32x4){acc0[4 * r4], acc0[4 * r4 + 1], acc0[4 * r4 + 2], acc0[4 * r4 + 3]};
            part[((wid * 2 + 1) * 8 + m4w) * 32 + r32] = (f32x4){acc1[4 * r4], acc1[4 * r4 + 1], acc1[4 * r4 + 2], acc1[4 * r4 + 3]}; }
        __syncthreads();
        f32x4 v0 = part[((0 * 2 + blk) * 8 + m4) * 32 + n], v1 = {0.f, 0.f, 0.f, 0.f};
#pragma unroll
        for (int w = 1; w < 8; ++w) v0 += part[((w * 2 + blk) * 8 + m4) * 32 + n];
        if (MODE == 1) { v1 = part[((0 * 2 + 1) * 8 + m4) * 32 + n];
#pragma unroll
            for (int w = 1; w < 8; ++w) v1 += part[((w * 2 + 1) * 8 + m4) * 32 + n]; }
        E(v0, v1, P, u, n, m4, blk, tid);
        u = un; have = hn;
    }
#undef SK_PTRS
#undef SK_PREFETCH_A
#undef SK_PREFETCH_B
#undef SK_CAT8
#undef SK_MMA
}
struct SEpiNone {
    __device__ __forceinline__ const float* stat_src() const { return nullptr; } __device__ __forceinline__ bool stat_idn() const { return true; }
    __device__ __forceinline__ SPre pre(const SUnit& u, int n, int m4, int blk, LAS const float* stab) const { SPre P = {}; return P; }
    __device__ __forceinline__ void operator()(f32x4 v, f32x4 v1, const SPre& P, const SUnit& u, int n, int m4, int blk, int tid) const { asm volatile("" :: "v"(v), "v"(v1)); }
};
struct SEpiQKV {
    const float* sst; bool idn; const float* uvec; const float* cvec; bf16_t* qkv; bf16_t* kvs; float* oks;
    __device__ __forceinline__ const float* stat_src() const { return sst; } __device__ __forceinline__ bool stat_idn() const { return idn; }
    __device__ __forceinline__ SPre pre(const SUnit& u, int n, int m4, int blk, LAS const float* stab) const { SPre P = {}; const int rl = u.rb * 32 + n, col = u.cb * 64 + 32 * blk + 4 * m4;
        if (!idn) { P.q0 = *(const f32x4*)(uvec + col); P.q1 = *(const f32x4*)(cvec + col); } P.mu = stab[2 * n]; P.rs = stab[2 * n + 1]; return P; }
    __device__ __forceinline__ void operator()(f32x4 v, f32x4, const SPre& P, const SUnit& u, int n, int m4, int blk, int tid) const {
        const int rl = u.rb * 32 + n, col = u.cb * 64 + 32 * blk + 4 * m4, which = col >> 11;
        if (!idn) v = (v - P.q0 * P.mu) * P.rs + P.q1;
        if (!which) v = v * QSCALE;
        u32x2 w; w.x = cvt_pk_bf16(v[0], v[1]); w.y = cvt_pk_bf16(v[2], v[3]);
        *(u32x2*)(qkv + (size_t)(MP + rl) * 6144 + col) = w;
        if (which) { const int colh = col - 2048 * which, b = rl >> 5, t = rl & 31;
            *(u32x2*)(kvs + ((size_t)((which - 1) * SBAT + b) * KVROWS + 512 + t) * D + colh) = w;
            *(f32x4*)(oks + (size_t)(which - 1) * (O_AVS - O_AKS) + (size_t)rl * D + colh) = v; }
    }
};
struct SEpiLin {
    const float* sst; const float* uvec; const float* cvec; bf16_t* out; float ascale;
    __device__ __forceinline__ const float* stat_src() const { return sst; } __device__ __forceinline__ bool stat_idn() const { return false; }
    __device__ __forceinline__ SPre pre(const SUnit& u, int n, int m4, int blk, LAS const float* stab) const { SPre P = {}; const int rl = u.rb * 32 + n, col = u.cb * 64 + 32 * blk + 4 * m4;
        P.q0 = *(const f32x4*)(uvec + col); P.q1 = *(const f32x4*)(cvec + col); P.mu = stab[2 * n]; P.rs = stab[2 * n + 1]; return P; }
    __device__ __forceinline__ void operator()(f32x4 v, f32x4, const SPre& P, const SUnit& u, int n, int m4, int blk, int tid) const {
        const int rl = u.rb * 32 + n, col = u.cb * 64 + 32 * blk + 4 * m4;
        v = (v * ascale - P.q0 * P.mu) * P.rs + P.q1;
        u32x2 w; w.x = cvt_pk_bf16(v[0], v[1]); w.y = cvt_pk_bf16(v[2], v[3]);
        *(u32x2*)(out + (size_t)(MP + rl) * D + col) = w;
    }
};
struct SEpiFfnIn {
    const float* sst; const float* uvec; const float* cvec; unsigned char* H;
    __device__ __forceinline__ const float* stat_src() const { return sst; } __device__ __forceinline__ bool stat_idn() const { return false; }
    __device__ __forceinline__ SPre pre(const SUnit& u, int n, int m4, int blk, LAS const float* stab) const { SPre P = {}; const int rl = u.rb * 32 + n, j0 = (u.cb & 3) * 32 + 4 * m4, rg = (u.cb >> 2) * 256 + 64 * (j0 >> 5) + (j0 & 31), ru = rg + 32;
        P.q0 = *(const f32x4*)(uvec + rg); P.q1 = *(const f32x4*)(cvec + rg); P.q2 = *(const f32x4*)(uvec + ru); P.q3 = *(const f32x4*)(cvec + ru); P.mu = stab[2 * n]; P.rs = stab[2 * n + 1]; return P; }
    __device__ __forceinline__ void operator()(f32x4 g, f32x4 up, const SPre& P, const SUnit& u, int n, int m4, int blk, int tid) const {
        if (blk) return;
        const int rl = u.rb * 32 + n;
        float kw = W8_INV, kh = H8_SCALE, lim = 448.f; asm volatile("" : "+s"(kw), "+s"(kh), "+v"(lim));
        const float nlim = -lim;
        g = (g * kw - P.q0 * P.mu) * P.rs + P.q1; up = ((up * kw - P.q2 * P.mu) * P.rs + P.q3) * kh;
        f32x4 h;
#pragma unroll
        for (int e = 0; e < 4; ++e) h[e] = __builtin_amdgcn_fmed3f(g[e] * up[e] * __builtin_amdgcn_rcpf(1.0f + __builtin_amdgcn_exp2f(-g[e] * LOG2E)), nlim, lim);
        *(unsigned*)(H + (size_t)(MP + rl) * DFF + u.cb * 32 + 4 * m4) = pk4_fp8(h[0], h[1], h[2], h[3]);
    }
};
template <bool POOL, bool Z8 = false> struct SEpiRes {
    const float* sst_old; float* sst_new; bool idn; const float* xs; half_t* zf; bf16_t* zb; const float* g; const float* b; const float* psc; LAS f32x2* red; float ascale; half_t* zfo;
    __device__ __forceinline__ const float* stat_src() const { return sst_old; } __device__ __forceinline__ bool stat_idn() const { return idn; }
    __device__ __forceinline__ SPre pre(const SUnit& u, int n, int m4, int blk, LAS const float* stab) const { SPre P = {}; const int rl = u.rb * 32 + n, row = MP + rl, col = u.cb * 64 + 32 * blk + 4 * m4;
        P.q0 = idn ? *(const f32x4*)(xs + (size_t)rl * D + col) : unpack4h(*(const u32x2*)(zf + (size_t)row * D + col));
        if (!idn) { P.q1 = *(const f32x4*)(g + col); P.q2 = *(const f32x4*)(b + col); }
        if (POOL) P.q3 = *(const f32x4*)(psc + col);
        P.mu = stab[2 * n]; P.rs = stab[2 * n + 1]; return P; }
    __device__ __forceinline__ void operator()(f32x4 a, f32x4, const SPre& P, const SUnit& u, int n, int m4, int blk, int tid) const {
        const int rl = u.rb * 32 + n, row = MP + rl, col = u.cb * 64 + 32 * blk + 4 * m4;
        a = a * ascale;
        if (POOL) a = a * P.q3;
        f32x4 v;
        if (idn) v = P.q0 * ALPHA + a; else v = ((P.q0 - P.mu) * P.rs * P.q1 + P.q2) * ALPHA + a;
        { u32x2 wh; wh.x = pk2h(v[0], v[1]); wh.y = pk2h(v[2], v[3]); *(u32x2*)(zfo + (size_t)row * D + col) = wh; }
        if (Z8) *(unsigned*)((unsigned char*)zb + (size_t)row * D + col) = pk4_fp8(v[0], v[1], v[2], v[3]);
        else { u32x2 w; w.x = cvt_pk_bf16(v[0], v[1]); w.y = cvt_pk_bf16(v[2], v[3]); *(u32x2*)(zb + (size_t)row * D + col) = w; }
        red[(m4 + 8 * blk) * 32 + n] = (f32x2){(v[0] + v[1]) + (v[2] + v[3]), (v[0] * v[0] + v[1] * v[1]) + (v[2] * v[2] + v[3] * v[3])};
        __syncthreads();
        if (tid < 32) { f32x2 t = red[tid];
#pragma unroll
            for (int j = 1; j < 16; ++j) t += red[j * 32 + tid];
            *(f32x2*)(sst_new + (size_t)(u.rb * 32 + tid) * 64 + u.cb * 2) = t; }
    }
};
}

struct Args { const float* in[20]; float* out; unsigned char* ws; };
enum { I_XP = 0, I_XS, I_CAK, I_CAV, I_SPOOL, I_CMK, I_CMV, I_MEMP, I_WQKV, I_WAO, I_RELB, I_WPOOL, I_PSC, I_WMQ, I_WMKV, I_WMO, I_WFI, I_WFO, I_LNG, I_LNB };

__global__ void __launch_bounds__(NTHR, 2) mk_fwd(Args args) {
    extern __shared__ __attribute__((aligned(16))) unsigned char lds_raw[];
    LAS unsigned char* lds = (LAS unsigned char*)lds_raw;
    const int G = gridDim.x, bx = blockIdx.x;
    const bool skf = ((blockIdx.x >> 3) & 1) != 0;
    const int wv = __builtin_amdgcn_readfirstlane((int)(threadIdx.x >> 6));
#define PHASE_IDS int tid = wv * 64 + lane_id(); asm volatile("" : "+v"(tid)); const int lane = tid & 63, wave = wv; (void)lane; (void)wave;
#define CAS __attribute__((address_space(4)))
#define PHASE_PTRS CAS const char* ka_ = (CAS const char*)__builtin_amdgcn_kernarg_segment_ptr(); asm volatile("" : "+s"(ka_)); \
    unsigned char* const ws = *(unsigned char* const CAS*)(ka_ + 168); float* const out = *(float* const CAS*)(ka_ + 160); (void)out; \
    float* const vec = (float*)(ws + WS_CTL); (void)vec;
#define IN(k) (((const float* const CAS*)ka_)[k])
#define wqkv ((bf16_t*)(ws + WS_WQKV))
#define wqkv8 (ws + WS_WQKV8)
#define wao (ws + WS_WAO)
#define wpool ((bf16_t*)(ws + WS_WPOOL))
#define wmq (ws + WS_WMQ)
#define wmkv ((bf16_t*)(ws + WS_WMKV))
#define wmo (ws + WS_WMO)
#define wfi (ws + WS_WFI)
#define wfo (ws + WS_WFO)
#define z8 (ws + WS_Z8)
#define zf ((half_t*)(ws + WS_ZF))
#define zb ((bf16_t*)(ws + WS_ZB))
#define qkv ((bf16_t*)(ws + WS_BIG))
#define qm ((bf16_t*)(ws + WS_QM))
#define Sb ((float*)(ws + WS_S))
#define Pb ((bf16_t*)(ws + WS_P))
#define Hb (ws + WS_H)
#define ob ((bf16_t*)(ws + WS_OB))
#define ob8 (ws + WS_OB)
#define kvs ((bf16_t*)(ws + WS_KVS))
#define mks ((bf16_t*)(ws + WS_MKS))
#define mvts ((bf16_t*)(ws + WS_MVTS))
#define memb ((bf16_t*)(ws + WS_MEMB))
#define mkp ((bf16_t*)(ws + WS_MKP))
#define mk8 (ws + WS_MK8)
#define mv8 (ws + WS_MV8)
#define wqr8 (ws + WS_WQR8)
#define w1 (ws + WS_W1)
#define w2 (ws + WS_W2)
#define Pb8 (ws + WS_P)
#define mvtp ((bf16_t*)(ws + WS_MVTP))
#define stA ((float*)(ws + WS_ST))
#define stB ((float*)(ws + WS_ST + ST_BYTES))
#define sstA ((float*)(ws + WS_SST))
#define sstB ((float*)(ws + WS_SST + SST_BYTES))
#define lng IN(I_LNG)
#define lnb IN(I_LNB)
    static_assert(sizeof(Args) == 176, "kernarg layout: in[20] at 0, out at 160, ws at 168");
    volatile LAS unsigned* misc = (volatile LAS unsigned*)(lds + MISC_OFF);
    if (threadIdx.x < 64) misc[threadIdx.x] = 0u;
    __syncthreads();
    const XcdBarrier bar = xcd_barrier_post((unsigned*)(args.ws + WS_CTL) + CW_BAR, misc + 8);
    LAS f32x2* const red = (LAS f32x2*)(lds + RED_OFF);
    LAS f32x2* const sred = (LAS f32x2*)(lds + RED_OFF);

    if (PH(0)) for (int rep_ = 0; rep_ < NREP(100); ++rep_) { PHASE_PTRS
        PHASE_IDS
        float* const vecw = rep_ ? nullptr : vec;
        LAS float* scr = (LAS float*)(lds + wave * 16640);
        const int gw = bx * NWAVES + wave, NGW = G * NWAVES;
        constexpr int I_QKV = (D / 64) * (6144 / 64), I_SQ = (D / 64) * (D / 64), I_POOLG = (512 / 64) * (512 / 64), I_MKV = (D / 64) * (4096 / 64),
                      I_FI = (D / 64) * (2 * DFF / 64), I_FO = (DFF / 64) * (D / 64), I_CMVT = (256 / 64) * (D / 64);
        constexpr int N0 = 2 * I_QKV, N1 = N0 + 2 * I_SQ, N2 = N1 + 8 * I_POOLG, N3 = N2 + 4 * I_SQ, N4 = N3 + 4 * I_MKV, N5 = N4 + 4 * I_SQ, N6 = N5 + 4 * I_FI,
                      N7 = N6 + 4 * I_FO, N8 = N7 + 32 * I_CMVT;
        for (int it = gw; it < N8; it += NGW) {
            if (it < N0) { const int l = it / I_QKV, r = it % I_QKV; const bool f = (l == 1);
                tr_item(IN(I_WQKV) + (size_t)l * D * 6144, D, 6144, 6144, wqkv + (size_t)l * 6144 * D, scr, r, lane, f ? lng + (1 * 3 + 2) * D : nullptr, f ? lnb + (1 * 3 + 2) * D : nullptr, vecw ? vecw + V_QKV_U : nullptr, vecw ? vecw + V_QKV_C : nullptr, false, false, wqkv8 + (size_t)l * 6144 * D, vecw ? vecw + V_QKV8_U : nullptr); }
            else if (it < N1) { const int l = (it - N0) / I_SQ, r = (it - N0) % I_SQ;
                tr_item(IN(I_WAO) + (size_t)l * D * D, D, D, D, (bf16_t*)(wao + (size_t)l * D * D), scr, r, lane, nullptr, nullptr, nullptr, nullptr, false, true); }
            else if (it < N2) { const int pg = (it - N1) / I_POOLG, r = (it - N1) % I_POOLG;
                tr_item(IN(I_WPOOL) + (size_t)pg * 512 * 512, 512, 512, 512, wpool + (size_t)pg * 512 * 512, scr, r, lane, nullptr, nullptr, nullptr, nullptr, false); }
            else if (it < N3) { const int l = (it - N2) / I_SQ, r = (it - N2) % I_SQ;
                tr_item(IN(I_WMQ) + (size_t)l * D * D, D, D, D, (bf16_t*)(wmq + (size_t)l * D * D), scr, r, lane, lng + (l * 3 + 0) * D, lnb + (l * 3 + 0) * D, vecw ? vecw + V_MQ_U + l * D : nullptr, vecw ? vecw + V_MQ_C + l * D : nullptr, false, true, nullptr, nullptr, wqr8 + (size_t)l * D * D); }
            else if (it < N4) { const int l = (it - N3) / I_MKV, r = (it - N3) % I_MKV;
                tr_item(IN(I_WMKV) + (size_t)l * D * 4096, D, 4096, 4096, wmkv + (size_t)l * 4096 * D, scr, r, lane, nullptr, nullptr, nullptr, nullptr, false); }
            else if (it < N5) { const int l = (it - N4) / I_SQ, r = (it - N4) % I_SQ;
                tr_item(IN(I_WMO) + (size_t)l * D * D, D, D, D, (bf16_t*)(wmo + (size_t)l * D * D), scr, r, lane, nullptr, nullptr, nullptr, nullptr, false, true); }
            else if (it < N6) { const int l = (it - N5) / I_FI, r = (it - N5) % I_FI;
                tr_item(IN(I_WFI) + (size_t)l * D * 2 * DFF, D, 2 * DFF, 2 * DFF, (bf16_t*)(wfi + (size_t)l * 2 * DFF * D), scr, r, lane, lng + (l * 3 + 1) * D, lnb + (l * 3 + 1) * D, vecw ? vecw + V_FI_U + l * 2 * DFF : nullptr, vecw ? vecw + V_FI_C + l * 2 * DFF : nullptr, true, true); }
            else if (it < N7) { const int l = (it - N6) / I_FO, r = (it - N6) % I_FO;
                tr_item(IN(I_WFO) + (size_t)l * DFF * D, DFF, D, D, (bf16_t*)(wfo + (size_t)l * D * DFF), scr, r, lane, nullptr, nullptr, nullptr, nullptr, false, true); }
            else { const int lb = (it - N7) / I_CMVT, r = (it - N7) % I_CMVT;
                tr_item(IN(I_CMV) + (size_t)lb * 256 * D, 256, D, D, mvts + (size_t)lb * D * 256, scr, r, lane, nullptr, nullptr, nullptr, nullptr, false); }
        }
        constexpr int R0 = MP, R1 = R0 + MS, R2 = R1 + NB * NMEM, R3 = R2 + 2 * SBAT * 512, R4 = R3 + 2 * SBAT * 512, R5 = R4 + 4 * SBAT * NMEM, R6 = R5 + 2 * 2 * SBAT * 32, R7 = R6;
        for (int rw = gw; rw < R7; rw += NGW) {
            if (rw < R0) { if (((rw >> 8) & 15) >= 14) cvt_row(IN(I_XP) + (size_t)rw * D, zb + (size_t)rw * D, lane, z8 + (size_t)rw * D); else cvt_row8(IN(I_XP) + (size_t)rw * D, z8 + (size_t)rw * D, lane); }
            else if (rw < R1) cvt_row(IN(I_XS) + (size_t)(rw - R0) * D, zb + (size_t)rw * D, lane);
            else if (rw < R2) cvt_row(IN(I_MEMP) + (size_t)(rw - R1) * D, memb + (size_t)(rw - R1) * D, lane);
            else if (rw < R3) { const int q = rw - R2, ab = q >> 9, t = q & 511, a = ab >> 3, b = ab & 7;
                cvt_row(IN(I_CAK) + (size_t)q * D, kvs + ((size_t)((a * 2 + 0) * SBAT + b) * KVROWS + t) * D, lane); }
            else if (rw < R4) { const int q = rw - R3, ab = q >> 9, t = q & 511, a = ab >> 3, b = ab & 7;
                cvt_row(IN(I_CAV) + (size_t)q * D, kvs + ((size_t)((a * 2 + 1) * SBAT + b) * KVROWS + t) * D, lane); }
            else if (rw < R5) { const int q = rw - R4; cvt_row(IN(I_CMK) + (size_t)q * D, mks + (size_t)q * D, lane); }
            else if (rw >= R6) { const int q = rw - R6, l = q >> 11, zd = q & 2047;
                const float sc = WQR_SCALE * lng[(size_t)(l * 3) * D + zd]; const GAS f32x4* s = (const GAS f32x4*)(IN(I_WMQ) + (size_t)q * D) + lane; GAS unsigned* o8 = (GAS unsigned*)(wqr8 + (size_t)q * D) + lane;
#pragma unroll
                for (int j = 0; j < 8; ++j) { const f32x4 v = s[64 * j] * sc; o8[64 * j] = pk4_fp8(v[0], v[1], v[2], v[3]); } }
            else { const int q = rw - R5, akb = q >> 5, t = q & 31;
                GAS u32x2* o = (GAS u32x2*)(kvs + ((size_t)akb * KVROWS + 544 + t) * D) + lane;
#pragma unroll
                for (int j = 0; j < 8; ++j) o[64 * j] = (u32x2){0u, 0u}; }
        }
    }
    xcd_barrier(bar, wv);

    if (PH(1)) for (int rep_ = 0; rep_ < NREP(101); ++rep_) { PHASE_PTRS
        pg8::OrdMemKV2 S{G, bx, (const char*)memb, (const char*)wmkv};
        pg8::EpiMemKV2 E{mk8, mv8, out + O_MKP, out + O_MVP};
        pg8::gemm_phase(lds, wv, D, D, D, S, E);
    }
    xcd_barrier(bar, wv);
    if (PH(1)) { PHASE_PTRS
        pg8::OrdW12 S{G, bx, (const char*)mk8, (const char*)wqr8, (const char*)wmo, (const char*)mv8};
        pg8::EpiW12 E{w1, w2, vec + V_S1_U, vec + V_S1_C, lng, lnb};
        pg8::gemm_phase<true>(lds, wv, 256, D / 2, D / 2, S, E);
    }
    xcd_barrier(bar, wv);

    for (int layer = 0; layer < DEPTH; ++layer) {
        if (PROBE_ID == 120) for (int xb_ = 0; xb_ < 10; ++xb_) xcd_barrier(bar, wv);
        const int a = layer >> 1;
        const int s0 = 3 * layer;
#define st_in (((s0 - 1) & 1) ? stB : stA)
#define st_0 ((s0 & 1) ? stB : stA)
#define st_1 (((s0 + 1) & 1) ? stB : stA)
#define st_2 (((s0 + 2) & 1) ? stB : stA)
#define sst_in (((s0 - 1) & 1) ? sstB : sstA)
#define sst_0 ((s0 & 1) ? sstB : sstA)
#define sst_1 (((s0 + 1) & 1) ? sstB : sstA)
#define sst_2 (((s0 + 2) & 1) ? sstB : sstA)
        const bool idn = (layer == 0);
#define g_in (lng + (size_t)((layer - 1) * 3 + 2) * D)
#define b_in (lnb + (size_t)((layer - 1) * 3 + 2) * D)
        if ((layer & 1) == 0) {
            if (PH(2)) for (int rep_ = 0; rep_ < NREP(102); ++rep_) { PHASE_PTRS
                pg8::OrdQKV8 S8{G, bx, (const char*)z8, (const char*)(wqkv8 + (size_t)a * 6144 * D)};
                pg8::EpiQKV8 E8{st_in, idn, vec + V_QKV8_U, vec + V_QKV_C, qkv};
                pg8::OrdQKVTail St{G, bx, (const char*)zb, (const char*)(wqkv + (size_t)a * 6144 * D)};
                pg8::EpiQKV Et{st_in, idn, vec + V_QKV_U, vec + V_QKV_C, qkv, kvs + (size_t)a * 2 * SBAT * KVROWS * D,
                               out + O_AKP + (size_t)a * NB * 512 * D, out + O_AKS + (size_t)a * MS * D};
                sk::SEpiQKV Es{sst_in, idn, vec + V_QKV_U, vec + V_QKV_C, qkv, kvs + (size_t)a * 2 * SBAT * KVROWS * D, out + O_AKS + (size_t)a * MS * D};
                _Pragma("unroll 1") for (int pass_ = 0; pass_ < 2; ++pass_) {
                    if ((pass_ == 0) != skf) { pg8::gemm_phase<true>(lds, wv, D / 2, D / 2, D / 2, S8, E8); pg8::gemm_phase(lds, wv, D, D, D, St, Et); }
                    else { for (int srep_ = 0; srep_ < ((PROBE_ID == 300) ? 2 : 1); ++srep_) sk::skinny_phase<0, false, true>((LAS char*)lds, wv, zb + (size_t)MP * D, D, wqkv + (size_t)a * 6144 * D, D, D, 6144 / 64, G, bx, Es); __syncthreads(); }
                }
            }
            xcd_barrier(bar, wv);
            if (PH(3)) for (int rep_ = 0; rep_ < NREP(103); ++rep_) { PHASE_PTRS
                const float* relb = IN(I_RELB) + (size_t)a * NHEAD * NREL;
                const bf16_t* kvsa = kvs + (size_t)a * 2 * SBAT * KVROWS * D;
                for (int it = 0; ; ++it) {
                    int U;
                    if (G != 256) { U = bx + it * G; if (U >= 1152) break; }
                    else if (it < 3) U = bx + 256 * it;
                    else if (it == 3) U = bx < 128 ? 768 + bx : 1024 + (bx - 128);
                    else if (it == 4 && bx >= 128) U = 896 + (bx - 128);
                    else break;
                    const bf16_t *Qp, *Kp, *Vp; unsigned char* Op; int kvst, T_lo, T_hi, cbase, nact, h; bool smp = false;
                    if (U < 1024) { int bh, qb; if (U < 896) { bh = U & 63; qb = 2 + (U >> 6); } else { bh = (U - 896) & 63; qb = 1 - ((U - 896) >> 6); }
                        const int b = bh >> 4; h = bh & 15;
                        const bf16_t* base = qkv + (size_t)b * SEQ * 6144 + h * HD;
                        Qp = base + (size_t)qb * 256 * 6144; Kp = base + 2048; Vp = base + 4096; kvst = 6144; Op = ob8 + ((size_t)b * SEQ + qb * 256) * D + h * HD;
                        T_lo = 4 * qb - 8 < 0 ? 0 : 4 * qb - 8; T_hi = 4 * qb + 4; cbase = 4 * qb; nact = 8; }
                    else { const int v = U - 1024, b = v >> 4; h = v & 15; smp = true;
                        Qp = qkv + (size_t)(MP + b * ST) * 6144 + h * HD; Kp = kvsa + (size_t)(0 * SBAT + b) * KVROWS * D + h * HD; Vp = kvsa + (size_t)(1 * SBAT + b) * KVROWS * D + h * HD;
                        kvst = D; Op = ob8 + (size_t)(MP + b * ST) * D + h * HD; T_lo = 0; T_hi = 9; cbase = 8; nact = 1; }
                    att::attn_unit((LAS char*)lds, Qp, 6144, Kp, Vp, kvst, Op, T_lo, T_hi, cbase, nact, smp, relb + h * NREL, wv);
                }
            }
            xcd_barrier(bar, wv);
            if (PH(4)) for (int rep_ = 0; rep_ < NREP(204); ++rep_) { PHASE_PTRS const bool dry_ = (NREP(204) == 2 && rep_ == 0); half_t* const zfo_ = dry_ ? (half_t*)(ws + WS_DUMMY) : zf; bf16_t* const zlo_ = dry_ ? (bf16_t*)(ws + WS_DUMMY + (size_t)M * D * 4) : (bf16_t*)z8; float* const stn_ = dry_ ? (float*)(ws + WS_DUMMY + (size_t)M * D * 4 + (size_t)MPAD * D * 2) : st_0; float* const sstn_ = dry_ ? (float*)(ws + WS_DUMMY + (size_t)M * D * 4 + (size_t)MPAD * D * 2 + ST_BYTES) : sst_0;
                pg8::OrdStd S{MP / 256, D / 256, G, bx, (const char*)ob8, (const char*)(wao + (size_t)a * D * D), (size_t)256 * D, (size_t)256 * D, 0, 0};
                pg8::EpiRes<false, true> E{st_in, stn_, idn, IN(I_XP), IN(I_XS), zf, zlo_, g_in, b_in, nullptr, red, W8_INV * O8_INV, zfo_, nullptr};
                sk::SEpiRes<false, true> Es{sst_in, sstn_, idn, IN(I_XS), zf, zlo_, g_in, b_in, nullptr, sred, W8_INV * O8_INV, zfo_};
                _Pragma("unroll 1") for (int pass_ = 0; pass_ < 2; ++pass_) {
                    if ((pass_ == 0) != skf) { pg8::gemm_phase<true>(lds, wv, D / 2, D / 2, D / 2, S, E); }
                    else { sk::skinny_phase<0, true>((LAS char*)lds, wv, (const bf16_t*)(ob8 + (size_t)MP * D), D / 2, (const bf16_t*)(wao + (size_t)a * D * D), D / 2, D / 2, D / 64, G, bx, Es); __syncthreads(); }
                }
            }
            xcd_barrier(bar, wv);
        } else {
            const int p = layer >> 1;
            if (PH(5)) for (int rep_ = 0; rep_ < NREP(105); ++rep_) { PHASE_PTRS
                PHASE_IDS
                LAS float* stl = (LAS float*)lds;
                const int col = 4 * tid;
                const f32x4 gq = *(const f32x4*)(g_in + col), bq = *(const f32x4*)(b_in + col);
                for (int U = bx; U < 1040; U += G) {
                    const bool smp = U >= 1024;
                    const int b = smp ? (U - 1024) >> 1 : U >> 8, t0 = smp ? ((U - 1024) & 1) * 16 : (U & 255) * 16;
                    const size_t row0 = smp ? (size_t)MP + b * ST + t0 : (size_t)b * SEQ + t0;
                    __syncthreads();
                    if (tid < 31) { const int t = t0 - 15 + tid;
                        if (t >= 0) { const f32x4* pp = smp ? (const f32x4*)(sst_in + (size_t)(b * ST + t) * 64) : (const f32x4*)(st_in + (row0 + (tid - 15)) * 16); float s = 0.f, q = 0.f;
                            const int np = smp ? 16 : 4;
                            for (int k = 0; k < np; ++k) { const f32x4 v = pp[k]; s += v[0] + v[2]; q += v[1] + v[3]; }
                            const float mm = s * (1.f / D), var = q * (1.f / D) - mm * mm; stl[2 * tid] = mm; stl[2 * tid + 1] = __builtin_amdgcn_rsqf(var + LN_EPS); } }
                    __syncthreads();
                    const float* spool = IN(I_SPOOL) + ((size_t)(p * SBAT + b) * 15) * D + col;
                    const half_t* zrow = zf + row0 * D + col;
                    bf16_t* urow = ob + row0 * D + col;
                    float* prow = smp ? out + O_PS + ((size_t)(p * SBAT + b) * 15) * D + col : out + O_PP + ((size_t)(p * NB + b) * 15) * D + col;
                    const bool wout = smp ? (t0 == 16) : (t0 == SEQ - 16);
#define POOL_BODY(W) do { f32x4 xv[15 + (W)]; \
                        _Pragma("unroll") for (int i = 0; i < 15 + (W); ++i) { const int tr = i - ((W) - 1), t = t0 + tr;            \
                            if (t >= 0) xv[i] = unpack4h(*(const u32x2*)(zrow + (ptrdiff_t)tr * D)); \
                            else if (smp) xv[i] = *(const f32x4*)(spool + (ptrdiff_t)(15 + t) * D); \
                            else xv[i] = (f32x4){0.f, 0.f, 0.f, 0.f}; } \
                        _Pragma("unroll") for (int i = 0; i < 15 + (W); ++i) { const int tr = i - ((W) - 1), t = t0 + tr; \
                            if (t >= 0) { const float mm = stl[2 * (tr + 15)], rr = stl[2 * (tr + 15) + 1]; xv[i] = (xv[i] - mm) * rr * gq + bq; } } \
                        f32x4 s = {0.f, 0.f, 0.f, 0.f}; \
                        _Pragma("unroll") for (int i = 0; i < (W) - 1; ++i) s += xv[i]; \
                        _Pragma("unroll") for (int t = 0; t < 16; ++t) { s += xv[t + (W) - 1]; \
                            const int cnt = smp ? (W) : ((t0 + t + 1 < (W)) ? t0 + t + 1 : (W)); \
                            const f32x4 uo = s * (1.0f / (float)cnt) - xv[t + (W) - 1]; \
                            u32x2 wv; wv.x = pk2(uo[0], uo[1]); wv.y = pk2(uo[2], uo[3]); \
                            *(u32x2*)(urow + (size_t)t * D) = wv; \
                            if (wout && t >= 1) *(f32x4*)(prow + (size_t)(t - 1) * D) = xv[t + (W) - 1]; \
                            s -= xv[t]; } } while (0)
                    const int wsel = tid >> 7;
                    if (wsel == 0) POOL_BODY(2); else if (wsel == 1) POOL_BODY(4); else if (wsel == 2) POOL_BODY(8); else POOL_BODY(16);
#undef POOL_BODY
                }
            }
            xcd_barrier(bar, wv);
            if (PH(6)) for (int rep_ = 0; rep_ < NREP(204); ++rep_) { PHASE_PTRS const bool dry_ = (NREP(204) == 2 && rep_ == 0); half_t* const zfo_ = dry_ ? (half_t*)(ws + WS_DUMMY) : zf; bf16_t* const zlo_ = dry_ ? (bf16_t*)(ws + WS_DUMMY + (size_t)M * D * 4) : (bf16_t*)z8; float* const stn_ = dry_ ? (float*)(ws + WS_DUMMY + (size_t)M * D * 4 + (size_t)MPAD * D * 2) : st_0; float* const sstn_ = dry_ ? (float*)(ws + WS_DUMMY + (size_t)M * D * 4 + (size_t)MPAD * D * 2 + ST_BYTES) : sst_0;
                pg8::OrdStd S{MP / 256, D / 256, G, bx, (const char*)ob, (const char*)(wpool + (size_t)p * D * 512), (size_t)256 * D * 2, (size_t)256 * 512 * 2, 1, 512 * 2};
                pg8::EpiRes<true, true> E{st_in, stn_, false, nullptr, nullptr, zf, zlo_, g_in, b_in, IN(I_PSC) + (size_t)p * D, red, 1.f, zfo_, nullptr};
                sk::SEpiRes<true, true> Es{sst_in, sstn_, false, nullptr, zf, zlo_, g_in, b_in, IN(I_PSC) + (size_t)p * D, sred, 1.f, zfo_};
                _Pragma("unroll 1") for (int pass_ = 0; pass_ < 2; ++pass_) {
                    if ((pass_ == 0) != skf) { pg8::gemm_phase(lds, wv, 512, D, 512, S, E); }
                    else { sk::skinny_phase<2>((LAS char*)lds, wv, ob + (size_t)MP * D, D, wpool + (size_t)p * D * 512, 512, 512, D / 64, G, bx, Es); __syncthreads(); }
                }
            }
            xcd_barrier(bar, wv);
        }
        if (PH(7)) for (int rep_ = 0; rep_ < NREP(107); ++rep_) { PHASE_PTRS
            pg8::OrdS8 S{G, bx, (const char*)z8, (const char*)(w1 + (size_t)layer * NB * 1024 * D)};
            pg8::EpiSoftP8 E{st_0, vec + V_S1_U + layer * NB * 1024, vec + V_S1_C + layer * NB * 1024, Pb8, (LAS float*)(lds + RED_OFF)};
            sk::SEpiLin Es{sst_0, vec + V_MQ_U + layer * D, vec + V_MQ_C + layer * D, qm, W8_INV};
            _Pragma("unroll 1") for (int pass_ = 0; pass_ < 2; ++pass_) {
                if ((pass_ == 0) != skf) { pg8::gemm_phase<true>(lds, wv, D / 2, D / 2, D / 2, S, E); }
                else { sk::skinny_phase<0, true>((LAS char*)lds, wv, (const bf16_t*)(z8 + (size_t)MP * D), D / 2, (const bf16_t*)(wmq + (size_t)layer * D * D), D / 2, D / 2, D / 64, G, bx, Es); __syncthreads(); }
            }
        }
        xcd_barrier(bar, wv);
        if (PH(11)) for (int rep_ = 0; rep_ < NREP(211); ++rep_) { PHASE_PTRS const bool dry_ = (NREP(211) == 2 && rep_ == 0); half_t* const zfo_ = dry_ ? (half_t*)(ws + WS_DUMMY) : zf; bf16_t* const zlo_ = dry_ ? (bf16_t*)(ws + WS_DUMMY + (size_t)M * D * 4) : (bf16_t*)z8; float* const stn_ = dry_ ? (float*)(ws + WS_DUMMY + (size_t)M * D * 4 + (size_t)MPAD * D * 2) : st_1;
            pg8::OrdG2 S{G, bx, (const char*)Pb8, (const char*)(w2 + (size_t)layer * NB * D * 1024)};
            pg8::EpiRes<false, true> E{st_0, stn_, false, nullptr, nullptr, zf, zlo_, lng + (size_t)(layer * 3 + 0) * D, lnb + (size_t)(layer * 3 + 0) * D, nullptr, red, 1.f / (P8_SCALE * W2_SCALE), zfo_, nullptr};
            pg8::gemm_phase<true>(lds, wv, 512, 512, 512, S, E);
            if (rep_ == NREP(211) - 1) for (int U = bx; U < 64; U += G) { const int b = U >> 3, h = (U >> 1) & 3;
                smem_attn_unit((LAS char*)lds, qm + (size_t)(MP + b * ST) * D + h * MHD, mks + ((size_t)(layer * SBAT + b) * NMEM) * D + h * MHD,
                               mvts + ((size_t)(layer * SBAT + b) * D + h * MHD) * 256, ob8 + (size_t)(MP + b * ST) * D + h * MHD, wv, U & 1); }
        }
        xcd_barrier(bar, wv);
        if (PH(11)) { PHASE_PTRS
            sk::SEpiRes<false, true> Es{sst_0, sst_1, false, nullptr, zf, (bf16_t*)z8, lng + (size_t)(layer * 3 + 0) * D, lnb + (size_t)(layer * 3 + 0) * D, nullptr, sred, W8_INV * O8_INV, zf};
            sk::skinny_phase<0, true>((LAS char*)lds, wv, (const bf16_t*)(ob8 + (size_t)MP * D), D / 2, (const bf16_t*)(wmo + (size_t)layer * D * D), D / 2, D / 2, D / 64, G, bx, Es);
        }
        xcd_barrier_arrive(bar, wv);
        if (PH(12)) for (int rep_ = 0; rep_ < NREP(112); ++rep_) { PHASE_PTRS
            pg8::OrdStd S{MP / 256, 2 * DFF / 256, G, bx, (const char*)z8, (const char*)(wfi + (size_t)layer * 2 * DFF * D), (size_t)256 * D, (size_t)256 * D, 0, 0};
            pg8::EpiFfnIn E{st_1, vec + V_FI_U + layer * 2 * DFF, vec + V_FI_C + layer * 2 * DFF, Hb, (LAS char*)(lds + RED_OFF), 0, 0, -1};
            sk::SEpiFfnIn Es{sst_1, vec + V_FI_U + layer * 2 * DFF, vec + V_FI_C + layer * 2 * DFF, Hb};
            if (PROBE_ID == 412) { pg8::EpiNone En; pg8::gemm_phase<true>(lds, wv, D / 2, D / 2, D / 2, S, En); }
            if (PROBE_ID == 421) { sk::SEpiNone Esn; sk::skinny_phase<1, true>((LAS char*)lds, wv, (const bf16_t*)(z8 + (size_t)MP * D), D / 2, (const bf16_t*)(wfi + (size_t)layer * 2 * DFF * D), D / 2, D / 2, DFF / 32, G, bx, Esn); __syncthreads(); }
            if (PROBE_ID == 422) { sk::skinny_phase<1, true>((LAS char*)lds, wv, (const bf16_t*)(z8 + (size_t)MP * D), D / 2, (const bf16_t*)(wfi + (size_t)layer * 2 * DFF * D), D / 2, D / 2, DFF / 32, G, bx, Es); __syncthreads(); }
            if (PROBE_ID == 413) { pg8::EpiFfnIn En{st_1, vec + V_FI_U + layer * 2 * DFF, vec + V_FI_C + layer * 2 * DFF, nullptr, (LAS char*)(lds + RED_OFF), 0, 0, -1}; pg8::gemm_phase<true>(lds, wv, D / 2, D / 2, D / 2, S, En); }
            pg8::gemm_phase<true>(lds, wv, D / 2, D / 2, D / 2, S, E);
            if (rep_ == 0) xcd_barrier_wait(bar, wv);
            {
                { for (int srep_ = 0; srep_ < ((PROBE_ID == 300) ? 2 : 1); ++srep_) sk::skinny_phase<1, true>((LAS char*)lds, wv, (const bf16_t*)(z8 + (size_t)MP * D), D / 2, (const bf16_t*)(wfi + (size_t)layer * 2 * DFF * D), D / 2, D / 2, DFF / 32, G, bx, Es); __syncthreads(); }
            }
        }
        xcd_barrier(bar, wv);
        if (PH(13)) for (int rep_ = 0; rep_ < NREP(213); ++rep_) { PHASE_PTRS const bool nxa = (layer == 1); const bool dry_ = (NREP(213) == 2 && rep_ == 0); half_t* const zfo_ = dry_ ? (half_t*)(ws + WS_DUMMY) : zf; bf16_t* const zlo_ = dry_ ? (bf16_t*)(ws + WS_DUMMY + (size_t)M * D * 4) : zb; float* const stn_ = dry_ ? (float*)(ws + WS_DUMMY + (size_t)M * D * 4 + (size_t)MPAD * D * 2) : st_2; float* const sstn_ = dry_ ? (float*)(ws + WS_DUMMY + (size_t)M * D * 4 + (size_t)MPAD * D * 2 + ST_BYTES) : sst_2;
            pg8::OrdStd S{MP / 256, D / 256, G, bx, (const char*)Hb, (const char*)(wfo + (size_t)layer * D * DFF), (size_t)256 * DFF, (size_t)256 * DFF, 0, 0};
            pg8::EpiRes<false> E{st_1, stn_, false, nullptr, nullptr, zf, nxa ? zlo_ : nullptr, lng + (size_t)(layer * 3 + 1) * D, lnb + (size_t)(layer * 3 + 1) * D, nullptr, red, W8_INV * H8_INV, zfo_, (nxa && !dry_) ? z8 : nullptr};
            sk::SEpiRes<false> Es{sst_1, sstn_, false, nullptr, zf, zlo_, lng + (size_t)(layer * 3 + 1) * D, lnb + (size_t)(layer * 3 + 1) * D, nullptr, sred, W8_INV * H8_INV, zfo_};
            _Pragma("unroll 1") for (int pass_ = 0; pass_ < 2; ++pass_) {
                if ((pass_ == 0) != skf) { pg8::gemm_phase<true>(lds, wv, DFF / 2, DFF / 2, DFF / 2, S, E); }
                else { sk::skinny_phase<0, true>((LAS char*)lds, wv, (const bf16_t*)(Hb + (size_t)MP * DFF), DFF / 2, (const bf16_t*)(wfo + (size_t)layer * D * DFF), DFF / 2, DFF / 2, D / 64, G, bx, Es); __syncthreads(); }
            }
        }
        xcd_barrier(bar, wv);
    }

    if (PH(14)) for (int rep_ = 0; rep_ < NREP(114); ++rep_) { PHASE_PTRS
        PHASE_IDS
        const float* gl = lng + (size_t)(3 * 3 + 2) * D; const float* bl = lnb + (size_t)(3 * 3 + 2) * D;
        f32x4 G0[4], G1[4], B0[4], B1[4];
#pragma unroll
        for (int j = 0; j < 4; ++j) { G0[j] = ((const f32x4*)gl)[2 * lane + 128 * j]; G1[j] = ((const f32x4*)gl)[2 * lane + 128 * j + 1]; B0[j] = ((const f32x4*)bl)[2 * lane + 128 * j]; B1[j] = ((const f32x4*)bl)[2 * lane + 128 * j + 1]; }
        u32x4 zc[4];
        { const int r0_ = bx * NWAVES + wave; if (r0_ < M) { const u32x4* zr = (const u32x4*)(zf + (size_t)r0_ * D) + lane;
#pragma unroll
            for (int j = 0; j < 4; ++j) zc[j] = zr[64 * j]; } }
        for (int r = bx * NWAVES + wave; r < M; r += G * NWAVES) {
            f32x4* yo = (f32x4*)(out + (size_t)r * D) + 2 * lane;
            u32x4 zn[4]; const int rn_ = r + G * NWAVES;
            if (rn_ < M) { const u32x4* zr = (const u32x4*)(zf + (size_t)rn_ * D) + lane;
#pragma unroll
                for (int j = 0; j < 4; ++j) zn[j] = zr[64 * j]; }
            float v[4][8]; float s = 0.f;
#pragma unroll
            for (int j = 0; j < 4; ++j) { unpack8h(zc[j], v[j]);
#pragma unroll
                for (int e = 0; e < 8; ++e) s += v[j][e]; }
            const float mean = wave_sum(s) * (1.f / D); float s2 = 0.f;
#pragma unroll
            for (int j = 0; j < 4; ++j)
#pragma unroll
                for (int e = 0; e < 8; ++e) { v[j][e] -= mean; s2 += v[j][e] * v[j][e]; }
            const float rstd = 1.0f / sqrtf(wave_sum(s2) * (1.f / D) + LN_EPS);
#pragma unroll
            for (int j = 0; j < 4; ++j) { yo[128 * j] = (f32x4){v[j][0], v[j][1], v[j][2], v[j][3]} * rstd * G0[j] + B0[j]; yo[128 * j + 1] = (f32x4){v[j][4], v[j][5], v[j][6], v[j][7]} * rstd * G1[j] + B1[j]; }
            if (rn_ < M) {
#pragma unroll
                for (int j = 0; j < 4; ++j) zc[j] = zn[j]; }
        }
    }
}

extern "C" void kernel_launch(void* const* d_in, const int* in_sizes, int n_in, void* d_out, int out_size, void* d_ws, size_t ws_size, hipStream_t stream) {
    static int grid = 0;
    if (grid == 0) {
        if (n_in != 20 || (size_t)out_size != O_END || ws_size < (PROBE_ID ? WS_END_PROBE : WS_END)) { fprintf(stderr, "kernel_launch: unexpected shapes (n_in %d, out %d vs %zu, ws %zu vs %zu)\n", n_in, out_size, (size_t)O_END, ws_size, (size_t)WS_END); grid = -1; return; }
        int dev = 0, cus = 0, per_cu = 0;
        if (hipGetDevice(&dev) != hipSuccess || hipDeviceGetAttribute(&cus, hipDeviceAttributeMultiprocessorCount, dev) != hipSuccess) { grid = -1; return; }
        if (hipFuncSetAttribute((const void*)mk_fwd, hipFuncAttributeMaxDynamicSharedMemorySize, LDS_BYTES) != hipSuccess) { fprintf(stderr, "kernel_launch: hipFuncSetAttribute failed\n"); grid = -1; return; }
        if (hipOccupancyMaxActiveBlocksPerMultiprocessor(&per_cu, (const void*)mk_fwd, NTHR, LDS_BYTES) != hipSuccess || per_cu < 1) { fprintf(stderr, "kernel_launch: occupancy query says %d\n", per_cu); }
        (void)hipGetLastError();
        grid = cus;
    }
    if (grid < 0) return;
    if (hipMemsetAsync((char*)d_ws + WS_CTL, 0, CTL_BYTES, stream) != hipSuccess) return;
    Args a{};
    for (int i = 0; i < 20; ++i) a.in[i] = (const float*)d_in[i];
    a.out = (float*)d_out; a.ws = (unsigned char*)d_ws;
    hipLaunchKernelGGL(mk_fwd, dim3(grid), dim3(NTHR), LDS_BYTES, stream, a);
}
```

```cpp
#include <hip/hip_runtime.h>
#include <cstdio>
#include <cstdint>

#define LAS __attribute__((address_space(3)))
#define GAS __attribute__((address_space(1)))
typedef unsigned short bf16_t;
typedef short bf16x8 __attribute__((ext_vector_type(8)));
typedef short s16x4 __attribute__((ext_vector_type(4)));
typedef float f32x4 __attribute__((ext_vector_type(4)));
typedef float f32x2 __attribute__((ext_vector_type(2)));
typedef float f32x16 __attribute__((ext_vector_type(16)));
typedef unsigned u32x4 __attribute__((ext_vector_type(4)));
typedef unsigned u32x2 __attribute__((ext_vector_type(2)));
typedef int i32x8 __attribute__((ext_vector_type(8)));
typedef int i32x4 __attribute__((ext_vector_type(4)));

constexpr int D = 2048, NB = 4, SEQ = 4096, DEPTH = 4, SBAT = 8, ST = 32, DFF = 5632;
constexpr int MP = NB * SEQ, MS = SBAT * ST, M = MP + MS, MPAD = M + 256;
constexpr int NHEAD = 16, HD = 128, NREL = 257, NMEM = 256, MHD = 512;
constexpr int KVROWS = 576;
constexpr float ALPHA = 1.6817928305074290f;
constexpr float LN_EPS = 1e-5f;
constexpr float LOG2E = 1.4426950408889634f;
constexpr int NWAVES = 8, NTHR = 512;
#ifndef ONLY
#define ONLY -1
#endif
#define PH(k) (ONLY < 0 || ONLY == (k))
#ifndef PROBE_ID
#define PROBE_ID 0
#endif
#define NREP(k) ((PROBE_ID == (k) || (PROBE_ID == 130 && ((k) == 108 || (k) == 110)) || (PROBE_ID == 131 && ((k) == 101 || (k) == 114))) ? 2 : 1)

constexpr size_t O_YP = 0, O_YS = O_YP + (size_t)MP * D, O_AKP = O_YS + (size_t)MS * D, O_AVP = O_AKP + (size_t)2 * NB * 512 * D,
                 O_PP = O_AVP + (size_t)2 * NB * 512 * D, O_MKP = O_PP + (size_t)2 * NB * 15 * D, O_MVP = O_MKP + (size_t)DEPTH * NB * NMEM * D,
                 O_AKS = O_MVP + (size_t)DEPTH * NB * NMEM * D, O_AVS = O_AKS + (size_t)2 * MS * D, O_PS = O_AVS + (size_t)2 * MS * D,
                 O_END = O_PS + (size_t)2 * SBAT * 15 * D;

constexpr size_t al256(size_t x) { return (x + 255) & ~(size_t)255; }
constexpr size_t WS_CTL = 0, CTL_BYTES = 2u << 20;
constexpr size_t WS_WQKV = WS_CTL + CTL_BYTES;
constexpr size_t WS_WQKV8 = WS_WQKV + (size_t)2 * 6144 * D * 2;
constexpr size_t WS_WAO  = WS_WQKV8 + (size_t)2 * 6144 * D;
constexpr size_t WS_WPOOL= WS_WAO + (size_t)2 * D * D;
constexpr size_t WS_WMQ  = WS_WPOOL + (size_t)2 * D * 512 * 2;
constexpr size_t WS_WMKV = WS_WMQ + (size_t)4 * D * D;
constexpr size_t WS_WMO  = WS_WMKV + (size_t)4 * 4096 * D * 2;
constexpr size_t WS_WFI  = WS_WMO + (size_t)4 * D * D;
constexpr size_t WS_WFO  = WS_WFI + (size_t)4 * 2 * DFF * D;
constexpr size_t WS_Z8   = WS_WFO + (size_t)4 * D * DFF;
constexpr size_t WS_ZF   = WS_Z8 + (size_t)MPAD * D;
constexpr size_t WS_ZB   = WS_ZF + (size_t)M * D * 2;
constexpr size_t WS_BIG  = WS_ZB + (size_t)MPAD * D * 2;
constexpr size_t BIG_BYTES = (size_t)MPAD * 6144 * 2;
constexpr size_t WS_QM   = WS_BIG;
constexpr size_t WS_S    = WS_QM + (size_t)MPAD * D * 2;
constexpr size_t WS_P    = WS_S + (size_t)MP * 1024 * 4;
constexpr size_t WS_H    = WS_BIG;
static_assert(WS_P + (size_t)MP * 1024 * 2 <= WS_BIG + BIG_BYTES && (size_t)M * DFF * 2 <= BIG_BYTES, "overlays");
constexpr size_t WS_OB   = WS_BIG + BIG_BYTES;
constexpr size_t WS_KVS  = WS_OB + (size_t)MPAD * D * 2;
constexpr size_t WS_MKS  = WS_KVS + (size_t)2 * 2 * SBAT * KVROWS * D * 2;
constexpr size_t WS_MVTS = WS_MKS + (size_t)4 * SBAT * NMEM * D * 2;
constexpr size_t WS_MEMB = WS_MVTS + (size_t)4 * SBAT * NMEM * D * 2;
constexpr size_t WS_MKP  = WS_MEMB + (size_t)NB * NMEM * D * 2;
constexpr size_t WS_MK8 = WS_MKP, WS_MV8 = WS_MKP + (size_t)4 * NB * NMEM * D;
constexpr size_t WS_MVTP = WS_MKP + (size_t)4 * NB * NMEM * D * 2;
constexpr size_t WS_WQR8 = WS_MVTP;
constexpr size_t WS_ST   = WS_MVTP + (size_t)4 * NB * NMEM * D * 2;
constexpr size_t ST_BYTES = (size_t)M * 16 * 4;
constexpr size_t WS_SST  = WS_ST + 2 * ST_BYTES;
constexpr size_t SST_BYTES = (size_t)MS * 64 * 4;
constexpr size_t WS_W1   = WS_SST + 2 * SST_BYTES;
constexpr size_t WS_W2   = WS_W1 + (size_t)4 * NB * 1024 * D;
constexpr size_t WS_END  = WS_W2 + (size_t)4 * NB * D * 1024;
constexpr size_t WS_DUMMY = WS_END;
constexpr size_t WS_END_PROBE = WS_DUMMY + (size_t)M * D * 4 + (size_t)MPAD * D * 2 + ST_BYTES + SST_BYTES;
constexpr int CW_BAR = 1024;
constexpr int CW_VEC = 8192;
constexpr int V_QKV_U = CW_VEC, V_QKV_C = V_QKV_U + 6144;
constexpr int V_MQ_U = V_QKV_C + 6144, V_MQ_C = V_MQ_U + 4 * D;
constexpr int V_FI_U = V_MQ_C + 4 * D, V_FI_C = V_FI_U + 4 * 2 * DFF, V_QKV8_U = V_FI_C + 4 * 2 * DFF, V_S1_U = V_QKV8_U + 6144, V_S1_C = V_S1_U + 4 * NB * 1024, V_END = V_S1_C + 4 * NB * 1024;
static_assert((size_t)V_END * 4 <= CTL_BYTES, "CTL");

constexpr int RING_BYTES = 131072, MISC_OFF = 135168  , RED_OFF = MISC_OFF + 1024, LDS_BYTES = 147456;
static_assert(8 * 16640 <= MISC_OFF && RED_OFF + 8192 <= LDS_BYTES, "LDS map");

__device__ __forceinline__ unsigned cvt_pk_bf16(float lo, float hi) { unsigned r; asm volatile("v_cvt_pk_bf16_f32 %0, %1, %2" : "=v"(r) : "v"(lo), "v"(hi)); return r; }
__device__ __forceinline__ u32x4 pack8(const float (&v)[8]) { u32x4 w; w.x = cvt_pk_bf16(v[0], v[1]); w.y = cvt_pk_bf16(v[2], v[3]); w.z = cvt_pk_bf16(v[4], v[5]); w.w = cvt_pk_bf16(v[6], v[7]); return w; }
__device__ __forceinline__ unsigned f2bf(float f) { unsigned u = __builtin_bit_cast(unsigned, f); return (u + 0x7fffu + ((u >> 16) & 1u)) >> 16; }
__device__ __forceinline__ float bf2f(unsigned b) { return __builtin_bit_cast(float, b << 16); }
__device__ __forceinline__ unsigned pk2(float lo, float hi) { return f2bf(lo) | (f2bf(hi) << 16); }
__device__ __forceinline__ int lane_id() { int l; asm volatile("v_mbcnt_lo_u32_b32 %0, -1, 0\n\tv_mbcnt_hi_u32_b32 %0, -1, %0" : "=v"(l)); return l; }
__device__ __forceinline__ float shx(float v, int mask) { const int l = lane_id(); return __builtin_bit_cast(float, __builtin_amdgcn_ds_bpermute((l ^ mask) << 2, __builtin_bit_cast(int, v))); }
__device__ __forceinline__ int shx(int v, int mask) { const int l = lane_id(); return __builtin_amdgcn_ds_bpermute((l ^ mask) << 2, v); }
__device__ __forceinline__ float shl(float v, int src) { return __builtin_bit_cast(float, __builtin_amdgcn_ds_bpermute(src << 2, __builtin_bit_cast(int, v))); }
__device__ __forceinline__ float wave_sum(float v) {
#pragma unroll
    for (int o = 1; o < 64; o <<= 1) v += shx(v, o);
    return v;
}
__device__ __forceinline__ float wave_max(float v) {
#pragma unroll
    for (int o = 1; o < 64; o <<= 1) v = fmaxf(v, shx(v, o));
    return v;
}
typedef _Float16 h16x2 __attribute__((ext_vector_type(2)));
typedef _Float16 h16x8 __attribute__((ext_vector_type(8)));
typedef unsigned short half_t;
__device__ __forceinline__ unsigned pk2h(float a, float b) { const h16x2 v = {(_Float16)a, (_Float16)b}; return __builtin_bit_cast(unsigned, v); }
__device__ __forceinline__ u32x4 pack8h(const float (&v)[8]) { u32x4 w; w.x = pk2h(v[0], v[1]); w.y = pk2h(v[2], v[3]); w.z = pk2h(v[4], v[5]); w.w = pk2h(v[6], v[7]); return w; }
__device__ __forceinline__ void unpack8h(u32x4 w, float (&v)[8]) { const h16x8 h = __builtin_bit_cast(h16x8, w);
#pragma unroll
    for (int i = 0; i < 8; ++i) v[i] = (float)h[i]; }
__device__ __forceinline__ f32x4 unpack4h(u32x2 w) { typedef _Float16 h16x4 __attribute__((ext_vector_type(4))); const h16x4 h = __builtin_bit_cast(h16x4, w); return (f32x4){(float)h[0], (float)h[1], (float)h[2], (float)h[3]}; }
constexpr float W8_SCALE = 1024.f, W8_INV = 1.f / 1024.f;
constexpr float H8_SCALE = 32.f, H8_INV = 1.f / 32.f;
constexpr float QSCALE = 0.08838834764831845f * 1.4426950408889634f;
constexpr float O8_SCALE = 64.f, O8_INV = 1.f / 64.f;
constexpr float WQR_SCALE = 64.f, MV8_SCALE = 8.f, W1_SCALE = 16.f, W2_SCALE = 64.f, P8_SCALE = 256.f;
__device__ __forceinline__ unsigned pk4_fp8(float a, float b, float c, float d) { int w = 0; w = __builtin_amdgcn_cvt_pk_fp8_f32(a, b, w, false); w = __builtin_amdgcn_cvt_pk_fp8_f32(c, d, w, true); return (unsigned)w; }
__device__ __forceinline__ u32x2 pack8_fp8(const float (&v)[8]) { u32x2 w; w.x = pk4_fp8(v[0], v[1], v[2], v[3]); w.y = pk4_fp8(v[4], v[5], v[6], v[7]); return w; }
__device__ __forceinline__ u32x4 widen8(u32x2 p0, u32x2 p1) {
    const auto x = __builtin_amdgcn_permlane16_swap(p0.x, p1.x, false, false); const auto y = __builtin_amdgcn_permlane16_swap(p0.y, p1.y, false, false);
    return (u32x4){x[0], y[0], x[1], y[1]};
}
__device__ __forceinline__ float sum4_fp8(unsigned w) { return (__builtin_amdgcn_cvt_f32_fp8((int)w, 0) + __builtin_amdgcn_cvt_f32_fp8((int)w, 1)) + (__builtin_amdgcn_cvt_f32_fp8((int)w, 2) + __builtin_amdgcn_cvt_f32_fp8((int)w, 3)); }
#define LDS_WAIT() asm volatile("s_waitcnt lgkmcnt(0)" ::: "memory")
#define VM_WAIT() asm volatile("s_waitcnt vmcnt(0)" ::: "memory")

#define XB_TMO      128
#define XB_XCNT(j)  (256  + 64 * (j))
#define XB_XSUB(j)  (1280 + 64 * (j))
#define XB_XGEN(j)  (2304 + 64 * (j))
#define XB_TOP      3328
#define XB_TOPGEN   3392
#define XCD_BAR_WORDS 3456
#define XB_SPIN_CAP (1u << 18)
static_assert(CW_BAR + XCD_BAR_WORDS <= CW_VEC, "CTL map");
__device__ __forceinline__ unsigned xb_ld(unsigned* p)              { return __hip_atomic_load(p, __ATOMIC_RELAXED, __HIP_MEMORY_SCOPE_AGENT); }
__device__ __forceinline__ unsigned xb_add(unsigned* p, unsigned v) { return __hip_atomic_fetch_add(p, v, __ATOMIC_RELAXED, __HIP_MEMORY_SCOPE_AGENT); }
__device__ __forceinline__ unsigned xb_xcc_id() { return (unsigned)__builtin_amdgcn_s_getreg((3 << 11) | 20) & 0xFu; }
#define XB_SPIN(cond, bar) do { unsigned _sp = 0; while (cond) { __builtin_amdgcn_s_sleep(1); \
    if ((++_sp & 255u) == 0u) { if (xb_ld(&(bar)[XB_TMO])) break; if (_sp > XB_SPIN_CAP) { atomicAdd(&(bar)[XB_TMO], 1u); break; } } } } while (0)
struct XcdBarrier { unsigned* bar; unsigned x; volatile LAS unsigned* st; };
__device__ __forceinline__ XcdBarrier xcd_barrier_post(unsigned* bar, volatile LAS unsigned* st) {
    XcdBarrier b; b.bar = bar; b.x = xb_xcc_id(); b.st = st;
    if (threadIdx.x == 0) (void)xb_add(&bar[XB_XCNT(b.x)], 1u);
    return b;
}
__device__ __forceinline__ void xcd_barrier_complete(unsigned* bar, unsigned x, unsigned& nloc, unsigned& nx) {
    const unsigned G = gridDim.x * gridDim.y * gridDim.z;
    unsigned sum, cnt, mine, sp = 0u;
    for (;;) {
        sum = 0u; cnt = 0u; mine = 0u;
#pragma unroll
        for (unsigned j = 0; j < 16; ++j) { const unsigned c = xb_ld(&bar[XB_XCNT(j)]); sum += c; cnt += (c > 0u) ? 1u : 0u; mine = (j == x) ? c : mine; }
        if (sum == G) break;
        __builtin_amdgcn_s_sleep(1);
        if ((++sp & 255u) == 0u) { if (xb_ld(&bar[XB_TMO])) break; if (sp > XB_SPIN_CAP) { atomicAdd(&bar[XB_TMO], 1u); break; } }
    }
    nloc = mine > 0u ? mine : 1u; nx = cnt > 0u ? cnt : 1u;
}
__device__ __forceinline__ void xcd_barrier(const XcdBarrier& b, const int wv) {
    asm volatile("s_waitcnt vmcnt(0)" ::: "memory");
    __syncthreads();
    if (wv == 0 && lane_id() == 0) {
        unsigned* bar = b.bar; unsigned bx_ = b.x;
        asm volatile("" : "+s"(bar), "+s"(bx_));
        __builtin_amdgcn_s_waitcnt(0);
        unsigned nloc = b.st[0], nx = b.st[1];
        if (nloc == 0u) { xcd_barrier_complete(bar, bx_, nloc, nx); b.st[0] = nloc; b.st[1] = nx; }
        const unsigned old = xb_add(&bar[XB_XSUB(bx_)], 1u);
        const unsigned gen = old / nloc;
        if (old + 1u == (gen + 1u) * nloc) {
            __builtin_amdgcn_fence(__ATOMIC_RELEASE, "agent");
            asm volatile("s_waitcnt vmcnt(0)" ::: "memory");
            const unsigned og = xb_add(&bar[XB_TOP], 1u);
            const unsigned tg = og / nx;
            if (og + 1u == (tg + 1u) * nx) xb_add(&bar[XB_TOPGEN], 1u);
            else XB_SPIN(xb_ld(&bar[XB_TOPGEN]) == tg, bar);
            __builtin_amdgcn_fence(__ATOMIC_ACQUIRE, "agent");
            xb_add(&bar[XB_XGEN(bx_)], 1u);
            asm volatile("s_waitcnt vmcnt(0)" ::: "memory");
        } else {
            XB_SPIN(xb_ld(&bar[XB_XGEN(bx_)]) == gen, bar);
            __builtin_amdgcn_fence(__ATOMIC_ACQUIRE, "agent");
            asm volatile("s_waitcnt vmcnt(0)" ::: "memory");
        }
    }
    __syncthreads();
}

__device__ __forceinline__ void xcd_barrier_arrive(const XcdBarrier& b, const int wv) {
    asm volatile("s_waitcnt vmcnt(0)" ::: "memory");
    __syncthreads();
    if (wv == 0 && lane_id() == 0) {
        unsigned* bar = b.bar; unsigned bx_ = b.x;
        asm volatile("" : "+s"(bar), "+s"(bx_));
        __builtin_amdgcn_s_waitcnt(0);
        unsigned nloc = b.st[0], nx = b.st[1];
        if (nloc == 0u) { xcd_barrier_complete(bar, bx_, nloc, nx); b.st[0] = nloc; b.st[1] = nx; }
        const unsigned old = xb_add(&bar[XB_XSUB(bx_)], 1u);
        const unsigned gen = old / nloc;
        unsigned role = 0u, tg = 0u;
        if (old + 1u == (gen + 1u) * nloc) {
            __builtin_amdgcn_fence(__ATOMIC_RELEASE, "agent");
            asm volatile("s_waitcnt vmcnt(0)" ::: "memory");
            const unsigned og = xb_add(&bar[XB_TOP], 1u);
            tg = og / nx;
            if (og + 1u == (tg + 1u) * nx) { xb_add(&bar[XB_TOPGEN], 1u); role = 2u; } else role = 1u;
        }
        b.st[4] = gen; b.st[5] = role; b.st[6] = tg;
    }
}
__device__ __forceinline__ void xcd_barrier_wait(const XcdBarrier& b, const int wv) {
    if (wv == 0 && lane_id() == 0) {
        unsigned* bar = b.bar; unsigned bx_ = b.x;
        asm volatile("" : "+s"(bar), "+s"(bx_));
        const unsigned gen = b.st[4], role = b.st[5], tg = b.st[6];
        if (role) {
            if (role == 1u) XB_SPIN(xb_ld(&bar[XB_TOPGEN]) == tg, bar);
            __builtin_amdgcn_fence(__ATOMIC_ACQUIRE, "agent");
            xb_add(&bar[XB_XGEN(bx_)], 1u);
            asm volatile("s_waitcnt vmcnt(0)" ::: "memory");
        } else {
            XB_SPIN(xb_ld(&bar[XB_XGEN(bx_)]) == gen, bar);
            __builtin_amdgcn_fence(__ATOMIC_ACQUIRE, "agent");
            asm volatile("s_waitcnt vmcnt(0)" ::: "memory");
        }
    }
    __syncthreads();
}

namespace pg8 {
constexpr int BM = 256, BK = 64, HALF = 128, HTB = HALF * BK * 2, STAGE_BYTES = 8 * HTB, NXCD = 8, WGM = 8;
__host__ __device__ __forceinline__ int lds_byte(int r, int c) { const int st = (r >> 4) * 2 + (c >> 5), rr = r & 15, cc = c & 31, ob = rr * 64 + cc * 2; return st * 1024 + (ob ^ (((ob >> 9) & 1) << 5)); }
__host__ __device__ __forceinline__ void stage_rc(int b, int& R, int& C) { const int st = b / 1024, sb = b % 1024, swz = sb ^ (((sb >> 9) & 1) << 5); R = (st >> 1) * 16 + swz / 64; C = (st & 1) * 32 + (swz % 64) / 2; }
__host__ __device__ __forceinline__ int perm32(int rho) { const int n = rho >> 4, i = rho & 15; return 8 * (i >> 2) + 4 * n + (i & 3); }

struct Unit { int pm, pn; const char* A; const char* B; };

__device__ __forceinline__ void tile_of(int L, int nM, int nN, int& pm, int& pn) {
    const int nwg = nM * nN; int wgid = L;
    { const int q = nwg / NXCD, r = nwg % NXCD, xcd = wgid % NXCD, off = wgid / NXCD; wgid = (xcd < r ? xcd * (q + 1) : r * (q + 1) + (xcd - r) * q) + off; }
    const int nig = WGM * nN, gid = wgid / nig, fm = gid * WGM, gsz = (nM - fm) < WGM ? (nM - fm) : WGM;
    pm = fm + ((wgid % nig) % gsz); pn = (wgid % nig) / gsz;
}

template <class T, class = void> struct HasPre { static constexpr bool value = false; };
template <class T> struct HasPre<T, decltype((void)T::kPre)> { static constexpr bool value = true; };
template <bool FP8 = false, class Epi, class Sched>
__device__ __forceinline__ void gemm_phase(LAS unsigned char* lds, const int wv, const int K, const int lda, const int ldb, const Sched& S, const Epi& E) {
    int tid = wv * 64 + lane_id(); asm volatile("" : "+v"(tid));
    const int wid = __builtin_amdgcn_readfirstlane(tid >> 6), lane = tid & 63, wr = wid >> 2, wc = wid & 3, fr = lane & 15, fq = lane >> 4;
    const int nt = K / BK;
    unsigned voffA, voffB;
    { int R, C; stage_rc(tid * 16, R, C); const int Rb = 64 * (R >> 5) + 8 * ((R >> 2) & 3) + 4 * ((R >> 4) & 1) + (R & 3); voffA = (unsigned)(R * lda + C) * 2u; voffB = (unsigned)(Rb * ldb + C) * 2u; }
    const size_t qstepA = (size_t)64 * lda * 2, qstepB = (size_t)128 * ldb * 2;
    const size_t kstep = (size_t)(BK * 2);
    const size_t hstepA = (size_t)HALF * lda * 2, hstepB = (size_t)32 * ldb * 2;
    const unsigned ldsw = (unsigned)wid * 1024u;
    const unsigned ldsbase = (unsigned)(uintptr_t)lds + ldsw;
    const int aoff = lds_byte(wr * 64 + fr, fq * 8), boff = lds_byte(wc * 32 + fr, fq * 8);
#define PG8_SA(b, h) (((b) * 2 + (h)) * HTB)
#define PG8_SB(b, h) ((4 + (b) * 2 + (h)) * HTB)
#define PG8_STAGE_(bufoff, gbase, voff, qstep) do { _Pragma("unroll") for (int _i = 0; _i < 2; ++_i) { \
        asm volatile("s_mov_b32 m0, %2\n\ts_nop 0\n\tglobal_load_lds_dwordx4 %0, %1" \
            :: "v"(voff), "s"((const char*)(gbase) + (_i ? (qstep) : (size_t)0)), "s"(ldsbase + (unsigned)((bufoff) + _i * 8192)) : "memory", "m0"); } } while (0)
#define PG8_STAGE(bufoff, gbase, voff) PG8_STAGE_(bufoff, gbase, voff, voff##_q)
#define voffA_q qstepA
#define voffB_q qstepB
#define PG8_LDA(dst, b, h) do { _Pragma("unroll") for (int m = 0; m < 4; ++m) _Pragma("unroll") for (int k = 0; k < 2; ++k) dst[m][k] = *(const LAS bf16x8*)(lds + PG8_SA(b, h) + aoff + m * 2048 + k * 1024); } while (0)
#define PG8_LDB(dst, b, h) do { _Pragma("unroll") for (int n = 0; n < 2; ++n) _Pragma("unroll") for (int k = 0; k < 2; ++k) dst[n][k] = *(const LAS bf16x8*)(lds + PG8_SB(b, h) + boff + n * 2048 + k * 1024); } while (0)
#define PG8_CAT8(x0, x1) __builtin_shufflevector(__builtin_bit_cast(i32x4, x0), __builtin_bit_cast(i32x4, x1), 0, 1, 2, 3, 4, 5, 6, 7)
#define PG8_MMA(ai, bj, At, Bt) do { __builtin_amdgcn_s_setprio(1); _Pragma("unroll") for (int m = 0; m < 4; ++m) _Pragma("unroll") for (int n = 0; n < 2; ++n) { \
        if constexpr (FP8) acc[ai][bj][m][n] = __builtin_amdgcn_mfma_scale_f32_16x16x128_f8f6f4(PG8_CAT8(Bt[n][0], Bt[n][1]), PG8_CAT8(At[m][0], At[m][1]), acc[ai][bj][m][n], 0, 0, 0, 0x7f7f7f7f, 0, 0x7f7f7f7f); \
        else { _Pragma("unroll") for (int k = 0; k < 2; ++k) acc[ai][bj][m][n] = __builtin_amdgcn_mfma_f32_16x16x32_bf16(Bt[n][k], At[m][k], acc[ai][bj][m][n], 0, 0, 0); } } \
        __builtin_amdgcn_s_setprio(0); } while (0)
#define PG8_WAIT_V(n) asm volatile("s_waitcnt vmcnt(" #n ")" ::: "memory")
#define PG8_WAIT_L(n) asm volatile("s_waitcnt lgkmcnt(" #n ")" ::: "memory")
#define PG8_BAR __builtin_amdgcn_s_barrier()
#define PG8_SCHED __builtin_amdgcn_sched_barrier(0)
    Unit cur, nxt; int ui = 0;
    if (!S.next(0, cur)) return;
    if constexpr (HasPre<Epi>::value) E.prefetch(cur, wid, lane);
    f32x4 acc[2][2][4][2];
#pragma unroll
    for (int a = 0; a < 2; ++a)
#pragma unroll
        for (int b = 0; b < 2; ++b)
#pragma unroll
            for (int m = 0; m < 4; ++m)
#pragma unroll
                for (int n = 0; n < 2; ++n) acc[a][b][m][n] = (f32x4){0.f, 0.f, 0.f, 0.f};
    bf16x8 At[4][2], B0[2][2], B1[2][2];
    const char* cA = cur.A; const char* cB = cur.B;
    PG8_STAGE(PG8_SB(0, 0), cB, voffB); PG8_STAGE(PG8_SB(0, 1), cB + hstepB, voffB); PG8_STAGE(PG8_SA(0, 0), cA, voffA); PG8_STAGE(PG8_SA(0, 1), cA + hstepA, voffA);
    if (wr == 1) PG8_BAR;
    PG8_WAIT_V(2); PG8_BAR;
    PG8_STAGE(PG8_SB(1, 0), cB + kstep, voffB); PG8_STAGE(PG8_SA(1, 0), cA + kstep, voffA); PG8_STAGE(PG8_SB(1, 1), cB + hstepB + kstep, voffB);
    PG8_WAIT_V(6); PG8_BAR;
    for (;;) {
        const bool has_next = S.next(ui + 1, nxt);
        const char* nA = has_next ? nxt.A : cA; const char* nB = has_next ? nxt.B : cB;
#pragma unroll 1
        for (int t = 0; t < nt; t += 2) {
            const bool last = (t == nt - 2);
            const char* a1 = cA + (size_t)(t + 1) * kstep;
            const char* a2 = last ? nA : cA + (size_t)(t + 2) * kstep; const char* b2 = last ? nB : cB + (size_t)(t + 2) * kstep;
            const char* a3 = a2 + kstep; const char* b3 = b2 + kstep;
            PG8_LDB(B0, 0, 0); PG8_LDB(B1, 0, 1); PG8_SCHED; PG8_LDA(At, 0, 0); PG8_STAGE(PG8_SA(1, 1), a1 + hstepA, voffA);
            PG8_WAIT_V(8); PG8_WAIT_L(0); PG8_BAR; PG8_MMA(0, 0, At, B0); PG8_MMA(0, 1, At, B1); PG8_BAR; PG8_SCHED;
            PG8_LDA(At, 0, 1); PG8_STAGE(PG8_SB(0, 0), b2, voffB); PG8_STAGE(PG8_SB(0, 1), b2 + hstepB, voffB); PG8_STAGE(PG8_SA(0, 0), a2, voffA);
            PG8_WAIT_V(8); PG8_WAIT_L(0); PG8_BAR; PG8_MMA(1, 0, At, B0); PG8_MMA(1, 1, At, B1); PG8_BAR; PG8_SCHED;
            PG8_LDB(B0, 1, 0); PG8_LDB(B1, 1, 1); PG8_SCHED; PG8_LDA(At, 1, 0); PG8_STAGE(PG8_SA(0, 1), a2 + hstepA, voffA);
            PG8_WAIT_V(8); PG8_WAIT_L(0); PG8_BAR; PG8_MMA(0, 0, At, B0); PG8_MMA(0, 1, At, B1); PG8_BAR; PG8_SCHED;
            PG8_LDA(At, 1, 1); PG8_STAGE(PG8_SB(1, 0), b3, voffB); PG8_STAGE(PG8_SB(1, 1), b3 + hstepB, voffB); PG8_STAGE(PG8_SA(1, 0), a3, voffA);
            PG8_WAIT_V(8); PG8_WAIT_L(0); PG8_BAR; PG8_MMA(1, 0, At, B0); PG8_MMA(1, 1, At, B1); PG8_BAR; PG8_SCHED;
        }
        if (wr == 0) PG8_BAR;
        E(acc, cur, wr, wc, fr, fq, lane);
        if constexpr (HasPre<Epi>::value) { if (has_next) E.prefetch(nxt, wid, lane); }
        if (!has_next) break;
#pragma unroll
        for (int a = 0; a < 2; ++a)
#pragma unroll
            for (int b = 0; b < 2; ++b)
#pragma unroll
                for (int m = 0; m < 4; ++m)
#pragma unroll
                    for (int n = 0; n < 2; ++n) acc[a][b][m][n] = (f32x4){0.f, 0.f, 0.f, 0.f};
        cur = nxt; cA = nA; cB = nB; ++ui;
        if (wr == 1) PG8_BAR;
    }
    PG8_WAIT_V(0);
    PG8_BAR;
#undef PG8_SA
#undef PG8_SB
#undef PG8_STAGE
#undef PG8_STAGE_
#undef voffA_q
#undef voffB_q
#undef PG8_LDA
#undef PG8_LDB
#undef PG8_MMA
#undef PG8_CAT8
#undef PG8_WAIT_V
#undef PG8_WAIT_L
#undef PG8_BAR
#undef PG8_SCHED
}

struct OrdStd {
    int nM, nN, G, c; const char* A; const char* B; size_t astep, bstep; int ashift, acolb;
    __device__ __forceinline__ bool next(int i, Unit& u) const { const int L = i * G + c; if (L >= nM * nN) return false; tile_of(L, nM, nN, u.pm, u.pn);
        u.A = A + (size_t)u.pm * astep + (size_t)((u.pn >> ashift) * acolb); u.B = B + (size_t)u.pn * bstep; return true; }
};
struct OrdQKV8 {
    int G, c; const char* A; const char* B;
    __device__ __forceinline__ bool next(int i, Unit& u) const { const int x = c & 7, e = (c >> 3) + i * (G >> 3); int j, n;
        if (x & 1) { if (e < 144) { j = e % 6; n = e / 6; } else if (e < 160) { j = 6 + ((e - 144) & 1); n = (e - 144) >> 1; } else return false; }
        else { if (e >= 192) return false; j = e & 7; n = e >> 3; }
        u.pm = 8 * x + j; u.pn = n; u.A = A + (size_t)u.pm * (256 * D) + 0; u.B = B + (size_t)n * (256 * D); return true; }
};
struct OrdQKVTail {
    int G, c; const char* A; const char* B;
    __device__ __forceinline__ bool next(int i, Unit& u) const { const int x = c & 7, r = c >> 3; if (i > 0 || !(x & 1) || r >= 32) return false;
        u.pm = 8 * x + 6 + (r & 1); u.pn = 8 + (r >> 1); u.A = A + (size_t)u.pm * (256 * D * 2); u.B = B + (size_t)u.pn * (256 * D * 2); return true; }
};
struct OrdS {
    int G, c; const char* A; const char* B;
    __device__ __forceinline__ bool next(int i, Unit& u) const { const int L = i * G + c; if (L >= 256) return false; tile_of(L, 64, 4, u.pm, u.pn);
        u.A = A + (size_t)u.pm * (256 * D * 2) + (size_t)u.pn * 1024; u.B = B + (size_t)(u.pm >> 4) * (256 * D * 2) + (size_t)u.pn * 1024; return true; }
};
struct OrdPV {
    int G, c; const char* A; const char* B;
    __device__ __forceinline__ bool next(int i, Unit& u) const { const int L = i * G + c; if (L >= 512) return false; tile_of(L, 64, 8, u.pm, u.pn);
        u.A = A + (size_t)u.pm * (256 * 1024 * 2) + (size_t)(u.pn >> 1) * 512; u.B = B + (size_t)(u.pm >> 4) * (D * 256 * 2) + (size_t)u.pn * (256 * 256 * 2); return true; }
};
struct OrdPV2 {
    int G, c; const char* A; const char* B;
    __device__ __forceinline__ bool next(int i, Unit& u) const { if (c >= 256 || i >= 2) return false; int h; tile_of(c, 64, 4, u.pm, h); u.pn = 2 * h + i;
        u.A = A + (size_t)u.pm * (256 * 1024 * 2) + (size_t)h * 512; u.B = B + (size_t)(u.pm >> 4) * (D * 256 * 2) + (size_t)u.pn * (256 * 256 * 2); return true; }
};
struct OrdMemKV {
    int G, c; const char* memb; const char* wt;
    __device__ __forceinline__ bool next(int i, Unit& u) const { const int L = i * G + c; if (L >= 256) return false; const int layer = L >> 6, r = L & 63;
        const char* w = wt + (size_t)layer * (4096 * (size_t)D * 2);
        if (r < 32) { const int tp = r & 3, pn = r >> 2; u.pm = layer * 64 + tp; u.pn = pn; u.A = memb + (size_t)tp * (256 * D * 2); u.B = w + (size_t)pn * (256 * D * 2); }
        else { const int q = r - 32, b = q & 3, vp = q >> 2; u.pm = layer * 64 + 32 + vp; u.pn = b; u.A = w + (size_t)(D + 256 * vp) * (D * 2); u.B = memb + (size_t)b * (256 * D * 2); }
        return true; }
};

__device__ __forceinline__ void wave_stats_load(const float* st, int row0, int lane, bool idn, f32x4 (&v)[2][4]) {
    if (idn) return;
#pragma unroll
    for (int j = 0; j < 2; ++j)
#pragma unroll
        for (int m = 0; m < 4; ++m) v[j][m] = *(const f32x4*)(st + (size_t)((unsigned)(row0 + 128 * j + 16 * m + (lane >> 2)) * 16u + (unsigned)(4 * (lane & 3))));
}
__device__ __forceinline__ void wave_stats_fin(const f32x4 (&v)[2][4], int lane, bool idn, float (&mu)[2][4], float (&rs)[2][4]) {
    if (idn) {
#pragma unroll
        for (int j = 0; j < 2; ++j)
#pragma unroll
            for (int m = 0; m < 4; ++m) { mu[j][m] = 0.f; rs[j][m] = 1.f; }
        return; }
    float invd = 1.f / D, eps = LN_EPS; asm volatile("" : "+s"(invd), "+s"(eps));
    const int a1 = (lane ^ 1) << 2, a2 = (lane ^ 2) << 2;
#pragma unroll
    for (int j = 0; j < 2; ++j)
#pragma unroll
        for (int m = 0; m < 4; ++m) {
            float s = v[j][m][0] + v[j][m][2], q = v[j][m][1] + v[j][m][3];
            s += __builtin_bit_cast(float, __builtin_amdgcn_ds_bpermute(a1, __builtin_bit_cast(int, s))); q += __builtin_bit_cast(float, __builtin_amdgcn_ds_bpermute(a1, __builtin_bit_cast(int, q)));
            s += __builtin_bit_cast(float, __builtin_amdgcn_ds_bpermute(a2, __builtin_bit_cast(int, s))); q += __builtin_bit_cast(float, __builtin_amdgcn_ds_bpermute(a2, __builtin_bit_cast(int, q)));
            const float mm = s * invd, var = q * invd - mm * mm;
            mu[j][m] = mm; rs[j][m] = __builtin_amdgcn_rsqf(var + eps);
        }
}
#define EPI_OPAQUE int pm = u.pm, pn = u.pn, ln_ = lane_id(); (void)lane; asm volatile("" : "+s"(pm), "+s"(pn), "+v"(ln_)); const int fr = ln_ & 15, fq = ln_ >> 4; (void)fr_; (void)fq_; \
        int rl = 64 * wr + fr;
#define EPI_ROWLOOP_BEGIN _Pragma("unroll") for (int ai = 0; ai < 2; ++ai) _Pragma("unroll") for (int m = 0; m < 4; ++m) { \
        asm volatile("" : "+v"(rl)); const float mr = shl(mu[ai][m], 4 * fr), rr = shl(rs[ai][m], 4 * fr);
#define EPI_ROWLOOP_END asm volatile("" ::: "memory"); rl += (m == 3) ? 80 : 16; }

struct EpiQKV {
    const float* st; bool idn; const float* uvec; const float* cvec;
    bf16_t* qkv; bf16_t* kvs; float* okp; float* oks;
    __device__ __forceinline__ void operator()(const f32x4 (&acc)[2][2][4][2], const Unit& u, int wr, int wc, int fr_, int fq_, int lane) const {
        EPI_OPAQUE
        const int which = pn >> 3; const bool smp = (pm == 64), tail = (!smp) && ((pm & 15) >= 14);
        f32x4 sv_[2][4]; wave_stats_load(st, pm * 256 + wr * 64, ln_, idn, sv_);
#define STATS_FIN float mu[2][4], rs[2][4]; wave_stats_fin(sv_, ln_, idn, mu, rs);
        const int colb = pn * 256 + wc * 64 + 8 * fq;
        f32x4 uu[2][2], cc[2][2];
#pragma unroll
        for (int bj = 0; bj < 2; ++bj)
#pragma unroll
            for (int n = 0; n < 2; ++n) { if (idn) { uu[bj][n] = (f32x4){0.f, 0.f, 0.f, 0.f}; cc[bj][n] = uu[bj][n]; }
                else { uu[bj][n] = *(const f32x4*)(uvec + colb + 32 * bj + 4 * n); cc[bj][n] = *(const f32x4*)(cvec + colb + 32 * bj + 4 * n); } }
        STATS_FIN
#undef STATS_FIN
        EPI_ROWLOOP_BEGIN
            const unsigned r = (unsigned)pm * 256u + (unsigned)rl;
            const float nrm = -rr * mr;
#pragma unroll
            for (int bj = 0; bj < 2; ++bj) {
                float v[8];
#pragma unroll
                for (int n = 0; n < 2; ++n)
#pragma unroll
                    for (int e = 0; e < 4; ++e) v[4 * n + e] = __builtin_fmaf(rr, acc[ai][bj][m][n][e], __builtin_fmaf(nrm, uu[bj][n][e], cc[bj][n][e]));
                const int col = colb + 32 * bj;
                *(u32x4*)(qkv + (size_t)(r * 6144u + (unsigned)col)) = pack8(v);
                if (which) {
                    const int colh = col - 2048 * which;
                    if (smp) { const int b = rl >> 5, t = rl & 31;
                        *(u32x4*)(kvs + (size_t)((unsigned)(((which - 1) * SBAT + b) * KVROWS + 512 + t) * (unsigned)D + (unsigned)colh)) = pack8(v);
                        float* o = oks + (size_t)(which - 1) * (O_AVS - O_AKS) + (size_t)((unsigned)rl * (unsigned)D + (unsigned)colh);
                        *(f32x4*)o = (f32x4){v[0], v[1], v[2], v[3]}; *(f32x4*)(o + 4) = (f32x4){v[4], v[5], v[6], v[7]}; }
                    else if (tail) { const int b = pm >> 4, pos = (pm & 15) * 256 + rl - 3584;
                        float* o = okp + (size_t)(which - 1) * (O_AVP - O_AKP) + (size_t)((unsigned)(b * 512 + pos) * (unsigned)D + (unsigned)colh);
                        *(f32x4*)o = (f32x4){v[0], v[1], v[2], v[3]}; *(f32x4*)(o + 4) = (f32x4){v[4], v[5], v[6], v[7]}; }
                }
            }
        EPI_ROWLOOP_END
    }
};
struct EpiNone { __device__ __forceinline__ void operator()(const f32x4 (&acc)[2][2][4][2], const Unit& u, int wr, int wc, int fr_, int fq_, int lane) const {
#pragma unroll
        for (int a = 0; a < 2; ++a)
#pragma unroll
            for (int b = 0; b < 2; ++b)
#pragma unroll
                for (int m = 0; m < 4; ++m)
#pragma unroll
                    for (int n = 0; n < 2; ++n) asm volatile("" :: "v"(acc[a][b][m][n])); } };
struct EpiQKV8 {
    const float* st; bool idn; const float* uvec; const float* cvec; bf16_t* qkv;
    __device__ __forceinline__ void operator()(const f32x4 (&acc)[2][2][4][2], const Unit& u, int wr, int wc, int fr_, int fq_, int lane) const {
        EPI_OPAQUE
        float kw = W8_INV; asm volatile("" : "+s"(kw));
        const float qs = 1.0f + (QSCALE - 1.0f) * (float)(pn < 8 ? 1 : 0);
        f32x4 sv_[2][4]; wave_stats_load(st, pm * 256 + wr * 64, ln_, idn, sv_);
        const int colb = pn * 256 + wc * 64 + 8 * fq;
        f32x4 uu[2][2], cc[2][2];
#pragma unroll
        for (int bj = 0; bj < 2; ++bj)
#pragma unroll
            for (int n = 0; n < 2; ++n) { if (idn) { uu[bj][n] = (f32x4){0.f, 0.f, 0.f, 0.f}; cc[bj][n] = uu[bj][n]; }
                else { uu[bj][n] = *(const f32x4*)(uvec + colb + 32 * bj + 4 * n); cc[bj][n] = *(const f32x4*)(cvec + colb + 32 * bj + 4 * n); } }
        float mu[2][4], rs[2][4]; wave_stats_fin(sv_, ln_, idn, mu, rs);
        EPI_ROWLOOP_BEGIN
            const unsigned r = (unsigned)pm * 256u + (unsigned)rl;
            const float rw = rr * kw * qs, nrm = -rr * mr * qs;
#pragma unroll
            for (int bj = 0; bj < 2; ++bj) {
                float v[8];
#pragma unroll
                for (int n = 0; n < 2; ++n)
#pragma unroll
                    for (int e = 0; e < 4; ++e) v[4 * n + e] = __builtin_fmaf(rw, acc[ai][bj][m][n][e], __builtin_fmaf(nrm, uu[bj][n][e], cc[bj][n][e] * qs));
                *(u32x4*)(qkv + (size_t)(r * 6144u + (unsigned)(colb + 32 * bj))) = pack8(v);
            }
        EPI_ROWLOOP_END
    }
};
struct EpiLinBf16 {
    const float* st; const float* uvec; const float* cvec; bf16_t* out; float ascale;
    __device__ __forceinline__ void operator()(const f32x4 (&acc)[2][2][4][2], const Unit& u, int wr, int wc, int fr_, int fq_, int lane) const {
        EPI_OPAQUE
        float as_ = ascale; asm volatile("" : "+s"(as_));
        f32x4 sv_[2][4]; wave_stats_load(st, pm * 256 + wr * 64, ln_, false, sv_);
#define STATS_FIN float mu[2][4], rs[2][4]; wave_stats_fin(sv_, ln_, false, mu, rs);
        const int colb = pn * 256 + wc * 64 + 8 * fq;
        f32x4 uu[2][2], cc[2][2];
#pragma unroll
        for (int bj = 0; bj < 2; ++bj)
#pragma unroll
            for (int n = 0; n < 2; ++n) { uu[bj][n] = *(const f32x4*)(uvec + colb + 32 * bj + 4 * n); cc[bj][n] = *(const f32x4*)(cvec + colb + 32 * bj + 4 * n); }
        STATS_FIN
#undef STATS_FIN
        EPI_ROWLOOP_BEGIN
            const unsigned eo = ((unsigned)pm * 256u + (unsigned)rl) * (unsigned)D + (unsigned)colb;
            const float rw = rr * as_, rm = rr * mr;
#pragma unroll
            for (int bj = 0; bj < 2; ++bj) {
                float v[8];
#pragma unroll
                for (int n = 0; n < 2; ++n)
#pragma unroll
                    for (int e = 0; e < 4; ++e) v[4 * n + e] = __builtin_fmaf(rw, acc[ai][bj][m][n][e], __builtin_fmaf(-rm, uu[bj][n][e], cc[bj][n][e]));
                *(u32x4*)(out + (size_t)(eo + 32u * bj)) = pack8(v);
            }
        EPI_ROWLOOP_END
    }
};
struct EpiFfnIn {
    static constexpr bool kPre = true;
    const float* st; const float* uvec; const float* cvec; unsigned char* H; LAS char* lv; mutable int wpar, rpar, cpm;
    __device__ __forceinline__ void prefetch(const Unit& u, int wid, int lane) const {
        const float* src = wid < 4 ? uvec : cvec;
        const unsigned vo = (unsigned)(u.pn * 256 + (wid & 3) * 64 + lane) * 4u;
        const unsigned dst = (unsigned)(uintptr_t)lv + (unsigned)wpar * 2048u + (unsigned)wid * 256u;
        asm volatile("s_mov_b32 m0, %2\n\ts_nop 0\n\tglobal_load_lds_dword %0, %1" :: "v"(vo), "s"(src), "s"(dst) : "memory", "m0");
        wpar ^= 1;
    }
    __device__ __forceinline__ void operator()(const f32x4 (&acc)[2][2][4][2], const Unit& u, int wr, int wc, int fr_, int fq_, int lane) const {
        EPI_OPAQUE
        float kw = W8_INV, kh = H8_SCALE, lim = 448.f; asm volatile("" : "+s"(kw), "+s"(kh), "+v"(lim));
        const float nlim = -lim; float nl2e = -LOG2E; asm volatile("" : "+s"(nl2e));
        LAS f32x2* tabs = (LAS f32x2*)(lv + 4096);
        if (cpm != pm) {
            f32x4 sv_[2][4]; wave_stats_load(st, pm * 256 + wr * 64, ln_, false, sv_);
            float mu[2][4], rs[2][4]; wave_stats_fin(sv_, ln_, false, mu, rs);
            asm volatile("s_waitcnt lgkmcnt(0)" ::: "memory"); __builtin_amdgcn_s_barrier();
            if (wc == 0 && (ln_ & 3) == 0) {
#pragma unroll
                for (int j = 0; j < 2; ++j)
#pragma unroll
                    for (int m = 0; m < 4; ++m) tabs[128 * j + 64 * wr + 16 * m + (ln_ >> 2)] = (f32x2){mu[j][m], rs[j][m]}; }
            asm volatile("s_waitcnt lgkmcnt(0)" ::: "memory"); __builtin_amdgcn_s_barrier(); asm volatile("" ::: "memory");
            cpm = pm;
        }
        LAS const f32x4* vb = (LAS const f32x4*)(lv + rpar * 2048); rpar ^= 1;
        const int cq = wc * 16 + 2 * fq;
        f32x4 uu[2][2], cc[2][2];
#pragma unroll
        for (int bj = 0; bj < 2; ++bj)
#pragma unroll
            for (int n = 0; n < 2; ++n) { uu[bj][n] = vb[cq + 8 * bj + n]; cc[bj][n] = vb[64 + cq + 8 * bj + n]; }
#pragma unroll
        for (int n = 0; n < 2; ++n) cc[1][n] = cc[1][n] * kh;
#pragma unroll
        for (int ai = 0; ai < 2; ++ai)
#pragma unroll
            for (int m = 0; m < 4; ++m) { asm volatile("" : "+v"(rl));
            const f32x2 ms_ = tabs[128 * ai + 64 * wr + 16 * m + fr]; const float mr = ms_[0], rr = ms_[1];
            const float rw = rr * kw, rm = rr * mr, rwu = rw * kh, rmu = rm * kh;
            float v[8];
#pragma unroll
            for (int n = 0; n < 2; ++n) {
#pragma unroll
                for (int e = 0; e < 4; ++e) { const float g = __builtin_fmaf(rw, acc[ai][0][m][n][e], __builtin_fmaf(-rm, uu[0][n][e], cc[0][n][e]));
                    const float inv = __builtin_amdgcn_rcpf(1.0f + __builtin_amdgcn_exp2f(g * nl2e));
                    const float up = __builtin_fmaf(rwu, acc[ai][1][m][n][e], __builtin_fmaf(-rmu, uu[1][n][e], cc[1][n][e]));
                    v[4 * n + e] = __builtin_amdgcn_fmed3f(g * up * inv, nlim, lim); }
            }
            if (PROBE_ID != 413 || H) *(u32x2*)(H + (size_t)(((unsigned)pm * 256u + (unsigned)rl) * (unsigned)DFF + (unsigned)(pn * 128 + wc * 32 + 8 * fq))) = pack8_fp8(v);
            else asm volatile("" :: "v"(v[0]), "v"(v[1]), "v"(v[2]), "v"(v[3]), "v"(v[4]), "v"(v[5]), "v"(v[6]), "v"(v[7]));
        EPI_ROWLOOP_END
    }
};
template <bool POOL, bool Z8 = false> struct EpiRes {
    const float* st_old; float* st_new; bool idn; const float* xp; const float* xs; half_t* zf; bf16_t* zb; const float* g; const float* b; const float* psc; LAS f32x2* red; float ascale; half_t* zfo; unsigned char* z8x;
    __device__ __forceinline__ void operator()(const f32x4 (&acc)[2][2][4][2], const Unit& u, int wr, int wc, int fr_, int fq_, int lane) const {
        EPI_OPAQUE
        float as_ = ascale; asm volatile("" : "+s"(as_));
        f32x4 sv_[2][4]; wave_stats_load(st_old, pm * 256 + wr * 64, ln_, idn, sv_);
#define STATS_FIN float mu[2][4], rs[2][4]; wave_stats_fin(sv_, ln_, idn, mu, rs);
        const float* zo = pm < 64 ? xp + (size_t)pm * 256 * D : xs;
        const half_t* zoh = zf + (size_t)pm * 256 * D;
        const int colb = pn * 256 + wc * 64 + 8 * fq;
        f32x4 gA[2][2], bA[2][2], ps[2][2];
#pragma unroll
        for (int bj = 0; bj < 2; ++bj)
#pragma unroll
            for (int n = 0; n < 2; ++n) { const int c = colb + 32 * bj + 4 * n;
                if (idn) { gA[bj][n] = (f32x4){ALPHA, ALPHA, ALPHA, ALPHA}; bA[bj][n] = (f32x4){0.f, 0.f, 0.f, 0.f}; }
                else { gA[bj][n] = *(const f32x4*)(g + c) * ALPHA; bA[bj][n] = *(const f32x4*)(b + c) * ALPHA; }
                if (POOL) ps[bj][n] = *(const f32x4*)(psc + c); }
        u32x4 zq[8][2];
#define EPIRES_ZLOAD(gi) do { if (!idn) { _Pragma("unroll") for (int bj_ = 0; bj_ < 2; ++bj_) \
            zq[gi][bj_] = *(const u32x4*)(zoh + (size_t)((unsigned)(128 * ((gi) >> 2) + 64 * wr + 16 * ((gi) & 3) + fr) * (unsigned)D + (unsigned)(colb + 32 * bj_))); } } while (0)
        constexpr int ZPD = POOL ? 1 : 2;
        EPIRES_ZLOAD(0); if (ZPD > 1) EPIRES_ZLOAD(1);
        STATS_FIN
#undef STATS_FIN
        EPI_ROWLOOP_BEGIN
            if (4 * ai + m + ZPD < 8) EPIRES_ZLOAD(4 * ai + m + ZPD);
            const unsigned lo = (unsigned)rl * (unsigned)D + (unsigned)colb;
            const unsigned eo = (unsigned)pm * (256u * D) + lo;
            const float nmr = -mr * rr;
            float s = 0.f, q = 0.f;
#pragma unroll
            for (int bj = 0; bj < 2; ++bj) {
                float zz[8];
                if (idn) { const f32x4 z0 = *(const f32x4*)(zo + (size_t)(lo + 32u * bj)), z1 = *(const f32x4*)(zo + (size_t)(lo + 32u * bj + 4u));
#pragma unroll
                    for (int e = 0; e < 4; ++e) { zz[e] = z0[e]; zz[4 + e] = z1[e]; } }
                else unpack8h(zq[4 * ai + m][bj], zz);
                float v[8];
#pragma unroll
                for (int e = 0; e < 4; ++e) {
                    float a0 = acc[ai][bj][m][0][e] * as_, a1 = acc[ai][bj][m][1][e] * as_;
                    if (POOL) { a0 *= ps[bj][0][e]; a1 *= ps[bj][1][e]; }
                    v[e] = __builtin_fmaf(__builtin_fmaf(zz[e], rr, nmr), gA[bj][0][e], bA[bj][0][e] + a0);
                    v[4 + e] = __builtin_fmaf(__builtin_fmaf(zz[4 + e], rr, nmr), gA[bj][1][e], bA[bj][1][e] + a1);
                }
#pragma unroll
                for (int e = 0; e < 8; ++e) { s += v[e]; q += v[e] * v[e]; }
                *(u32x4*)(zfo + (size_t)(eo + 32u * bj)) = pack8h(v);
                if (Z8) *(u32x2*)((unsigned char*)zb + (size_t)(eo + 32u * bj)) = pack8_fp8(v);
                else { if (zb && (pm & 15) >= 14) *(u32x4*)(zb + (size_t)(eo + 32u * bj)) = pack8(v); if (z8x) *(u32x2*)(z8x + (size_t)(eo + 32u * bj)) = pack8_fp8(v); }
            }
            s += shx(s, 16); s += shx(s, 32); q += shx(q, 16); q += shx(q, 32);
            if (fq == 0) red[((wr * 4 + wc) * 128 + 64 * ai + 16 * m + fr)] = (f32x2){s, q};
        EPI_ROWLOOP_END
        asm volatile("s_waitcnt lgkmcnt(0)" ::: "memory"); __builtin_amdgcn_s_barrier(); asm volatile("" ::: "memory");
        if (ln_ < 32) { const int hrow = 32 * wc + ln_; f32x2 t = red[(wr * 4 + 0) * 128 + hrow];
            t += red[(wr * 4 + 1) * 128 + hrow]; t += red[(wr * 4 + 2) * 128 + hrow]; t += red[(wr * 4 + 3) * 128 + hrow];
            const int rrow = 128 * (hrow >> 6) + 64 * wr + (hrow & 63);
            *(f32x2*)(st_new + (size_t)(((unsigned)pm * 256u + (unsigned)rrow) * 16u + (unsigned)(pn * 2))) = t; }
        asm volatile("s_waitcnt lgkmcnt(0)" ::: "memory");
    }
};
#define EPI_PLAINLOOP_BEGIN _Pragma("unroll") for (int ai = 0; ai < 2; ++ai) _Pragma("unroll") for (int m = 0; m < 4; ++m) { asm volatile("" : "+v"(rl));
struct EpiS {
    float* S;
    __device__ __forceinline__ void operator()(const f32x4 (&acc)[2][2][4][2], const Unit& u, int wr, int wc, int fr_, int fq_, int lane) const {
        EPI_OPAQUE
        EPI_PLAINLOOP_BEGIN
            float* o = S + (size_t)(((unsigned)pm * 256u + (unsigned)rl) * 1024u + (unsigned)(pn * 256 + wc * 64 + 8 * fq));
#pragma unroll
            for (int bj = 0; bj < 2; ++bj) { *(f32x4*)(o + 32 * bj) = acc[ai][bj][m][0]; *(f32x4*)(o + 32 * bj + 4) = acc[ai][bj][m][1]; }
        EPI_ROWLOOP_END
    }
};
struct EpiSoftP {
    bf16_t* P; LAS float* tab;
    __device__ __forceinline__ void operator()(f32x4 (&acc)[2][2][4][2], const Unit& u, int wr, int wc, int fr_, int fq_, int lane) const {
        EPI_OPAQUE
        float c2 = 0.04419417382415922f * LOG2E; asm volatile("" : "+s"(c2));
        LAS float* t0 = tab + (wr * 4) * 128; LAS float* t1 = tab + 1024 + (wr * 4) * 128;
#pragma unroll
        for (int ai = 0; ai < 2; ++ai)
#pragma unroll
            for (int m = 0; m < 4; ++m) { float mx = acc[ai][0][m][0][0];
#pragma unroll
                for (int bj = 0; bj < 2; ++bj)
#pragma unroll
                    for (int n = 0; n < 2; ++n)
#pragma unroll
                        for (int e = 0; e < 4; ++e) mx = fmaxf(mx, acc[ai][bj][m][n][e]);
                mx = fmaxf(mx, shx(mx, 16)); mx = fmaxf(mx, shx(mx, 32));
                if (fq == 0) t0[wc * 128 + 64 * ai + 16 * m + fr] = mx; }
        asm volatile("s_waitcnt lgkmcnt(0)" ::: "memory"); __builtin_amdgcn_s_barrier(); asm volatile("" ::: "memory");
#pragma unroll
        for (int ai = 0; ai < 2; ++ai)
#pragma unroll
            for (int m = 0; m < 4; ++m) { const int hr = 64 * ai + 16 * m + fr;
                const float mx = fmaxf(fmaxf(t0[hr], t0[128 + hr]), fmaxf(t0[256 + hr], t0[384 + hr])); float s = 0.f;
#pragma unroll
                for (int bj = 0; bj < 2; ++bj)
#pragma unroll
                    for (int n = 0; n < 2; ++n)
#pragma unroll
                        for (int e = 0; e < 4; ++e) { const float p = __builtin_amdgcn_exp2f((acc[ai][bj][m][n][e] - mx) * c2); acc[ai][bj][m][n][e] = p; s += p; }
                s += shx(s, 16); s += shx(s, 32);
                if (fq == 0) t1[wc * 128 + hr] = s; }
        asm volatile("s_waitcnt lgkmcnt(0)" ::: "memory"); __builtin_amdgcn_s_barrier(); asm volatile("" ::: "memory");
        EPI_PLAINLOOP_BEGIN
            const int hr = 64 * ai + 16 * m + fr;
            const float inv = __builtin_amdgcn_rcpf((t1[hr] + t1[128 + hr]) + (t1[256 + hr] + t1[384 + hr]));
            bf16_t* o = P + (size_t)(((unsigned)pm * 256u + (unsigned)rl) * 1024u + (unsigned)(pn * 256 + wc * 64 + 8 * fq));
#pragma unroll
            for (int bj = 0; bj < 2; ++bj) { const f32x4 a = acc[ai][bj][m][0] * inv, c = acc[ai][bj][m][1] * inv; const float v[8] = {a[0], a[1], a[2], a[3], c[0], c[1], c[2], c[3]};
                *(u32x4*)(o + 32 * bj) = pack8(v); }
        EPI_ROWLOOP_END
    }
};
struct EpiO8 {
    unsigned char* out;
    __device__ __forceinline__ void operator()(const f32x4 (&acc)[2][2][4][2], const Unit& u, int wr, int wc, int fr_, int fq_, int lane) const {
        EPI_OPAQUE
        float ko = O8_SCALE; asm volatile("" : "+s"(ko));
        EPI_PLAINLOOP_BEGIN
            unsigned char* o = out + (size_t)(((unsigned)pm * 256u + (unsigned)rl) * (unsigned)D + (unsigned)(pn * 256 + wc * 64 + 8 * fq));
#pragma unroll
            for (int bj = 0; bj < 2; ++bj) { const f32x4 a = acc[ai][bj][m][0] * ko, c = acc[ai][bj][m][1] * ko; const float v[8] = {a[0], a[1], a[2], a[3], c[0], c[1], c[2], c[3]};
                *(u32x2*)(o + 32 * bj) = pack8_fp8(v); }
        EPI_ROWLOOP_END
    }
};
struct EpiMemKV {
    bf16_t* mkp; bf16_t* mvtp; float* ok; float* ov;
    __device__ __forceinline__ void operator()(const f32x4 (&acc)[2][2][4][2], const Unit& u, int wr, int wc, int fr_, int fq_, int lane) const {
        EPI_OPAQUE
        const int layer = pm >> 6, r6 = pm & 63;
        EPI_PLAINLOOP_BEGIN
#pragma unroll
            for (int bj = 0; bj < 2; ++bj) { const f32x4 a = acc[ai][bj][m][0], c = acc[ai][bj][m][1]; const float v[8] = {a[0], a[1], a[2], a[3], c[0], c[1], c[2], c[3]};
                const int cl = 32 * bj + wc * 64 + 8 * fq;
                if (r6 < 32) { const unsigned eo = (unsigned)(layer * 1024 + r6 * 256 + rl) * (unsigned)D + (unsigned)(pn * 256 + cl);
                    *(u32x4*)(mkp + (size_t)eo) = pack8(v);
                    float* o = ok + (size_t)eo; *(f32x4*)o = a; *(f32x4*)(o + 4) = c; }
                else { const int vcol = (r6 - 32) * 256 + rl, bb = pn;
                    *(u32x4*)(mvtp + (size_t)((unsigned)((layer * NB + bb) * D + vcol) * 256u + (unsigned)cl)) = pack8(v);
                    float* o = ov + (size_t)((unsigned)((layer * NB + bb) * 256 + cl) * (unsigned)D + (unsigned)vcol);
#pragma unroll
                    for (int e = 0; e < 8; ++e) o[(size_t)e * D] = v[e]; }
            }
        EPI_ROWLOOP_END
    }
};

struct OrdMemKV2 {
    int G, c; const char* memb; const char* wt;
    __device__ __forceinline__ bool next(int i, Unit& u) const { const int L = i * G + c; if (L >= 256) return false; const int layer = L >> 6, r = L & 63, tp = r & 3, pn = r >> 2;
        u.pm = layer * 4 + tp; u.pn = pn; u.A = memb + (size_t)tp * (256 * D * 2); u.B = wt + (size_t)layer * (4096 * (size_t)D * 2) + (size_t)pn * (256 * D * 2); return true; }
};
struct EpiMemKV2 {
    unsigned char* k8; unsigned char* v8; float* ok; float* ov;
    __device__ __forceinline__ void operator()(const f32x4 (&acc)[2][2][4][2], const Unit& u, int wr, int wc, int fr_, int fq_, int lane) const {
        EPI_OPAQUE
        const int isv = pn >> 3; const float sc8 = 1.f + (MV8_SCALE - 1.f) * (float)isv;
        float* of = ok + (size_t)isv * (size_t)(ov - ok); unsigned char* o8 = k8 + (size_t)isv * (size_t)(v8 - k8);
        EPI_PLAINLOOP_BEGIN
            const unsigned eo = ((unsigned)pm * 256u + (unsigned)rl) * (unsigned)D + (unsigned)((pn & 7) * 256 + wc * 64 + 8 * fq);
#pragma unroll
            for (int bj = 0; bj < 2; ++bj) { const f32x4 a = acc[ai][bj][m][0], c = acc[ai][bj][m][1];
                float* o = of + (size_t)(eo + 32u * bj); *(f32x4*)o = a; *(f32x4*)(o + 4) = c;
                const float v[8] = {a[0] * sc8, a[1] * sc8, a[2] * sc8, a[3] * sc8, c[0] * sc8, c[1] * sc8, c[2] * sc8, c[3] * sc8};
                *(u32x2*)(o8 + (size_t)(eo + 32u * bj)) = pack8_fp8(v); }
        EPI_ROWLOOP_END
    }
};
struct OrdW12 {
    int G, c; const char* k8; const char* wqr; const char* wmo_; const char* v8;
    __device__ __forceinline__ bool next(int i, Unit& u) const { if (i >= 4) return false; const int v = (c & 7) * 128 + (c >> 3) + (G >> 3) * i; if (v >= 1024) return false;
        const int idx = v & 511, l = idx >> 7, b = (idx >> 5) & 3, h = (idx >> 3) & 3, t = idx & 7; u.pm = v; u.pn = t;
        if (v < 512) { u.A = k8 + ((size_t)(l * 1024 + b * 256) * D) + h * 512; u.B = wqr + ((size_t)(l * 2048 + t * 256) * D) + h * 512; }
        else { u.A = wmo_ + ((size_t)(l * 2048 + t * 256) * D) + h * 512; u.B = v8 + ((size_t)(l * 1024 + b * 256) * D) + h * 512; }
        return true; }
};
struct EpiW12 {
    unsigned char* w1_; unsigned char* w2_; float* u1; float* c1; const float* lg; const float* lb;
    __device__ __forceinline__ void operator()(const f32x4 (&acc)[2][2][4][2], const Unit& u, int wr, int wc, int fr_, int fq_, int lane) const {
        EPI_OPAQUE
        const int idx = pm & 511, l = idx >> 7, b = (idx >> 5) & 3, h = (idx >> 3) & 3, t = pn;
        if (pm < 512) {
            float k1 = W1_SCALE / WQR_SCALE, ki = 1.f / W1_SCALE; asm volatile("" : "+s"(k1), "+s"(ki));
            const int colb = t * 256 + wc * 64 + 8 * fq;
            f32x4 bg[2][2];
#pragma unroll
            for (int bj = 0; bj < 2; ++bj)
#pragma unroll
                for (int n = 0; n < 2; ++n) { const f32x4 gg = *(const f32x4*)(lg + (size_t)(l * 3) * D + colb + 32 * bj + 4 * n), bb = *(const f32x4*)(lb + (size_t)(l * 3) * D + colb + 32 * bj + 4 * n);
#pragma unroll
                    for (int e = 0; e < 4; ++e) bg[bj][n][e] = bb[e] * __builtin_amdgcn_rcpf(gg[e]) * ki; }
            EPI_PLAINLOOP_BEGIN
                const unsigned nrow = (unsigned)((l * NB + b) * 1024 + h * 256) + (unsigned)rl; float su = 0.f, sc = 0.f;
#pragma unroll
                for (int bj = 0; bj < 2; ++bj) { const f32x4 a = acc[ai][bj][m][0] * k1, c = acc[ai][bj][m][1] * k1; const float v[8] = {a[0], a[1], a[2], a[3], c[0], c[1], c[2], c[3]};
                    const u32x2 w = pack8_fp8(v); *(u32x2*)(w1_ + (size_t)(nrow * (unsigned)D + (unsigned)(colb + 32 * bj))) = w;
                    su += sum4_fp8(w.x) + sum4_fp8(w.y);
#pragma unroll
                    for (int e = 0; e < 4; ++e) sc += a[e] * bg[bj][0][e] + c[e] * bg[bj][1][e]; }
                su += shx(su, 16); su += shx(su, 32); sc += shx(sc, 16); sc += shx(sc, 32);
                if (fq == 0) { atomicAdd(u1 + nrow, su * ki); atomicAdd(c1 + nrow, sc); }
            EPI_ROWLOOP_END
        } else {
            float k2 = W2_SCALE / (W8_SCALE * MV8_SCALE); asm volatile("" : "+s"(k2));
            EPI_PLAINLOOP_BEGIN
                unsigned char* o = w2_ + (size_t)(((unsigned)((l * NB + b) * D + t * 256) + (unsigned)rl) * 1024u + (unsigned)(h * 256 + wc * 64 + 8 * fq));
#pragma unroll
                for (int bj = 0; bj < 2; ++bj) { const f32x4 a = acc[ai][bj][m][0] * k2, c = acc[ai][bj][m][1] * k2; const float v[8] = {a[0], a[1], a[2], a[3], c[0], c[1], c[2], c[3]};
                    *(u32x2*)(o + 32 * bj) = pack8_fp8(v); }
            EPI_ROWLOOP_END
        }
    }
};
struct OrdS8 {
    int G, c; const char* A; const char* B;
    __device__ __forceinline__ bool next(int i, Unit& u) const { const int L = i * G + c; if (L >= 256) return false; tile_of(L, 64, 4, u.pm, u.pn);
        u.A = A + (size_t)u.pm * (256 * D); u.B = B + ((size_t)((u.pm >> 4) * 1024 + u.pn * 256) * D); return true; }
};
struct OrdG2 {
    int G, c; const char* A; const char* B;
    __device__ __forceinline__ bool next(int i, Unit& u) const { const int L = i * G + c; if (L >= 512) return false; tile_of(L, 64, 8, u.pm, u.pn);
        u.A = A + (size_t)u.pm * (256 * 1024); u.B = B + ((size_t)((u.pm >> 4) * D + u.pn * 256) * 1024); return true; }
};
struct EpiSoftP8 {
    const float* st; const float* uvec; const float* cvec; unsigned char* P; LAS float* tab;
    __device__ __forceinline__ void operator()(f32x4 (&acc)[2][2][4][2], const Unit& u, int wr, int wc, int fr_, int fq_, int lane) const {
        EPI_OPAQUE
        float c2 = 0.04419417382415922f * LOG2E, ki = 1.f / W1_SCALE, kp = P8_SCALE; asm volatile("" : "+s"(c2), "+s"(ki), "+s"(kp));
        f32x4 sv_[2][4]; wave_stats_load(st, pm * 256 + wr * 64, ln_, false, sv_);
        const int colb = pn * 256 + wc * 64 + 8 * fq;
        const float* ub = uvec + (size_t)(pm >> 4) * 1024; const float* cb = cvec + (size_t)(pm >> 4) * 1024;
        f32x4 uu[2][2], cc[2][2];
#pragma unroll
        for (int bj = 0; bj < 2; ++bj)
#pragma unroll
            for (int n = 0; n < 2; ++n) { uu[bj][n] = *(const f32x4*)(ub + colb + 32 * bj + 4 * n); cc[bj][n] = *(const f32x4*)(cb + colb + 32 * bj + 4 * n); }
        float mu[2][4], rs[2][4]; wave_stats_fin(sv_, ln_, false, mu, rs);
        LAS float* t0 = tab + (wr * 4) * 128; LAS float* t1 = tab + 1024 + (wr * 4) * 128;
#pragma unroll
        for (int ai = 0; ai < 2; ++ai)
#pragma unroll
            for (int m = 0; m < 4; ++m) { const float mr = shl(mu[ai][m], 4 * fr), rr = shl(rs[ai][m], 4 * fr); const float rw = rr * ki * c2, nrm = -rr * mr * c2;
                float mx = -3.0e38f;
#pragma unroll
                for (int bj = 0; bj < 2; ++bj)
#pragma unroll
                    for (int n = 0; n < 2; ++n)
#pragma unroll
                        for (int e = 0; e < 4; ++e) { const float s = __builtin_fmaf(rw, acc[ai][bj][m][n][e], __builtin_fmaf(nrm, uu[bj][n][e], cc[bj][n][e] * c2)); acc[ai][bj][m][n][e] = s; mx = fmaxf(mx, s); }
                mx = fmaxf(mx, shx(mx, 16)); mx = fmaxf(mx, shx(mx, 32));
                if (fq == 0) t0[wc * 128 + 64 * ai + 16 * m + fr] = mx; }
        asm volatile("s_waitcnt lgkmcnt(0)" ::: "memory"); __builtin_amdgcn_s_barrier(); asm volatile("" ::: "memory");
#pragma unroll
        for (int ai = 0; ai < 2; ++ai)
#pragma unroll
            for (int m = 0; m < 4; ++m) { const int hr = 64 * ai + 16 * m + fr;
                const float mx = fmaxf(fmaxf(t0[hr], t0[128 + hr]), fmaxf(t0[256 + hr], t0[384 + hr])); float s = 0.f;
#pragma unroll
                for (int bj = 0; bj < 2; ++bj)
#pragma unroll
                    for (int n = 0; n < 2; ++n)
#pragma unroll
                        for (int e = 0; e < 4; ++e) { const float p = __builtin_amdgcn_exp2f(acc[ai][bj][m][n][e] - mx); acc[ai][bj][m][n][e] = p; s += p; }
                s += shx(s, 16); s += shx(s, 32);
                if (fq == 0) t1[wc * 128 + hr] = s; }
        asm volatile("s_waitcnt lgkmcnt(0)" ::: "memory"); __builtin_amdgcn_s_barrier(); asm volatile("" ::: "memory");
        EPI_PLAINLOOP_BEGIN
            const int hr = 64 * ai + 16 * m + fr;
            const float inv = kp * __builtin_amdgcn_rcpf((t1[hr] + t1[128 + hr]) + (t1[256 + hr] + t1[384 + hr]));
            unsigned char* o = P + (size_t)(((unsigned)pm * 256u + (unsigned)rl) * 1024u + (unsigned)(pn * 256 + wc * 64 + 8 * fq + 24 * (fq & 1)));
            u32x2 p8[2];
#pragma unroll
            for (int bj = 0; bj < 2; ++bj) { const f32x4 a = acc[ai][bj][m][0] * inv, c = acc[ai][bj][m][1] * inv; const float v[8] = {a[0], a[1], a[2], a[3], c[0], c[1], c[2], c[3]};
                p8[bj] = pack8_fp8(v); }
            *(u32x4*)o = widen8(p8[0], p8[1]);
        EPI_ROWLOOP_END
    }
};
}

__device__ __forceinline__ void tr_item(const float* W, int K, int N, int ldw, bf16_t* WT, LAS float* scr, int item, int lane, const float* g, const float* b, float* uv, float* cv, bool ileave, bool f8 = false, unsigned char* WT8 = nullptr, float* uv8 = nullptr, unsigned char* WR8 = nullptr) {
    const int nblk = N / 64, kb = item / nblk, nb = item % nblk, k0 = 64 * kb, n0 = 64 * nb;
#pragma unroll 16
    for (int kk = 0; kk < 64; ++kk) scr[kk * 65 + lane] = __builtin_nontemporal_load(W + (size_t)(k0 + kk) * ldw + n0 + lane);
    LDS_WAIT(); asm volatile("" ::: "memory");
    if (WR8) {
        const float sc = WQR_SCALE * g[k0 + lane]; const LAS float* s = scr + lane * 65; GAS u32x4* o8 = (GAS u32x4*)(WR8 + (size_t)(k0 + lane) * N + n0);
#pragma unroll
        for (int q = 0; q < 4; ++q) { u32x4 w;
#pragma unroll
            for (int e = 0; e < 4; ++e) w[e] = pk4_fp8(s[16 * q + 4 * e] * sc, s[16 * q + 4 * e + 1] * sc, s[16 * q + 4 * e + 2] * sc, s[16 * q + 4 * e + 3] * sc);
            o8[q] = w; } }
    const int c = lane & 7;
    float gk[8], bk[8];
    if (g) {
#pragma unroll
        for (int i = 0; i < 8; ++i) { gk[i] = g[k0 + 8 * c + i]; bk[i] = b[k0 + 8 * c + i]; } }
#pragma unroll
    for (int j = 0; j < 8; ++j) { const int nl = (lane >> 3) + 8 * j; const LAS float* s = scr + (8 * c) * 65 + nl;
        float w[8];
#pragma unroll
        for (int i = 0; i < 8; ++i) w[i] = s[i * 65];
        int n = n0 + nl, dr = n;
        if (ileave) { const int hc = (n < DFF) ? n : n - DFF, j = hc & 127; dr = 256 * (hc >> 7) + 64 * (j >> 5) + (j & 31) + ((n < DFF) ? 0 : 32); }
        float su = 0.f, sc = 0.f;
        if (g) {
#pragma unroll
            for (int i = 0; i < 8; ++i) { sc += bk[i] * w[i]; w[i] *= gk[i]; } }
        if (f8) { u32x2 o8; o8.x = pk4_fp8(w[0] * W8_SCALE, w[1] * W8_SCALE, w[2] * W8_SCALE, w[3] * W8_SCALE); o8.y = pk4_fp8(w[4] * W8_SCALE, w[5] * W8_SCALE, w[6] * W8_SCALE, w[7] * W8_SCALE);
            *(GAS u32x2*)((unsigned char*)WT + (size_t)dr * K + k0 + 8 * c) = o8;
            if (g) su = (sum4_fp8(o8.x) + sum4_fp8(o8.y)) * W8_INV; }
        else { u32x4 o; o.x = pk2(w[0], w[1]); o.y = pk2(w[2], w[3]); o.z = pk2(w[4], w[5]); o.w = pk2(w[6], w[7]);
        *(GAS u32x4*)(WT + (size_t)dr * K + k0 + 8 * c) = o;
        if (g) su = (bf2f(o.x & 0xffffu) + bf2f(o.x >> 16)) + (bf2f(o.y & 0xffffu) + bf2f(o.y >> 16)) + (bf2f(o.z & 0xffffu) + bf2f(o.z >> 16)) + (bf2f(o.w & 0xffffu) + bf2f(o.w >> 16)); }
        if (WT8) { u32x2 o8; o8.x = pk4_fp8(w[0] * W8_SCALE, w[1] * W8_SCALE, w[2] * W8_SCALE, w[3] * W8_SCALE); o8.y = pk4_fp8(w[4] * W8_SCALE, w[5] * W8_SCALE, w[6] * W8_SCALE, w[7] * W8_SCALE);
            *(GAS u32x2*)(WT8 + (size_t)dr * K + k0 + 8 * c) = o8;
            if (g) { float s8 = (sum4_fp8(o8.x) + sum4_fp8(o8.y)) * W8_INV; s8 += shx(s8, 1); s8 += shx(s8, 2); s8 += shx(s8, 4); if (c == 0 && uv8) atomicAdd(uv8 + dr, s8); } }
        if (g) {
            su += shx(su, 1); su += shx(su, 2); su += shx(su, 4);
            sc += shx(sc, 1); sc += shx(sc, 2); sc += shx(sc, 4);
            if (c == 0 && uv) { atomicAdd(uv + dr, su); atomicAdd(cv + dr, sc); }
        }
    }
    LDS_WAIT(); asm volatile("" ::: "memory");
}
__device__ __forceinline__ void cvt_row8(const float* src, unsigned char* dst8, int lane) {
    const GAS f32x4* s = (const GAS f32x4*)src + lane; GAS unsigned* o8 = (GAS unsigned*)dst8 + lane;
    f32x4 v[8];
#pragma unroll
    for (int j = 0; j < 8; ++j) v[j] = __builtin_nontemporal_load(s + 64 * j);
#pragma unroll
    for (int j = 0; j < 8; ++j) o8[64 * j] = pk4_fp8(v[j][0], v[j][1], v[j][2], v[j][3]);
}
__device__ __forceinline__ void cvt_row(const float* src, bf16_t* dst, int lane, unsigned char* dst8 = nullptr) {
    const GAS f32x4* s = (const GAS f32x4*)src + lane; GAS u32x2* o = (GAS u32x2*)dst + lane;
    f32x4 v[8];
#pragma unroll
    for (int j = 0; j < 8; ++j) v[j] = __builtin_nontemporal_load(s + 64 * j);
#pragma unroll
    for (int j = 0; j < 8; ++j) { u32x2 w; w.x = pk2(v[j][0], v[j][1]); w.y = pk2(v[j][2], v[j][3]); o[64 * j] = w; }
    if (dst8) { GAS unsigned* o8 = (GAS unsigned*)dst8 + lane;
#pragma unroll
        for (int j = 0; j < 8; ++j) o8[64 * j] = pk4_fp8(v[j][0], v[j][1], v[j][2], v[j][3]); }
}

namespace att {
constexpr int SHM_V = 64 * 128 * 2, SHM_K = 64 * 128 * 2;
constexpr int OFF_V = 0, OFF_K = 2 * SHM_V, OFF_WS = OFF_K + 2 * SHM_K, OFF_TBL = OFF_WS + NWAVES * 64 * 4, ATT_LDS = OFF_TBL + 1280;
static_assert(ATT_LDS <= RING_BYTES, "attention LDS");
#define KSWZ(row, colB) ((row) * 256 + ((colB) ^ (((row) & 15) << 4)))
__device__ __forceinline__ int v_st(int k, int c) { const int kk = (k & ~0xC) | ((k & 4) << 1) | ((k & 8) >> 1); return ((kk >> 3) * 4 + (c >> 5)) * 512 + ((kk & 7) * 32 + (c & 31)) * 2; }
__device__ __forceinline__ int v_rd_base(int lane) { return ((lane & 3) << 3) | (((lane >> 2) & 3) << 6) | (((lane >> 4) & 1) << 5) | (((lane >> 5) & 1) << 8); }
constexpr int v_rd_off(int d0, int ks, int half) { return d0 * 512 + ks * 4096 + half * 2048; }
__device__ __forceinline__ int crow(int r, int hi) { return (r & 3) + 8 * (r >> 2) + 4 * hi; }

template <int KB>
__device__ __forceinline__ void qkt(f32x16& p0, f32x16& p1, LAS const char* K_lds, int r32, int hi, const bf16x8* qr) {
    p0 = f32x16{}; p1 = f32x16{};
#pragma unroll
    for (int d0 = 0; d0 < 8; ++d0) { LAS const char* a = K_lds + KB * SHM_K + KSWZ(r32, (d0 * 16 + hi * 8) * 2);
        const bf16x8 b0 = *(LAS const bf16x8*)a;
        const bf16x8 b1 = *(LAS const bf16x8*)(a + 32 * 256);
        p0 = __builtin_amdgcn_mfma_f32_32x32x16_bf16(b0, qr[d0], p0, 0, 0, 0);
        p1 = __builtin_amdgcn_mfma_f32_32x32x16_bf16(b1, qr[d0], p1, 0, 0, 0); }
}
template <int VB>
__device__ __forceinline__ void pv_tile(f32x16* o, int vb0, bf16x8 pa0, bf16x8 pa1, bf16x8 pa2, bf16x8 pa3) {
#define TRRD(dst, off) asm volatile("ds_read_b64_tr_b16 %0, %1 offset:%2" : "=&v"(dst) : "v"(vb0), "i"(off) : "memory")
#define PV_D0(d0) do { s16x4 l0, l1, l2, l3, h0, h1, h2, h3; constexpr int b_ = OFF_V + VB * SHM_V + v_rd_off(d0, 0, 0); \
        TRRD(l0, b_); TRRD(h0, b_ + 2048); TRRD(l1, b_ + 4096); TRRD(h1, b_ + 6144); TRRD(l2, b_ + 8192); TRRD(h2, b_ + 10240); TRRD(l3, b_ + 12288); TRRD(h3, b_ + 14336); \
        asm volatile("s_waitcnt lgkmcnt(0)" ::: "memory"); __builtin_amdgcn_sched_barrier(0); \
        o[d0] = __builtin_amdgcn_mfma_f32_32x32x16_bf16((bf16x8){l0[0], l0[1], l0[2], l0[3], h0[0], h0[1], h0[2], h0[3]}, pa0, o[d0], 0, 0, 0);   \
        o[d0] = __builtin_amdgcn_mfma_f32_32x32x16_bf16((bf16x8){l1[0], l1[1], l1[2], l1[3], h1[0], h1[1], h1[2], h1[3]}, pa1, o[d0], 0, 0, 0);   \
        o[d0] = __builtin_amdgcn_mfma_f32_32x32x16_bf16((bf16x8){l2[0], l2[1], l2[2], l2[3], h2[0], h2[1], h2[2], h2[3]}, pa2, o[d0], 0, 0, 0);   \
        o[d0] = __builtin_amdgcn_mfma_f32_32x32x16_bf16((bf16x8){l3[0], l3[1], l3[2], l3[3], h3[0], h3[1], h3[2], h3[3]}, pa3, o[d0], 0, 0, 0); } while (0)
    PV_D0(0); PV_D0(1); PV_D0(2); PV_D0(3);
#undef PV_D0
#undef TRRD
}

__device__ __forceinline__ void attn_unit(LAS char* lds, const bf16_t* Qp, int qstride, const bf16_t* Kp, const bf16_t* Vp, int kvstride, unsigned char* Op,
                                          int T_lo, int T_hi, int cbase, int nact, bool smp, const float* relb, const int wv) {
    int tid = wv * 64 + lane_id(); asm volatile("" : "+v"(tid));
    const int wid = __builtin_amdgcn_readfirstlane(tid >> 6), lane = tid & 63, r32 = lane & 31, hi = lane >> 5;
    const bool wact = wid < nact;
    const int cw = cbase + (wid >> 1);
    LAS char* V_lds = lds + OFF_V; LAS char* K_lds = lds + OFF_K;
    LAS float* wsc = (LAS float*)(lds + OFF_WS) + wid * 64; LAS float* li_l = wsc; LAS float* al_l = wsc + 32;
    LAS float* tbl = (LAS float*)(lds + OFF_TBL);
    const int sr = tid >> 4, sc = (tid & 15) * 8, vst0 = v_st(sr, sc), vst1 = v_st(32 + sr, sc), kws = KSWZ(sr, sc * 2);
    const int vb0 = (int)(uintptr_t)lds + v_rd_base(lane);
    bf16x8 qr[8];
    if (wact) {
#pragma unroll
        for (int d0 = 0; d0 < 8; ++d0) qr[d0] = *(const bf16x8*)(Qp + (size_t)(wid * 32 + r32) * qstride + d0 * 16 + hi * 8);
    } else {
#pragma unroll
        for (int d0 = 0; d0 < 8; ++d0) qr[d0] = bf16x8{};
    }
    float m_reg = -1e30f, l_reg = 0.f; f32x16 o[4] = {};
    bf16x8 st_k0[2], st_k1[2], st_v0[2], st_v1[2];
#define ATT_LOAD(T, S) do { const size_t k0_ = (size_t)(T) * 64; \
        st_k0[S] = *(const bf16x8*)(Kp + (k0_ + sr) * kvstride + sc); st_k1[S] = *(const bf16x8*)(Kp + (k0_ + 32 + sr) * kvstride + sc); \
        st_v0[S] = *(const bf16x8*)(Vp + (k0_ + sr) * kvstride + sc); st_v1[S] = *(const bf16x8*)(Vp + (k0_ + 32 + sr) * kvstride + sc); } while (0)
#define ATT_WRITE(bf, S) do { *(LAS bf16x8*)(K_lds + (bf) * SHM_K + kws) = st_k0[S]; *(LAS bf16x8*)(K_lds + (bf) * SHM_K + kws + 32 * 256) = st_k1[S]; \
        *(LAS bf16x8*)(V_lds + (bf) * SHM_V + vst0) = st_v0[S]; *(LAS bf16x8*)(V_lds + (bf) * SHM_V + vst1) = st_v1[S]; } while (0)
    ATT_LOAD(T_lo, 0);
    if (T_lo + 1 < T_hi) ATT_LOAD(T_lo + 1, 1);
    __syncthreads();
    if (tid < 320) tbl[tid] = tid < NREL ? (relb[tid] - relb[NREL - 1]) * LOG2E : 0.f;
    ATT_WRITE(0, 0);
    __syncthreads();
    const int qi = 32 * (wid & 1) + r32;
#define ATT_STEP(T, BUF) do { \
        if ((T) + 2 < T_hi) ATT_LOAD((T) + 2, BUF); \
        if (wact && (T) >= cw - 8 && (T) <= cw) { \
            const int jt = (T) - (cw - 8); f32x16 p0, p1; \
            qkt<BUF>(p0, p1, K_lds, r32, hi, qr); \
            if (jt >= 6) { LAS const float* tp_ = tbl + (qi + 512 - 64 * jt - 4 * hi + 128 - 59);        \
                _Pragma("unroll") for (int r4 = 0; r4 < 4; ++r4) { \
                    _Pragma("unroll") for (int rr_ = 0; rr_ < 4; ++rr_) { const int r = 4 * r4 + rr_; const int c_ = (r & 3) + 8 * (r >> 2); \
                        p0[r] += tp_[59 - c_]; p1[r] += tp_[27 - c_]; } } } \
            if (smp && (T) == 8) { _Pragma("unroll") for (int r = 0; r < 16; ++r) p1[r] = -__builtin_inff(); } \
            float pmax = p0[0]; \
            _Pragma("unroll") for (int r = 1; r < 16; ++r) pmax = fmaxf(pmax, p0[r]); \
            _Pragma("unroll") for (int r = 0; r < 16; ++r) pmax = fmaxf(pmax, p1[r]); \
            pmax = fmaxf(pmax, shx(pmax, 32)); \
            const float mn = (pmax - m_reg > 8.f) ? pmax : m_reg, alpha = __builtin_amdgcn_exp2f(m_reg - mn); m_reg = mn;     \
            float ps = 0.f; \
            _Pragma("unroll") for (int r = 0; r < 16; ++r) { p0[r] = __builtin_amdgcn_exp2f(p0[r] - mn); p1[r] = __builtin_amdgcn_exp2f(p1[r] - mn); ps += p0[r] + p1[r]; } \
            ps += shx(ps, 32); l_reg = l_reg * alpha + ps; \
            bf16x8 pa0, pa1, pa2, pa3; \
            ATT_PK4(p0, 0, pa0); ATT_PK4(p0, 8, pa1); ATT_PK4(p1, 0, pa2); ATT_PK4(p1, 8, pa3); \
            if (__any(alpha < 1.f)) { _Pragma("unroll") for (int d_ = 0; d_ < 4; ++d_) _Pragma("unroll") for (int r = 0; r < 16; ++r) o[d_][r] *= alpha; }     \
            pv_tile<BUF>(o, vb0, pa0, pa1, pa2, pa3); \
        } \
        if ((T) + 1 < T_hi) ATT_WRITE((BUF) ^ 1, (BUF) ^ 1); \
        __syncthreads(); } while (0)
#define ATT_PK4(P, B_, OUT) do { unsigned a0 = cvt_pk_bf16(P[B_+0], P[B_+1]), a1 = cvt_pk_bf16(P[B_+2], P[B_+3]);                          \
        unsigned b0 = cvt_pk_bf16(P[B_+4], P[B_+5]), b1 = cvt_pk_bf16(P[B_+6], P[B_+7]);                                             \
        auto r0 = __builtin_amdgcn_permlane32_swap(a0, b0, false, false); auto r1 = __builtin_amdgcn_permlane32_swap(a1, b1, false, false); \
        u32x4 w = {r0[0], r1[0], r0[1], r1[1]}; OUT = __builtin_bit_cast(bf16x8, w); } while (0)
    for (int T = T_lo; T < T_hi; T += 2) {
        ATT_STEP(T, 0);
        if (T + 1 < T_hi) ATT_STEP(T + 1, 1);
    }
#undef ATT_STEP
#undef ATT_PK4
#undef ATT_LOAD
#undef ATT_WRITE
    if (wact) {
        float ko = O8_SCALE; asm volatile("" : "+s"(ko));
        const float rli = ko * __builtin_amdgcn_rcpf(l_reg);
        int r32o = r32, hio = hi; asm volatile("" : "+v"(r32o), "+v"(hio));
        unsigned char* orow = Op + (size_t)((unsigned)(wid * 32 + r32o) * (unsigned)D + (unsigned)(16 * hio));
#pragma unroll
        for (int d0 = 0; d0 < 4; ++d0) {
            unsigned dw[4];
#pragma unroll
            for (int g = 0; g < 4; ++g) dw[g] = pk4_fp8(o[d0][4 * g] * rli, o[d0][4 * g + 1] * rli, o[d0][4 * g + 2] * rli, o[d0][4 * g + 3] * rli);
            const auto s02 = __builtin_amdgcn_permlane32_swap(dw[0], dw[2], false, false);
            const auto s13 = __builtin_amdgcn_permlane32_swap(dw[1], dw[3], false, false);
            const u32x4 w = {s02[0], s02[1], s13[0], s13[1]};
            *(u32x4*)(orow + d0 * 32) = w;
        }
    }
}
}

__device__ __forceinline__ void smem_attn_unit(LAS char* lds, const bf16_t* Q  , const bf16_t* Kc  ,
                                                const bf16_t* Vt  , unsigned char* O  , const int wv, const int half  ) {
    int tid = wv * 64 + lane_id(); asm volatile("" : "+v"(tid));
    const int wid = __builtin_amdgcn_readfirstlane(tid >> 6), lane = tid & 63, r32 = lane & 31, hi = lane >> 5;
    LAS float* smax = (LAS float*)lds;
    LAS float* ssum = smax + 256;
    LAS bf16_t* Pl = (LAS bf16_t*)(lds + 2048);
    constexpr int PLD = 264;
    LAS char* Ql = lds + 32768;
    f32x16 s = {};
    const bf16_t* kp = Kc + (size_t)(32 * wid + r32) * D + hi * 8;
    bf16x8 kf[32];
#pragma unroll
    for (int ks = 0; ks < 32; ++ks) kf[ks] = *(const bf16x8*)(kp + ks * 16);
    bf16x8 qst[4];
    { const int qr_ = tid >> 4, qc_ = tid & 15;
#pragma unroll
        for (int j = 0; j < 4; ++j) qst[j] = *(const bf16x8*)(Q + (size_t)qr_ * D + (qc_ + 16 * j) * 8);
        __syncthreads();
#pragma unroll
        for (int j = 0; j < 4; ++j) *(LAS bf16x8*)(Ql + qr_ * 1024 + (((qc_ + 16 * j) ^ (qr_ & 15)) << 4)) = qst[j];
    }
    __syncthreads();
#pragma unroll
    for (int ks = 0; ks < 32; ++ks) { const bf16x8 b = *(LAS const bf16x8*)(Ql + r32 * 1024 + (((2 * ks + hi) ^ (r32 & 15)) << 4));
        s = __builtin_amdgcn_mfma_f32_32x32x16_bf16(kf[ks], b, s, 0, 0, 0); }
    const bf16_t* v0 = Vt + (size_t)(256 * half + 32 * wid + r32) * 256 + hi * 8;
    bf16x8 vf0[16];
#pragma unroll
    for (int ks = 0; ks < 16; ++ks) vf0[ks] = *(const bf16x8*)(v0 + ks * 16);
    constexpr float C2 = 0.04419417382415922f * LOG2E;
    float pmax = s[0];
#pragma unroll
    for (int r = 1; r < 16; ++r) pmax = fmaxf(pmax, s[r]);
    pmax = fmaxf(pmax, shx(pmax, 32));
    if (hi == 0) smax[wid * 32 + r32] = pmax;
    __syncthreads();
    float gm = smax[r32];
#pragma unroll
    for (int w = 1; w < 8; ++w) gm = fmaxf(gm, smax[w * 32 + r32]);
    float ps = 0.f;
#pragma unroll
    for (int r = 0; r < 16; ++r) { s[r] = __builtin_amdgcn_exp2f((s[r] - gm) * C2); ps += s[r]; }
    ps += shx(ps, 32);
    if (hi == 0) ssum[wid * 32 + r32] = ps;
    __syncthreads();
    float tot = 0.f;
#pragma unroll
    for (int w = 0; w < 8; ++w) tot += ssum[w * 32 + r32];
    const float inv = 1.0f / tot;
#pragma unroll
    for (int r = 0; r < 16; ++r) Pl[r32 * PLD + 32 * wid + att::crow(r, hi)] = (bf16_t)f2bf(s[r] * inv);
    __syncthreads();
    f32x16 o0 = {};
#pragma unroll
    for (int ks = 0; ks < 16; ++ks) { const bf16x8 a = *(LAS const bf16x8*)(Pl + r32 * PLD + ks * 16 + hi * 8);
        o0 = __builtin_amdgcn_mfma_f32_32x32x16_bf16(vf0[ks], a, o0, 0, 0, 0); }
    {
        unsigned char* orow = O + (size_t)r32 * D + 256 * half + 32 * wid + 16 * hi;
#pragma unroll
        for (int blk = 0; blk < 1; ++blk) { const f32x16& oo = o0; unsigned dw[4];
#pragma unroll
            for (int g = 0; g < 4; ++g) dw[g] = pk4_fp8(oo[4 * g] * O8_SCALE, oo[4 * g + 1] * O8_SCALE, oo[4 * g + 2] * O8_SCALE, oo[4 * g + 3] * O8_SCALE);
            const auto s02 = __builtin_amdgcn_permlane32_swap(dw[0], dw[2], false, false);
            const auto s13 = __builtin_amdgcn_permlane32_swap(dw[1], dw[3], false, false);
            const u32x4 w = {s02[0], s02[1], s13[0], s13[1]};
            *(u32x4*)(orow + 32 * blk) = w; }
    }
}


namespace sk {
struct SUnit { int cb, rb; };
struct SPre { float mu, rs; f32x4 q0, q1, q2, q3; };
template <bool UNEVEN = false>
__device__ __forceinline__ bool next_unit(int i, int ncb, int G, int bx, SUnit& u) {
    const int x = bx & 7, rank = bx >> 3, per = G >> 3, e = rank + i * per;
    if (UNEVEN) { const int j = e >> 3, lim = (x & 1) ? 8 : 16; if (j >= lim) return false; u.cb = 24 * (x >> 1) + ((x & 1) ? 16 : 0) + j; u.rb = e & 7; return true; }
    const int cb = x + 8 * (e >> 3);
    if (cb >= ncb) return false; u.cb = cb; u.rb = e & 7; return true;
}
__device__ __forceinline__ void row_stats(const float* sst, int rl, bool idn, float& mu, float& rs) {
    if (idn) { mu = 0.f; rs = 1.f; return; }
    const f32x4* p = (const f32x4*)(sst + (size_t)rl * 64); float s = 0.f, q = 0.f;
#pragma unroll
    for (int t = 0; t < 16; ++t) { const f32x4 v = p[t]; s += v[0] + v[2]; q += v[1] + v[3]; }
    mu = s * (1.f / D); rs = __builtin_amdgcn_rsqf(q * (1.f / D) - mu * mu + LN_EPS);
}
template <int MODE, bool FP8 = false, bool UNEVEN = false, class Epi>
__device__ __forceinline__ void skinny_phase(LAS char* lds, const int wv, const bf16_t* A  , int lda, const bf16_t* Bt, int ldb, int K, int ncb, int G, int bx, const Epi& E) {
    int tid = wv * 64 + lane_id(); asm volatile("" : "+v"(tid));
    const int wid = __builtin_amdgcn_readfirstlane(tid >> 6), lane = tid & 63, r32 = lane & 31, hi = lane >> 5;
    const int ngrp = K >> 6, g0 = (wid * ngrp) >> 3, g1 = ((wid + 1) * ngrp) >> 3, klo = g0 * 64, ksl = (g1 - g0) * 64;
    LAS f32x4* part = (LAS f32x4*)lds;
    constexpr int PF = FP8 ? 2 : 1;
    bf16x8 pa[PF][4], pb0[PF][4], pb1[PF][4];
#define SK_PTRS(u_) const int j1_ = ((u_).cb & 3) * 32 + r32; const int brow0_ = (MODE == 1) ? (((u_).cb >> 2) * 256 + 64 * (j1_ >> 5) + (j1_ & 31)) : ((u_).cb * 64 + r32), brow1_ = brow0_ + 32; \
        const bf16_t* ap = A + (size_t)((u_).rb * 32 + r32) * lda + klo + 8 * hi + ((MODE == 2) ? 512 * ((u_).cb >> 3) : 0); \
        const bf16_t* b0p = Bt + (size_t)brow0_ * ldb + klo + 8 * hi; const bf16_t* b1p = Bt + (size_t)brow1_ * ldb + klo + 8 * hi;
#define SK_PREFETCH_A() _Pragma("unroll") for (int g = 0; g < PF; ++g) if (g * 64 < ksl) { _Pragma("unroll") for (int s = 0; s < 4; ++s) pa[g][s] = *(const bf16x8*)(ap + g * 64 + 16 * s); }
#define SK_PREFETCH_B() _Pragma("unroll") for (int g = 0; g < PF; ++g) if (g * 64 < ksl) { _Pragma("unroll") for (int s = 0; s < 4; ++s) { \
            pb0[g][s] = *(const bf16x8*)(b0p + g * 64 + 16 * s); pb1[g][s] = *(const bf16x8*)(b1p + g * 64 + 16 * s); } }
    constexpr bool AREG = FP8 && MODE == 1;
#define SK_CAT8(x0, x1) __builtin_shufflevector(__builtin_bit_cast(i32x4, x0), __builtin_bit_cast(i32x4, x1), 0, 1, 2, 3, 4, 5, 6, 7)
#define SK_MMA(a, b0, b1) do { if constexpr (FP8) { _Pragma("unroll") for (int s = 0; s < 4; s += 2) { \
            acc0 = __builtin_amdgcn_mfma_scale_f32_32x32x64_f8f6f4(SK_CAT8(b0[s], b0[s + 1]), SK_CAT8(a[s], a[s + 1]), acc0, 0, 0, 0, 0x7f7f7f7f, 0, 0x7f7f7f7f); \
            acc1 = __builtin_amdgcn_mfma_scale_f32_32x32x64_f8f6f4(SK_CAT8(b1[s], b1[s + 1]), SK_CAT8(a[s], a[s + 1]), acc1, 0, 0, 0, 0x7f7f7f7f, 0, 0x7f7f7f7f); } } \
        else { _Pragma("unroll") for (int s = 0; s < 4; ++s) { acc0 = __builtin_amdgcn_mfma_f32_32x32x16_bf16(b0[s], a[s], acc0, 0, 0, 0); acc1 = __builtin_amdgcn_mfma_f32_32x32x16_bf16(b1[s], a[s], acc1, 0, 0, 0); } } } while (0)
    SUnit u; bool have = next_unit<UNEVEN>(0, ncb, G, bx, u);
    LAS float* stab = (LAS float*)(lds + 65536);
    if (have) { SK_PTRS(u) SK_PREFETCH_A() SK_PREFETCH_B()
        if (tid < 32) { float mu_, rs_; row_stats(E.stat_src(), u.rb * 32 + tid, E.stat_idn(), mu_, rs_); stab[2 * tid] = mu_; stab[2 * tid + 1] = rs_; }
        __syncthreads(); }
    for (int i = 0; have; ++i) {
        SUnit un; const bool hn = next_unit<UNEVEN>(i + 1, ncb, G, bx, un);
        const int n = tid & 31, m4 = (tid >> 5) & 7, blk = tid >> 8;
        const SPre P = E.pre(u, n, m4, blk, stab);
        f32x16 acc0 = {}, acc1 = {};
#pragma unroll
        for (int g = 0; g < PF; ++g) if (g * 64 < ksl) SK_MMA(pa[g], pb0[g], pb1[g]);
        if (!AREG && ksl > PF * 64) { SK_PTRS(u)
#pragma unroll 1
            for (int k = PF * 64; k < ksl; k += PF * 64) {
#pragma unroll
                for (int g = 0; g < PF; ++g) if (g == 0 || k + g * 64 < ksl) {
#pragma unroll
                    for (int s = 0; s < 4; ++s) { pa[g][s] = *(const bf16x8*)(ap + k + g * 64 + 16 * s); pb0[g][s] = *(const bf16x8*)(b0p + k + g * 64 + 16 * s); pb1[g][s] = *(const bf16x8*)(b1p + k + g * 64 + 16 * s); } }
#pragma unroll
                for (int g = 0; g < PF; ++g) if (g == 0 || k + g * 64 < ksl) SK_MMA(pa[g], pb0[g], pb1[g]); } }
        if (hn) { SK_PTRS(un) if (!AREG) { SK_PREFETCH_A() } SK_PREFETCH_B() }
        __syncthreads();
#pragma unroll
        for (int r4 = 0; r4 < 4; ++r4) { const int m4w = 2 * r4 + hi;
            part[((wid * 2 + 0) * 8 + m4w) * 32 + r32] = (f32x4){acc0[4 * r4], acc0[4 * r4 + 1], acc0[4 * r4 + 2], acc0[4 * r4 + 3]};
            part[((wid * 2 + 1) * 8 + m4w) * 32 + r32] = (f32x4){acc1[4 * r4], acc1[4 * r4 + 1], acc1[4 * r4 + 2], acc1[4 * r4 + 3]}; }
        __syncthreads();
        f32x4 v0 = part[((0 * 2 + blk) * 8 + m4) * 32 + n], v1 = {0.f, 0.f, 0.f, 0.f};
#pragma unroll
        for (int w = 1; w < 8; ++w) v0 += part[((w * 2 + blk) * 8 + m4) * 32 + n];
        if (MODE == 1) { v1 = part[((0 * 2 + 1) * 8 + m4) * 32 + n];
#pragma unroll
            for (int w = 1; w < 8; ++w) v1 += part[((w * 2 + 1) * 8 + m4) * 32 + n]; }
        E(v0, v1, P, u, n, m4, blk, tid);
        u = un; have = hn;
    }
#undef SK_PTRS
#undef SK_PREFETCH_A
#undef SK_PREFETCH_B
#undef SK_CAT8
#undef SK_MMA
}
struct SEpiNone {
    __device__ __forceinline__ const float* stat_src() const { return nullptr; } __device__ __forceinline__ bool stat_idn() const { return true; }
    __device__ __forceinline__ SPre pre(const SUnit& u, int n, int m4, int blk, LAS const float* stab) const { SPre P = {}; return P; }
    __device__ __forceinline__ void operator()(f32x4 v, f32x4 v1, const SPre& P, const SUnit& u, int n, int m4, int blk, int tid) const { asm volatile("" :: "v"(v), "v"(v1)); }
};
struct SEpiQKV {
    const float* sst; bool idn; const float* uvec; const float* cvec; bf16_t* qkv; bf16_t* kvs; float* oks;
    __device__ __forceinline__ const float* stat_src() const { return sst; } __device__ __forceinline__ bool stat_idn() const { return idn; }
    __device__ __forceinline__ SPre pre(const SUnit& u, int n, int m4, int blk, LAS const float* stab) const { SPre P = {}; const int rl = u.rb * 32 + n, col = u.cb * 64 + 32 * blk + 4 * m4;
        if (!idn) { P.q0 = *(const f32x4*)(uvec + col); P.q1 = *(const f32x4*)(cvec + col); } P.mu = stab[2 * n]; P.rs = stab[2 * n + 1]; return P; }
    __device__ __forceinline__ void operator()(f32x4 v, f32x4, const SPre& P, const SUnit& u, int n, int m4, int blk, int tid) const {
        const int rl = u.rb * 32 + n, col = u.cb * 64 + 32 * blk + 4 * m4, which = col >> 11;
        if (!idn) v = (v - P.q0 * P.mu) * P.rs + P.q1;
        if (!which) v = v * QSCALE;
        u32x2 w; w.x = cvt_pk_bf16(v[0], v[1]); w.y = cvt_pk_bf16(v[2], v[3]);
        *(u32x2*)(qkv + (size_t)(MP + rl) * 6144 + col) = w;
        if (which) { const int colh = col - 2048 * which, b = rl >> 5, t = rl & 31;
            *(u32x2*)(kvs + ((size_t)((which - 1) * SBAT + b) * KVROWS + 512 + t) * D + colh) = w;
            *(f32x4*)(oks + (size_t)(which - 1) * (O_AVS - O_AKS) + (size_t)rl * D + colh) = v; }
    }
};
struct SEpiLin {
    const float* sst; const float* uvec; const float* cvec; bf16_t* out; float ascale;
    __device__ __forceinline__ const float* stat_src() const { return sst; } __device__ __forceinline__ bool stat_idn() const { return false; }
    __device__ __forceinline__ SPre pre(const SUnit& u, int n, int m4, int blk, LAS const float* stab) const { SPre P = {}; const int rl = u.rb * 32 + n, col = u.cb * 64 + 32 * blk + 4 * m4;
        P.q0 = *(const f32x4*)(uvec + col); P.q1 = *(const f32x4*)(cvec + col); P.mu = stab[2 * n]; P.rs = stab[2 * n + 1]; return P; }
    __device__ __forceinline__ void operator()(f32x4 v, f32x4, const SPre& P, const SUnit& u, int n, int m4, int blk, int tid) const {
        const int rl = u.rb * 32 + n, col = u.cb * 64 + 32 * blk + 4 * m4;
        v = (v * ascale - P.q0 * P.mu) * P.rs + P.q1;
        u32x2 w; w.x = cvt_pk_bf16(v[0], v[1]); w.y = cvt_pk_bf16(v[2], v[3]);
        *(u32x2*)(out + (size_t)(MP + rl) * D + col) = w;
    }
};
struct SEpiFfnIn {
    const float* sst; const float* uvec; const float* cvec; unsigned char* H;
    __device__ __forceinline__ const float* stat_src() const { return sst; } __device__ __forceinline__ bool stat_idn() const { return false; }
    __device__ __forceinline__ SPre pre(const SUnit& u, int n, int m4, int blk, LAS const float* stab) const { SPre P = {}; const int rl = u.rb * 32 + n, j0 = (u.cb & 3) * 32 + 4 * m4, rg = (u.cb >> 2) * 256 + 64 * (j0 >> 5) + (j0 & 31), ru = rg + 32;
        P.q0 = *(const f32x4*)(uvec + rg); P.q1 = *(const f32x4*)(cvec + rg); P.q2 = *(const f32x4*)(uvec + ru); P.q3 = *(const f32x4*)(cvec + ru); P.mu = stab[2 * n]; P.rs = stab[2 * n + 1]; return P; }
    __device__ __forceinline__ void operator()(f32x4 g, f32x4 up, const SPre& P, const SUnit& u, int n, int m4, int blk, int tid) const {
        if (blk) return;
        const int rl = u.rb * 32 + n;
        float kw = W8_INV, kh = H8_SCALE, lim = 448.f; asm volatile("" : "+s"(kw), "+s"(kh), "+v"(lim));
        const float nlim = -lim;
        g = (g * kw - P.q0 * P.mu) * P.rs + P.q1; up = ((up * kw - P.q2 * P.mu) * P.rs + P.q3) * kh;
        f32x4 h;
#pragma unroll
        for (int e = 0; e < 4; ++e) h[e] = __builtin_amdgcn_fmed3f(g[e] * up[e] * __builtin_amdgcn_rcpf(1.0f + __builtin_amdgcn_exp2f(-g[e] * LOG2E)), nlim, lim);
        *(unsigned*)(H + (size_t)(MP + rl) * DFF + u.cb * 32 + 4 * m4) = pk4_fp8(h[0], h[1], h[2], h[3]);
    }
};
template <bool POOL, bool Z8 = false> struct SEpiRes {
    const float* sst_old; float* sst_new; bool idn; const float* xs; half_t* zf; bf16_t* zb; const float* g; const float* b; const float* psc; LAS f32x2* red; float ascale; half_t* zfo;
    __device__ __forceinline__ const float* stat_src() const { return sst_old; } __device__ __forceinline__ bool stat_idn() const { return idn; }
    __device__ __forceinline__ SPre pre(const SUnit& u, int n, int m4, int blk, LAS const float* stab) const { SPre P = {}; const int rl = u.rb * 32 + n, row = MP + rl, col = u.cb * 64 + 32 * blk + 4 * m4;
        P.q0 = idn ? *(const f32x4*)(xs + (size_t)rl * D + col) : unpack4h(*(const u32x2*)(zf + (size_t)row * D + col));
        if (!idn) { P.q1 = *(const f32x4*)(g + col); P.q2 = *(const f32x4*)(b + col); }
        if (POOL) P.q3 = *(const f32x4*)(psc + col);
        P.mu = stab[2 * n]; P.rs = stab[2 * n + 1]; return P; }
    __device__ __forceinline__ void operator()(f32x4 a, f32x4, const SPre& P, const SUnit& u, int n, int m4, int blk, int tid) const {
        const int rl = u.rb * 32 + n, row = MP + rl, col = u.cb * 64 + 32 * blk + 4 * m4;
        a = a * ascale;
        if (POOL) a = a * P.q3;
        f32x4 v;
        if (idn) v = P.q0 * ALPHA + a; else v = ((P.q0 - P.mu) * P.rs * P.q1 + P.q2) * ALPHA + a;
        { u32x2 wh; wh.x = pk2h(v[0], v[1]); wh.y = pk2h(v[2], v[3]); *(u32x2*)(zfo + (size_t)row * D + col) = wh; }
        if (Z8) *(unsigned*)((unsigned char*)zb + (size_t)row * D + col) = pk4_fp8(v[0], v[1], v[2], v[3]);
        else { u32x2 w; w.x = cvt_pk_bf16(v[0], v[1]); w.y = cvt_pk_bf16(v[2], v[3]); *(u32x2*)(zb + (size_t)row * D + col) = w; }
        red[(m4 + 8 * blk) * 32 + n] = (f32x2){(v[0] + v[1]) + (v[2] + v[3]), (v[0] * v[0] + v[1] * v[1]) + (v[2] * v[2] + v[3] * v[3])};
        __syncthreads();
        if (tid < 32) { f32x2 t = red[tid];
#pragma unroll
            for (int j = 1; j < 16; ++j) t += red[j * 32 + tid];
            *(f32x2*)(sst_new + (size_t)(u.rb * 32 + tid) * 64 + u.cb * 2) = t; }
    }
};
}

struct Args { const float* in[20]; float* out; unsigned char* ws; };
enum { I_XP = 0, I_XS, I_CAK, I_CAV, I_SPOOL, I_CMK, I_CMV, I_MEMP, I_WQKV, I_WAO, I_RELB, I_WPOOL, I_PSC, I_WMQ, I_WMKV, I_WMO, I_WFI, I_WFO, I_LNG, I_LNB };

__global__ void __launch_bounds__(NTHR, 2) mk_fwd(Args args) {
    extern __shared__ __attribute__((aligned(16))) unsigned char lds_raw[];
    LAS unsigned char* lds = (LAS unsigned char*)lds_raw;
    const int G = gridDim.x, bx = blockIdx.x;
    const bool skf = ((blockIdx.x >> 3) & 1) != 0;
    const int wv = __builtin_amdgcn_readfirstlane((int)(threadIdx.x >> 6));
#define PHASE_IDS int tid = wv * 64 + lane_id(); asm volatile("" : "+v"(tid)); const int lane = tid & 63, wave = wv; (void)lane; (void)wave;
#define CAS __attribute__((address_space(4)))
#define PHASE_PTRS CAS const char* ka_ = (CAS const char*)__builtin_amdgcn_kernarg_segment_ptr(); asm volatile("" : "+s"(ka_)); \
    unsigned char* const ws = *(unsigned char* const CAS*)(ka_ + 168); float* const out = *(float* const CAS*)(ka_ + 160); (void)out; \
    float* const vec = (float*)(ws + WS_CTL); (void)vec;
#define IN(k) (((const float* const CAS*)ka_)[k])
#define wqkv ((bf16_t*)(ws + WS_WQKV))
#define wqkv8 (ws + WS_WQKV8)
#define wao (ws + WS_WAO)
#define wpool ((bf16_t*)(ws + WS_WPOOL))
#define wmq (ws + WS_WMQ)
#define wmkv ((bf16_t*)(ws + WS_WMKV))
#define wmo (ws + WS_WMO)
#define wfi (ws + WS_WFI)
#define wfo (ws + WS_WFO)
#define z8 (ws + WS_Z8)
#define zf ((half_t*)(ws + WS_ZF))
#define zb ((bf16_t*)(ws + WS_ZB))
#define qkv ((bf16_t*)(ws + WS_BIG))
#define qm ((bf16_t*)(ws + WS_QM))
#define Sb ((float*)(ws + WS_S))
#define Pb ((bf16_t*)(ws + WS_P))
#define Hb (ws + WS_H)
#define ob ((bf16_t*)(ws + WS_OB))
#define ob8 (ws + WS_OB)
#define kvs ((bf16_t*)(ws + WS_KVS))
#define mks ((bf16_t*)(ws + WS_MKS))
#define mvts ((bf16_t*)(ws + WS_MVTS))
#define memb ((bf16_t*)(ws + WS_MEMB))
#define mkp ((bf16_t*)(ws + WS_MKP))
#define mk8 (ws + WS_MK8)
#define mv8 (ws + WS_MV8)
#define wqr8 (ws + WS_WQR8)
#define w1 (ws + WS_W1)
#define w2 (ws + WS_W2)
#define Pb8 (ws + WS_P)
#define mvtp ((bf16_t*)(ws + WS_MVTP))
#define stA ((float*)(ws + WS_ST))
#define stB ((float*)(ws + WS_ST + ST_BYTES))
#define sstA ((float*)(ws + WS_SST))
#define sstB ((float*)(ws + WS_SST + SST_BYTES))
#define lng IN(I_LNG)
#define lnb IN(I_LNB)
    static_assert(sizeof(Args) == 176, "kernarg layout: in[20] at 0, out at 160, ws at 168");
    volatile LAS unsigned* misc = (volatile LAS unsigned*)(lds + MISC_OFF);
    if (threadIdx.x < 64) misc[threadIdx.x] = 0u;
    __syncthreads();
    const XcdBarrier bar = xcd_barrier_post((unsigned*)(args.ws + WS_CTL) + CW_BAR, misc + 8);
    LAS f32x2* const red = (LAS f32x2*)(lds + RED_OFF);
    LAS f32x2* const sred = (LAS f32x2*)(lds + RED_OFF);

    if (PH(0)) for (int rep_ = 0; rep_ < NREP(100); ++rep_) { PHASE_PTRS
        PHASE_IDS
        float* const vecw = rep_ ? nullptr : vec;
        LAS float* scr = (LAS float*)(lds + wave * 16640);
        const int gw = bx * NWAVES + wave, NGW = G * NWAVES;
        constexpr int I_QKV = (D / 64) * (6144 / 64), I_SQ = (D / 64) * (D / 64), I_POOLG = (512 / 64) * (512 / 64), I_MKV = (D / 64) * (4096 / 64),
                      I_FI = (D / 64) * (2 * DFF / 64), I_FO = (DFF / 64) * (D / 64), I_CMVT = (256 / 64) * (D / 64);
        constexpr int N0 = 2 * I_QKV, N1 = N0 + 2 * I_SQ, N2 = N1 + 8 * I_POOLG, N3 = N2 + 4 * I_SQ, N4 = N3 + 4 * I_MKV, N5 = N4 + 4 * I_SQ, N6 = N5 + 4 * I_FI,
                      N7 = N6 + 4 * I_FO, N8 = N7 + 32 * I_CMVT;
        for (int it = gw; it < N8; it += NGW) {
            if (it < N0) { const int l = it / I_QKV, r = it % I_QKV; const bool f = (l == 1);
                tr_item(IN(I_WQKV) + (size_t)l * D * 6144, D, 6144, 6144, wqkv + (size_t)l * 6144 * D, scr, r, lane, f ? lng + (1 * 3 + 2) * D : nullptr, f ? lnb + (1 * 3 + 2) * D : nullptr, vecw ? vecw + V_QKV_U : nullptr, vecw ? vecw + V_QKV_C : nullptr, false, false, wqkv8 + (size_t)l * 6144 * D, vecw ? vecw + V_QKV8_U : nullptr); }
            else if (it < N1) { const int l = (it - N0) / I_SQ, r = (it - N0) % I_SQ;
                tr_item(IN(I_WAO) + (size_t)l * D * D, D, D, D, (bf16_t*)(wao + (size_t)l * D * D), scr, r, lane, nullptr, nullptr, nullptr, nullptr, false, true); }
            else if (it < N2) { const int pg = (it - N1) / I_POOLG, r = (it - N1) % I_POOLG;
                tr_item(IN(I_WPOOL) + (size_t)pg * 512 * 512, 512, 512, 512, wpool + (size_t)pg * 512 * 512, scr, r, lane, nullptr, nullptr, nullptr, nullptr, false); }
            else if (it < N3) { const int l = (it - N2) / I_SQ, r = (it - N2) % I_SQ;
                tr_item(IN(I_WMQ) + (size_t)l * D * D, D, D, D, (bf16_t*)(wmq + (size_t)l * D * D), scr, r, lane, lng + (l * 3 + 0) * D, lnb + (l * 3 + 0) * D, vecw ? vecw + V_MQ_U + l * D : nullptr, vecw ? vecw + V_MQ_C + l * D : nullptr, false, true, nullptr, nullptr, wqr8 + (size_t)l * D * D); }
            else if (it < N4) { const int l = (it - N3) / I_MKV, r = (it - N3) % I_MKV;
                tr_item(IN(I_WMKV) + (size_t)l * D * 4096, D, 4096, 4096, wmkv + (size_t)l * 4096 * D, scr, r, lane, nullptr, nullptr, nullptr, nullptr, false); }
            else if (it < N5) { const int l = (it - N4) / I_SQ, r = (it - N4) % I_SQ;
                tr_item(IN(I_WMO) + (size_t)l * D * D, D, D, D, (bf16_t*)(wmo + (size_t)l * D * D), scr, r, lane, nullptr, nullptr, nullptr, nullptr, false, true); }
            else if (it < N6) { const int l = (it - N5) / I_FI, r = (it - N5) % I_FI;
                tr_item(IN(I_WFI) + (size_t)l * D * 2 * DFF, D, 2 * DFF, 2 * DFF, (bf16_t*)(wfi + (size_t)l * 2 * DFF * D), scr, r, lane, lng + (l * 3 + 1) * D, lnb + (l * 3 + 1) * D, vecw ? vecw + V_FI_U + l * 2 * DFF : nullptr, vecw ? vecw + V_FI_C + l * 2 * DFF : nullptr, true, true); }
            else if (it < N7) { const int l = (it - N6) / I_FO, r = (it - N6) % I_FO;
                tr_item(IN(I_WFO) + (size_t)l * DFF * D, DFF, D, D, (bf16_t*)(wfo + (size_t)l * D * DFF), scr, r, lane, nullptr, nullptr, nullptr, nullptr, false, true); }
            else { const int lb = (it - N7) / I_CMVT, r = (it - N7) % I_CMVT;
                tr_item(IN(I_CMV) + (size_t)lb * 256 * D, 256, D, D, mvts + (size_t)lb * D * 256, scr, r, lane, nullptr, nullptr, nullptr, nullptr, false); }
        }
        constexpr int R0 = MP, R1 = R0 + MS, R2 = R1 + NB * NMEM, R3 = R2 + 2 * SBAT * 512, R4 = R3 + 2 * SBAT * 512, R5 = R4 + 4 * SBAT * NMEM, R6 = R5 + 2 * 2 * SBAT * 32, R7 = R6;
        for (int rw = gw; rw < R7; rw += NGW) {
            if (rw < R0) { if (((rw >> 8) & 15) >= 14) cvt_row(IN(I_XP) + (size_t)rw * D, zb + (size_t)rw * D, lane, z8 + (size_t)rw * D); else cvt_row8(IN(I_XP) + (size_t)rw * D, z8 + (size_t)rw * D, lane); }
            else if (rw < R1) cvt_row(IN(I_XS) + (size_t)(rw - R0) * D, zb + (size_t)rw * D, lane);
            else if (rw < R2) cvt_row(IN(I_MEMP) + (size_t)(rw - R1) * D, memb + (size_t)(rw - R1) * D, lane);
            else if (rw < R3) { const int q = rw - R2, ab = q >> 9, t = q & 511, a = ab >> 3, b = ab & 7;
                cvt_row(IN(I_CAK) + (size_t)q * D, kvs + ((size_t)((a * 2 + 0) * SBAT + b) * KVROWS + t) * D, lane); }
            else if (rw < R4) { const int q = rw - R3, ab = q >> 9, t = q & 511, a = ab >> 3, b = ab & 7;
                cvt_row(IN(I_CAV) + (size_t)q * D, kvs + ((size_t)((a * 2 + 1) * SBAT + b) * KVROWS + t) * D, lane); }
            else if (rw < R5) { const int q = rw - R4; cvt_row(IN(I_CMK) + (size_t)q * D, mks + (size_t)q * D, lane); }
            else if (rw >= R6) { const int q = rw - R6, l = q >> 11, zd = q & 2047;
                const float sc = WQR_SCALE * lng[(size_t)(l * 3) * D + zd]; const GAS f32x4* s = (const GAS f32x4*)(IN(I_WMQ) + (size_t)q * D) + lane; GAS unsigned* o8 = (GAS unsigned*)(wqr8 + (size_t)q * D) + lane;
#pragma unroll
                for (int j = 0; j < 8; ++j) { const f32x4 v = s[64 * j] * sc; o8[64 * j] = pk4_fp8(v[0], v[1], v[2], v[3]); } }
            else { const int q = rw - R5, akb = q >> 5, t = q & 31;
                GAS u32x2* o = (GAS u32x2*)(kvs + ((size_t)akb * KVROWS + 544 + t) * D) + lane;
#pragma unroll
                for (int j = 0; j < 8; ++j) o[64 * j] = (u32x2){0u, 0u}; }
        }
    }
    xcd_barrier(bar, wv);

    if (PH(1)) for (int rep_ = 0; rep_ < NREP(101); ++rep_) { PHASE_PTRS
        pg8::OrdMemKV2 S{G, bx, (const char*)memb, (const char*)wmkv};
        pg8::EpiMemKV2 E{mk8, mv8, out + O_MKP, out + O_MVP};
        pg8::gemm_phase(lds, wv, D, D, D, S, E);
    }
    xcd_barrier(bar, wv);
    if (PH(1)) { PHASE_PTRS
        pg8::OrdW12 S{G, bx, (const char*)mk8, (const char*)wqr8, (const char*)wmo, (const char*)mv8};
        pg8::EpiW12 E{w1, w2, vec + V_S1_U, vec + V_S1_C, lng, lnb};
        pg8::gemm_phase<true>(lds, wv, 256, D / 2, D / 2, S, E);
    }
    xcd_barrier(bar, wv);

    for (int layer = 0; layer < DEPTH; ++layer) {
        if (PROBE_ID == 120) for (int xb_ = 0; xb_ < 10; ++xb_) xcd_barrier(bar, wv);
        const int a = layer >> 1;
        const int s0 = 3 * layer;
#define st_in (((s0 - 1) & 1) ? stB : stA)
#define st_0 ((s0 & 1) ? stB : stA)
#define st_1 (((s0 + 1) & 1) ? stB : stA)
#define st_2 (((s0 + 2) & 1) ? stB : stA)
#define sst_in (((s0 - 1) & 1) ? sstB : sstA)
#define sst_0 ((s0 & 1) ? sstB : sstA)
#define sst_1 (((s0 + 1) & 1) ? sstB : sstA)
#define sst_2 (((s0 + 2) & 1) ? sstB : sstA)
        const bool idn = (layer == 0);
#define g_in (lng + (size_t)((layer - 1) * 3 + 2) * D)
#define b_in (lnb + (size_t)((layer - 1) * 3 + 2) * D)
        if ((layer & 1) == 0) {
            if (PH(2)) for (int rep_ = 0; rep_ < NREP(102); ++rep_) { PHASE_PTRS
                pg8::OrdQKV8 S8{G, bx, (const char*)z8, (const char*)(wqkv8 + (size_t)a * 6144 * D)};
                pg8::EpiQKV8 E8{st_in, idn, vec + V_QKV8_U, vec + V_QKV_C, qkv};
                pg8::OrdQKVTail St{G, bx, (const char*)zb, (const char*)(wqkv + (size_t)a * 6144 * D)};
                pg8::EpiQKV Et{st_in, idn, vec + V_QKV_U, vec + V_QKV_C, qkv, kvs + (size_t)a * 2 * SBAT * KVROWS * D,
                               out + O_AKP + (size_t)a * NB * 512 * D, out + O_AKS + (size_t)a * MS * D};
                sk::SEpiQKV Es{sst_in, idn, vec + V_QKV_U, vec + V_QKV_C, qkv, kvs + (size_t)a * 2 * SBAT * KVROWS * D, out + O_AKS + (size_t)a * MS * D};
                _Pragma("unroll 1") for (int pass_ = 0; pass_ < 2; ++pass_) {
                    if ((pass_ == 0) != skf) { pg8::gemm_phase<true>(lds, wv, D / 2, D / 2, D / 2, S8, E8); pg8::gemm_phase(lds, wv, D, D, D, St, Et); }
                    else { for (int srep_ = 0; srep_ < ((PROBE_ID == 300) ? 2 : 1); ++srep_) sk::skinny_phase<0, false, true>((LAS char*)lds, wv, zb + (size_t)MP * D, D, wqkv + (size_t)a * 6144 * D, D, D, 6144 / 64, G, bx, Es); __syncthreads(); }
                }
            }
            xcd_barrier(bar, wv);
            if (PH(3)) for (int rep_ = 0; rep_ < NREP(103); ++rep_) { PHASE_PTRS
                const float* relb = IN(I_RELB) + (size_t)a * NHEAD * NREL;
                const bf16_t* kvsa = kvs + (size_t)a * 2 * SBAT * KVROWS * D;
                for (int it = 0; ; ++it) {
                    int U;
                    if (G != 256) { U = bx + it * G; if (U >= 1152) break; }
                    else if (it < 3) U = bx + 256 * it;
                    else if (it == 3) U = bx < 128 ? 768 + bx : 1024 + (bx - 128);
                    else if (it == 4 && bx >= 128) U = 896 + (bx - 128);
                    else break;
                    const bf16_t *Qp, *Kp, *Vp; unsigned char* Op; int kvst, T_lo, T_hi, cbase, nact, h; bool smp = false;
                    if (U < 1024) { int bh, qb; if (U < 896) { bh = U & 63; qb = 2 + (U >> 6); } else { bh = (U - 896) & 63; qb = 1 - ((U - 896) >> 6); }
                        const int b = bh >> 4; h = bh & 15;
                        const bf16_t* base = qkv + (size_t)b * SEQ * 6144 + h * HD;
                        Qp = base + (size_t)qb * 256 * 6144; Kp = base + 2048; Vp = base + 4096; kvst = 6144; Op = ob8 + ((size_t)b * SEQ + qb * 256) * D + h * HD;
                        T_lo = 4 * qb - 8 < 0 ? 0 : 4 * qb - 8; T_hi = 4 * qb + 4; cbase = 4 * qb; nact = 8; }
                    else { const int v = U - 1024, b = v >> 4; h = v & 15; smp = true;
                        Qp = qkv + (size_t)(MP + b * ST) * 6144 + h * HD; Kp = kvsa + (size_t)(0 * SBAT + b) * KVROWS * D + h * HD; Vp = kvsa + (size_t)(1 * SBAT + b) * KVROWS * D + h * HD;
                        kvst = D; Op = ob8 + (size_t)(MP + b * ST) * D + h * HD; T_lo = 0; T_hi = 9; cbase = 8; nact = 1; }
                    att::attn_unit((LAS char*)lds, Qp, 6144, Kp, Vp, kvst, Op, T_lo, T_hi, cbase, nact, smp, relb + h * NREL, wv);
                }
            }
            xcd_barrier(bar, wv);
            if (PH(4)) for (int rep_ = 0; rep_ < NREP(204); ++rep_) { PHASE_PTRS const bool dry_ = (NREP(204) == 2 && rep_ == 0); half_t* const zfo_ = dry_ ? (half_t*)(ws + WS_DUMMY) : zf; bf16_t* const zlo_ = dry_ ? (bf16_t*)(ws + WS_DUMMY + (size_t)M * D * 4) : (bf16_t*)z8; float* const stn_ = dry_ ? (float*)(ws + WS_DUMMY + (size_t)M * D * 4 + (size_t)MPAD * D * 2) : st_0; float* const sstn_ = dry_ ? (float*)(ws + WS_DUMMY + (size_t)M * D * 4 + (size_t)MPAD * D * 2 + ST_BYTES) : sst_0;
                pg8::OrdStd S{MP / 256, D / 256, G, bx, (const char*)ob8, (const char*)(wao + (size_t)a * D * D), (size_t)256 * D, (size_t)256 * D, 0, 0};
                pg8::EpiRes<false, true> E{st_in, stn_, idn, IN(I_XP), IN(I_XS), zf, zlo_, g_in, b_in, nullptr, red, W8_INV * O8_INV, zfo_, nullptr};
                sk::SEpiRes<false, true> Es{sst_in, sstn_, idn, IN(I_XS), zf, zlo_, g_in, b_in, nullptr, sred, W8_INV * O8_INV, zfo_};
                _Pragma("unroll 1") for (int pass_ = 0; pass_ < 2; ++pass_) {
                    if ((pass_ == 0) != skf) { pg8::gemm_phase<true>(lds, wv, D / 2, D / 2, D / 2, S, E); }
                    else { sk::skinny_phase<0, true>((LAS char*)lds, wv, (const bf16_t*)(ob8 + (size_t)MP * D), D / 2, (const bf16_t*)(wao + (size_t)a * D * D), D / 2, D / 2, D / 64, G, bx, Es); __syncthreads(); }
                }
            }
            xcd_barrier(bar, wv);
        } else {
            const int p = layer >> 1;
            if (PH(5)) for (int rep_ = 0; rep_ < NREP(105); ++rep_) { PHASE_PTRS
                PHASE_IDS
                LAS float* stl = (LAS float*)lds;
                const int col = 4 * tid;
                const f32x4 gq = *(const f32x4*)(g_in + col), bq = *(const f32x4*)(b_in + col);
                for (int U = bx; U < 1040; U += G) {
                    const bool smp = U >= 1024;
                    const int b = smp ? (U - 1024) >> 1 : U >> 8, t0 = smp ? ((U - 1024) & 1) * 16 : (U & 255) * 16;
                    const size_t row0 = smp ? (size_t)MP + b * ST + t0 : (size_t)b * SEQ + t0;
                    __syncthreads();
                    if (tid < 31) { const int t = t0 - 15 + tid;
                        if (t >= 0) { const f32x4* pp = smp ? (const f32x4*)(sst_in + (size_t)(b * ST + t) * 64) : (const f32x4*)(st_in + (row0 + (tid - 15)) * 16); float s = 0.f, q = 0.f;
                            const int np = smp ? 16 : 4;
                            for (int k = 0; k < np; ++k) { const f32x4 v = pp[k]; s += v[0] + v[2]; q += v[1] + v[3]; }
                            const float mm = s * (1.f / D), var = q * (1.f / D) - mm * mm; stl[2 * tid] = mm; stl[2 * tid + 1] = __builtin_amdgcn_rsqf(var + LN_EPS); } }
                    __syncthreads();
                    const float* spool = IN(I_SPOOL) + ((size_t)(p * SBAT + b) * 15) * D + col;
                    const half_t* zrow = zf + row0 * D + col;
                    bf16_t* urow = ob + row0 * D + col;
                    float* prow = smp ? out + O_PS + ((size_t)(p * SBAT + b) * 15) * D + col : out + O_PP + ((size_t)(p * NB + b) * 15) * D + col;
                    const bool wout = smp ? (t0 == 16) : (t0 == SEQ - 16);
#define POOL_BODY(W) do { f32x4 xv[15 + (W)]; \
                        _Pragma("unroll") for (int i = 0; i < 15 + (W); ++i) { const int tr = i - ((W) - 1), t = t0 + tr;            \
                            if (t >= 0) xv[i] = unpack4h(*(const u32x2*)(zrow + (ptrdiff_t)tr * D)); \
                            else if (smp) xv[i] = *(const f32x4*)(spool + (ptrdiff_t)(15 + t) * D); \
                            else xv[i] = (f32x4){0.f, 0.f, 0.f, 0.f}; } \
                        _Pragma("unroll") for (int i = 0; i < 15 + (W); ++i) { const int tr = i - ((W) - 1), t = t0 + tr; \
                            if (t >= 0) { const float mm = stl[2 * (tr + 15)], rr = stl[2 * (tr + 15) + 1]; xv[i] = (xv[i] - mm) * rr * gq + bq; } } \
                        f32x4 s = {0.f, 0.f, 0.f, 0.f}; \
                        _Pragma("unroll") for (int i = 0; i < (W) - 1; ++i) s += xv[i]; \
                        _Pragma("unroll") for (int t = 0; t < 16; ++t) { s += xv[t + (W) - 1]; \
                            const int cnt = smp ? (W) : ((t0 + t + 1 < (W)) ? t0 + t + 1 : (W)); \
                            const f32x4 uo = s * (1.0f / (float)cnt) - xv[t + (W) - 1]; \
                            u32x2 wv; wv.x = pk2(uo[0], uo[1]); wv.y = pk2(uo[2], uo[3]); \
                            *(u32x2*)(urow + (size_t)t * D) = wv; \
                            if (wout && t >= 1) *(f32x4*)(prow + (size_t)(t - 1) * D) = xv[t + (W) - 1]; \
                            s -= xv[t]; } } while (0)
                    const int wsel = tid >> 7;
                    if (wsel == 0) POOL_BODY(2); else if (wsel == 1) POOL_BODY(4); else if (wsel == 2) POOL_BODY(8); else POOL_BODY(16);
#undef POOL_BODY
                }
            }
            xcd_barrier(bar, wv);
            if (PH(6)) for (int rep_ = 0; rep_ < NREP(204); ++rep_) { PHASE_PTRS const bool dry_ = (NREP(204) == 2 && rep_ == 0); half_t* const zfo_ = dry_ ? (half_t*)(ws + WS_DUMMY) : zf; bf16_t* const zlo_ = dry_ ? (bf16_t*)(ws + WS_DUMMY + (size_t)M * D * 4) : (bf16_t*)z8; float* const stn_ = dry_ ? (float*)(ws + WS_DUMMY + (size_t)M * D * 4 + (size_t)MPAD * D * 2) : st_0; float* const sstn_ = dry_ ? (float*)(ws + WS_DUMMY + (size_t)M * D * 4 + (size_t)MPAD * D * 2 + ST_BYTES) : sst_0;
                pg8::OrdStd S{MP / 256, D / 256, G, bx, (const char*)ob, (const char*)(wpool + (size_t)p * D * 512), (size_t)256 * D * 2, (size_t)256 * 512 * 2, 1, 512 * 2};
                pg8::EpiRes<true, true> E{st_in, stn_, false, nullptr, nullptr, zf, zlo_, g_in, b_in, IN(I_PSC) + (size_t)p * D, red, 1.f, zfo_, nullptr};
                sk::SEpiRes<true, true> Es{sst_in, sstn_, false, nullptr, zf, zlo_, g_in, b_in, IN(I_PSC) + (size_t)p * D, sred, 1.f, zfo_};
                _Pragma("unroll 1") for (int pass_ = 0; pass_ < 2; ++pass_) {
                    if ((pass_ == 0) != skf) { pg8::gemm_phase(lds, wv, 512, D, 512, S, E); }
                    else { sk::skinny_phase<2>((LAS char*)lds, wv, ob + (size_t)MP * D, D, wpool + (size_t)p * D * 512, 512, 512, D / 64, G, bx, Es); __syncthreads(); }
                }
            }
            xcd_barrier(bar, wv);
        }
        if (PH(7)) for (int rep_ = 0; rep_ < NREP(107); ++rep_) { PHASE_PTRS
            pg8::OrdS8 S{G, bx, (const char*)z8, (const char*)(w1 + (size_t)layer * NB * 1024 * D)};
            pg8::EpiSoftP8 E{st_0, vec + V_S1_U + layer * NB * 1024, vec + V_S1_C + layer * NB * 1024, Pb8, (LAS float*)(lds + RED_OFF)};
            sk::SEpiLin Es{sst_0, vec + V_MQ_U + layer * D, vec + V_MQ_C + layer * D, qm, W8_INV};
            _Pragma("unroll 1") for (int pass_ = 0; pass_ < 2; ++pass_) {
                if ((pass_ == 0) != skf) { pg8::gemm_phase<true>(lds, wv, D / 2, D / 2, D / 2, S, E); }
                else { sk::skinny_phase<0, true>((LAS char*)lds, wv, (const bf16_t*)(z8 + (size_t)MP * D), D / 2, (const bf16_t*)(wmq + (size_t)layer * D * D), D / 2, D / 2, D / 64, G, bx, Es); __syncthreads(); }
            }
        }
        xcd_barrier(bar, wv);
        if (PH(11)) for (int rep_ = 0; rep_ < NREP(211); ++rep_) { PHASE_PTRS const bool dry_ = (NREP(211) == 2 && rep_ == 0); half_t* const zfo_ = dry_ ? (half_t*)(ws + WS_DUMMY) : zf; bf16_t* const zlo_ = dry_ ? (bf16_t*)(ws + WS_DUMMY + (size_t)M * D * 4) : (bf16_t*)z8; float* const stn_ = dry_ ? (float*)(ws + WS_DUMMY + (size_t)M * D * 4 + (size_t)MPAD * D * 2) : st_1;
            pg8::OrdG2 S{G, bx, (const char*)Pb8, (const char*)(w2 + (size_t)layer * NB * D * 1024)};
            pg8::EpiRes<false, true> E{st_0, stn_, false, nullptr, nullptr, zf, zlo_, lng + (size_t)(layer * 3 + 0) * D, lnb + (size_t)(layer * 3 + 0) * D, nullptr, red, 1.f / (P8_SCALE * W2_SCALE), zfo_, nullptr};
            pg8::gemm_phase<true>(lds, wv, 512, 512, 512, S, E);
            if (rep_ == NREP(211) - 1) for (int U = bx; U < 64; U += G) { const int b = U >> 3, h = (U >> 1) & 3;
                smem_attn_unit((LAS char*)lds, qm + (size_t)(MP + b * ST) * D + h * MHD, mks + ((size_t)(layer * SBAT + b) * NMEM) * D + h * MHD,
                               mvts + ((size_t)(layer * SBAT + b) * D + h * MHD) * 256, ob8 + (size_t)(MP + b * ST) * D + h * MHD, wv, U & 1); }
        }
        xcd_barrier(bar, wv);
        if (PH(11)) { PHASE_PTRS
            sk::SEpiRes<false, true> Es{sst_0, sst_1, false, nullptr, zf, (bf16_t*)z8, lng + (size_t)(layer * 3 + 0) * D, lnb + (size_t)(layer * 3 + 0) * D, nullptr, sred, W8_INV * O8_INV, zf};
            sk::skinny_phase<0, true>((LAS char*)lds, wv, (const bf16_t*)(ob8 + (size_t)MP * D), D / 2, (const bf16_t*)(wmo + (size_t)layer * D * D), D / 2, D / 2, D / 64, G, bx, Es);
        }
        xcd_barrier_arrive(bar, wv);
        if (PH(12)) for (int rep_ = 0; rep_ < NREP(112); ++rep_) { PHASE_PTRS
            pg8::OrdStd S{MP / 256, 2 * DFF / 256, G, bx, (const char*)z8, (const char*)(wfi + (size_t)layer * 2 * DFF * D), (size_t)256 * D, (size_t)256 * D, 0, 0};
            pg8::EpiFfnIn E{st_1, vec + V_FI_U + layer * 2 * DFF, vec + V_FI_C + layer * 2 * DFF, Hb, (LAS char*)(lds + RED_OFF), 0, 0, -1};
            sk::SEpiFfnIn Es{sst_1, vec + V_FI_U + layer * 2 * DFF, vec + V_FI_C + layer * 2 * DFF, Hb};
            if (PROBE_ID == 412) { pg8::EpiNone En; pg8::gemm_phase<true>(lds, wv, D / 2, D / 2, D / 2, S, En); }
            if (PROBE_ID == 421) { sk::SEpiNone Esn; sk::skinny_phase<1, true>((LAS char*)lds, wv, (const bf16_t*)(z8 + (size_t)MP * D), D / 2, (const bf16_t*)(wfi + (size_t)layer * 2 * DFF * D), D / 2, D / 2, DFF / 32, G, bx, Esn); __syncthreads(); }
            if (PROBE_ID == 422) { sk::skinny_phase<1, true>((LAS char*)lds, wv, (const bf16_t*)(z8 + (size_t)MP * D), D / 2, (const bf16_t*)(wfi + (size_t)layer * 2 * DFF * D), D / 2, D / 2, DFF / 32, G, bx, Es); __syncthreads(); }
            if (PROBE_ID == 413) { pg8::EpiFfnIn En{st_1, vec + V_FI_U + layer * 2 * DFF, vec + V_FI_C + layer * 2 * DFF, nullptr, (LAS char*)(lds + RED_OFF), 0, 0, -1}; pg8::gemm_phase<true>(lds, wv, D / 2, D / 2, D / 2, S, En); }
            pg8::gemm_phase<true>(lds, wv, D / 2, D / 2, D / 2, S, E);
            if (rep_ == 0) xcd_barrier_wait(bar, wv);
            {
                { for (int srep_ = 0; srep_ < ((PROBE_ID == 300) ? 2 : 1); ++srep_) sk::skinny_phase<1, true>((LAS char*)lds, wv, (const bf16_t*)(z8 + (size_t)MP * D), D / 2, (const bf16_t*)(wfi + (size_t)layer * 2 * DFF * D), D / 2, D / 2, DFF / 32, G, bx, Es); __syncthreads(); }
            }
        }
        xcd_barrier(bar, wv);
        if (PH(13)) for (int rep_ = 0; rep_ < NREP(213); ++rep_) { PHASE_PTRS const bool nxa = (layer == 1); const bool dry_ = (NREP(213) == 2 && rep_ == 0); half_t* const zfo_ = dry_ ? (half_t*)(ws + WS_DUMMY) : zf; bf16_t* const zlo_ = dry_ ? (bf16_t*)(ws + WS_DUMMY + (size_t)M * D * 4) : zb; float* const stn_ = dry_ ? (float*)(ws + WS_DUMMY + (size_t)M * D * 4 + (size_t)MPAD * D * 2) : st_2; float* const sstn_ = dry_ ? (float*)(ws + WS_DUMMY + (size_t)M * D * 4 + (size_t)MPAD * D * 2 + ST_BYTES) : sst_2;
            pg8::OrdStd S{MP / 256, D / 256, G, bx, (const char*)Hb, (const char*)(wfo + (size_t)layer * D * DFF), (size_t)256 * DFF, (size_t)256 * DFF, 0, 0};
            pg8::EpiRes<false> E{st_1, stn_, false, nullptr, nullptr, zf, nxa ? zlo_ : nullptr, lng + (size_t)(layer * 3 + 1) * D, lnb + (size_t)(layer * 3 + 1) * D, nullptr, red, W8_INV * H8_INV, zfo_, (nxa && !dry_) ? z8 : nullptr};
            sk::SEpiRes<false> Es{sst_1, sstn_, false, nullptr, zf, zlo_, lng + (size_t)(layer * 3 + 1) * D, lnb + (size_t)(layer * 3 + 1) * D, nullptr, sred, W8_INV * H8_INV, zfo_};
            _Pragma("unroll 1") for (int pass_ = 0; pass_ < 2; ++pass_) {
                if ((pass_ == 0) != skf) { pg8::gemm_phase<true>(lds, wv, DFF / 2, DFF / 2, DFF / 2, S, E); }
                else { sk::skinny_phase<0, true>((LAS char*)lds, wv, (const bf16_t*)(Hb + (size_t)MP * DFF), DFF / 2, (const bf16_t*)(wfo + (size_t)layer * D * DFF), DFF / 2, DFF / 2, D / 64, G, bx, Es); __syncthreads(); }
            }
        }
        xcd_barrier(bar, wv);
    }

    if (PH(14)) for (int rep_ = 0; rep_ < NREP(114); ++rep_) { PHASE_PTRS
        PHASE_IDS
        const float* gl = lng + (size_t)(3 * 3 + 2) * D; const float* bl = lnb + (size_t)(3 * 3 + 2) * D;
        f32x4 G0[4], G1[4], B0[4], B1[4];
#pragma unroll
        for (int j = 0; j < 4; ++j) { G0[j] = ((const f32x4*)gl)[2 * lane + 128 * j]; G1[j] = ((const f32x4*)gl)[2 * lane + 128 * j + 1]; B0[j] = ((const f32x4*)bl)[2 * lane + 128 * j]; B1[j] = ((const f32x4*)bl)[2 * lane + 128 * j + 1]; }
        u32x4 zc[4];
        { const int r0_ = bx * NWAVES + wave; if (r0_ < M) { const u32x4* zr = (const u32x4*)(zf + (size_t)r0_ * D) + lane;
#pragma unroll
            for (int j = 0; j < 4; ++j) zc[j] = zr[64 * j]; } }
        for (int r = bx * NWAVES + wave; r < M; r += G * NWAVES) {
            f32x4* yo = (f32x4*)(out + (size_t)r * D) + 2 * lane;
            u32x4 zn[4]; const int rn_ = r + G * NWAVES;
            if (rn_ < M) { const u32x4* zr = (const u32x4*)(zf + (size_t)rn_ * D) + lane;
#pragma unroll
                for (int j = 0; j < 4; ++j) zn[j] = zr[64 * j]; }
            float v[4][8]; float s = 0.f;
#pragma unroll
            for (int j = 0; j < 4; ++j) { unpack8h(zc[j], v[j]);
#pragma unroll
                for (int e = 0; e < 8; ++e) s += v[j][e]; }
            const float mean = wave_sum(s) * (1.f / D); float s2 = 0.f;
#pragma unroll
            for (int j = 0; j < 4; ++j)
#pragma unroll
                for (int e = 0; e < 8; ++e) { v[j][e] -= mean; s2 += v[j][e] * v[j][e]; }
            const float rstd = 1.0f / sqrtf(wave_sum(s2) * (1.f / D) + LN_EPS);
#pragma unroll
            for (int j = 0; j < 4; ++j) { yo[128 * j] = (f32x4){v[j][0], v[j][1], v[j][2], v[j][3]} * rstd * G0[j] + B0[j]; yo[128 * j + 1] = (f32x4){v[j][4], v[j][5], v[j][6], v[j][7]} * rstd * G1[j] + B1[j]; }
            if (rn_ < M) {
#pragma unroll
                for (int j = 0; j < 4; ++j) zc[j] = zn[j]; }
        }
    }
}

extern "C" void kernel_launch(void* const* d_in, const int* in_sizes, int n_in, void* d_out, int out_size, void* d_ws, size_t ws_size, hipStream_t stream) {
    static int grid = 0;
    if (grid == 0) {
        if (n_in != 20 || (size_t)out_size != O_END || ws_size < (PROBE_ID ? WS_END_PROBE : WS_END)) { fprintf(stderr, "kernel_launch: unexpected shapes (n_in %d, out %d vs %zu, ws %zu vs %zu)\n", n_in, out_size, (size_t)O_END, ws_size, (size_t)WS_END); grid = -1; return; }
        int dev = 0, cus = 0, per_cu = 0;
        if (hipGetDevice(&dev) != hipSuccess || hipDeviceGetAttribute(&cus, hipDeviceAttributeMultiprocessorCount, dev) != hipSuccess) { grid = -1; return; }
        if (hipFuncSetAttribute((const void*)mk_fwd, hipFuncAttributeMaxDynamicSharedMemorySize, LDS_BYTES) != hipSuccess) { fprintf(stderr, "kernel_launch: hipFuncSetAttribute failed\n"); grid = -1; return; }
        if (hipOccupancyMaxActiveBlocksPerMultiprocessor(&per_cu, (const void*)mk_fwd, NTHR, LDS_BYTES) != hipSuccess || per_cu < 1) { fprintf(stderr, "kernel_launch: occupancy query says %d\n", per_cu); }
        (void)hipGetLastError();
        grid = cus;
    }
    if (grid < 0) return;
    if (hipMemsetAsync((char*)d_ws + WS_CTL, 0, CTL_BYTES, stream) != hipSuccess) return;
    Args a{};
    for (int i = 0; i < 20; ++i) a.in[i] = (const float*)d_in[i];
    a.out = (float*)d_out; a.ws = (unsigned char*)d_ws;
    hipLaunchKernelGGL(mk_fwd, dim3(grid), dim3(NTHR), LDS_BYTES, stream, a);
}
```

```cpp
#include <hip/hip_runtime.h>
#include <cstdio>
#include <cstdint>

#define LAS __attribute__((address_space(3)))
#define GAS __attribute__((address_space(1)))
typedef unsigned short bf16_t;
typedef short bf16x8 __attribute__((ext_vector_type(8)));
typedef short s16x4 __attribute__((ext_vector_type(4)));
typedef float f32x4 __attribute__((ext_vector_type(4)));
typedef float f32x2 __attribute__((ext_vector_type(2)));
typedef float f32x16 __attribute__((ext_vector_type(16)));
typedef unsigned u32x4 __attribute__((ext_vector_type(4)));
typedef unsigned u32x2 __attribute__((ext_vector_type(2)));
typedef int i32x8 __attribute__((ext_vector_type(8)));
typedef int i32x4 __attribute__((ext_vector_type(4)));

constexpr int D = 2048, NB = 4, SEQ = 4096, DEPTH = 4, SBAT = 8, ST = 32, DFF = 5632;
constexpr int MP = NB * SEQ, MS = SBAT * ST, M = MP + MS, MPAD = M + 256;
constexpr int NHEAD = 16, HD = 128, NREL = 257, NMEM = 256, MHD = 512;
constexpr int KVROWS = 576;
constexpr float ALPHA = 1.6817928305074290f;
constexpr float LN_EPS = 1e-5f;
constexpr float LOG2E = 1.4426950408889634f;
constexpr int NWAVES = 8, NTHR = 512;
#ifndef ONLY
#define ONLY -1
#endif
#define PH(k) (ONLY < 0 || ONLY == (k))
#ifndef PROBE_ID
#define PROBE_ID 0
#endif
#define NREP(k) ((PROBE_ID == (k) || (PROBE_ID == 130 && ((k) == 108 || (k) == 110)) || (PROBE_ID == 131 && ((k) == 101 || (k) == 114))) ? 2 : 1)

constexpr size_t O_YP = 0, O_YS = O_YP + (size_t)MP * D, O_AKP = O_YS + (size_t)MS * D, O_AVP = O_AKP + (size_t)2 * NB * 512 * D,
                 O_PP = O_AVP + (size_t)2 * NB * 512 * D, O_MKP = O_PP + (size_t)2 * NB * 15 * D, O_MVP = O_MKP + (size_t)DEPTH * NB * NMEM * D,
                 O_AKS = O_MVP + (size_t)DEPTH * NB * NMEM * D, O_AVS = O_AKS + (size_t)2 * MS * D, O_PS = O_AVS + (size_t)2 * MS * D,
                 O_END = O_PS + (size_t)2 * SBAT * 15 * D;

constexpr size_t al256(size_t x) { return (x + 255) & ~(size_t)255; }
constexpr size_t WS_CTL = 0, CTL_BYTES = 2u << 20;
constexpr size_t WS_WQKV = WS_CTL + CTL_BYTES;
constexpr size_t WS_WQKV8 = WS_WQKV + (size_t)2 * 6144 * D * 2;
constexpr size_t WS_WAO  = WS_WQKV8 + (size_t)2 * 6144 * D;
constexpr size_t WS_WPOOL= WS_WAO + (size_t)2 * D * D;
constexpr size_t WS_WMQ  = WS_WPOOL + (size_t)2 * D * 512 * 2;
constexpr size_t WS_WMKV = WS_WMQ + (size_t)4 * D * D;
constexpr size_t WS_WMO  = WS_WMKV + (size_t)4 * 4096 * D * 2;
constexpr size_t WS_WFI  = WS_WMO + (size_t)4 * D * D;
constexpr size_t WS_WFO  = WS_WFI + (size_t)4 * 2 * DFF * D;
constexpr size_t WS_Z8   = WS_WFO + (size_t)4 * D * DFF;
constexpr size_t WS_ZF   = WS_Z8 + (size_t)MPAD * D;
constexpr size_t WS_ZB   = WS_ZF + (size_t)M * D * 2;
constexpr size_t WS_BIG  = WS_ZB + (size_t)MPAD * D * 2;
constexpr size_t BIG_BYTES = (size_t)MPAD * 6144 * 2;
constexpr size_t WS_QM   = WS_BIG;
constexpr size_t WS_S    = WS_QM + (size_t)MPAD * D * 2;
constexpr size_t WS_P    = WS_S + (size_t)MP * 1024 * 4;
constexpr size_t WS_H    = WS_BIG;
static_assert(WS_P + (size_t)MP * 1024 * 2 <= WS_BIG + BIG_BYTES && (size_t)M * DFF * 2 <= BIG_BYTES, "overlays");
constexpr size_t WS_OB   = WS_BIG + BIG_BYTES;
constexpr size_t WS_KVS  = WS_OB + (size_t)MPAD * D * 2;
constexpr size_t WS_MKS  = WS_KVS + (size_t)2 * 2 * SBAT * KVROWS * D * 2;
constexpr size_t WS_MVTS = WS_MKS + (size_t)4 * SBAT * NMEM * D * 2;
constexpr size_t WS_MEMB = WS_MVTS + (size_t)4 * SBAT * NMEM * D * 2;
constexpr size_t WS_MKP  = WS_MEMB + (size_t)NB * NMEM * D * 2;
constexpr size_t WS_MK8 = WS_MKP, WS_MV8 = WS_MKP + (size_t)4 * NB * NMEM * D;
constexpr size_t WS_MVTP = WS_MKP + (size_t)4 * NB * NMEM * D * 2;
constexpr size_t WS_WQR8 = WS_MVTP;
constexpr size_t WS_ST   = WS_MVTP + (size_t)4 * NB * NMEM * D * 2;
constexpr size_t ST_BYTES = (size_t)M * 16 * 4;
constexpr size_t WS_SST  = WS_ST + 2 * ST_BYTES;
constexpr size_t SST_BYTES = (size_t)MS * 64 * 4;
constexpr size_t WS_W1   = WS_SST + 2 * SST_BYTES;
constexpr size_t WS_W2   = WS_W1 + (size_t)4 * NB * 1024 * D;
constexpr size_t WS_END  = WS_W2 + (size_t)4 * NB * D * 1024;
constexpr size_t WS_DUMMY = WS_END;
constexpr size_t WS_END_PROBE = WS_DUMMY + (size_t)M * D * 4 + (size_t)MPAD * D * 2 + ST_BYTES + SST_BYTES;
constexpr int CW_BAR = 1024;
constexpr int CW_VEC = 8192;
constexpr int V_QKV_U = CW_VEC, V_QKV_C = V_QKV_U + 6144;
constexpr int V_MQ_U = V_QKV_C + 6144, V_MQ_C = V_MQ_U + 4 * D;
constexpr int V_FI_U = V_MQ_C + 4 * D, V_FI_C = V_FI_U + 4 * 2 * DFF, V_QKV8_U = V_FI_C + 4 * 2 * DFF, V_S1_U = V_QKV8_U + 6144, V_S1_C = V_S1_U + 4 * NB * 1024, V_END = V_S1_C + 4 * NB * 1024;
static_assert((size_t)V_END * 4 <= CTL_BYTES, "CTL");

constexpr int RING_BYTES = 131072, MISC_OFF = 135168  , RED_OFF = MISC_OFF + 1024, LDS_BYTES = 147456;
static_assert(8 * 16640 <= MISC_OFF && RED_OFF + 8192 <= LDS_BYTES, "LDS map");

__device__ __forceinline__ unsigned cvt_pk_bf16(float lo, float hi) { unsigned r; asm volatile("v_cvt_pk_bf16_f32 %0, %1, %2" : "=v"(r) : "v"(lo), "v"(hi)); return r; }
__device__ __forceinline__ u32x4 pack8(const float (&v)[8]) { u32x4 w; w.x = cvt_pk_bf16(v[0], v[1]); w.y = cvt_pk_bf16(v[2], v[3]); w.z = cvt_pk_bf16(v[4], v[5]); w.w = cvt_pk_bf16(v[6], v[7]); return w; }
__device__ __forceinline__ unsigned f2bf(float f) { unsigned u = __builtin_bit_cast(unsigned, f); return (u + 0x7fffu + ((u >> 16) & 1u)) >> 16; }
__device__ __forceinline__ float bf2f(unsigned b) { return __builtin_bit_cast(float, b << 16); }
__device__ __forceinline__ unsigned pk2(float lo, float hi) { return f2bf(lo) | (f2bf(hi) << 16); }
__device__ __forceinline__ int lane_id() { int l; asm volatile("v_mbcnt_lo_u32_b32 %0, -1, 0\n\tv_mbcnt_hi_u32_b32 %0, -1, %0" : "=v"(l)); return l; }
__device__ __forceinline__ float shx(float v, int mask) { const int l = lane_id(); return __builtin_bit_cast(float, __builtin_amdgcn_ds_bpermute((l ^ mask) << 2, __builtin_bit_cast(int, v))); }
__device__ __forceinline__ int shx(int v, int mask) { const int l = lane_id(); return __builtin_amdgcn_ds_bpermute((l ^ mask) << 2, v); }
__device__ __forceinline__ float shl(float v, int src) { return __builtin_bit_cast(float, __builtin_amdgcn_ds_bpermute(src << 2, __builtin_bit_cast(int, v))); }
__device__ __forceinline__ float wave_sum(float v) {
#pragma unroll
    for (int o = 1; o < 64; o <<= 1) v += shx(v, o);
    return v;
}
__device__ __forceinline__ float wave_max(float v) {
#pragma unroll
    for (int o = 1; o < 64; o <<= 1) v = fmaxf(v, shx(v, o));
    return v;
}
typedef _Float16 h16x2 __attribute__((ext_vector_type(2)));
typedef _Float16 h16x8 __attribute__((ext_vector_type(8)));
typedef unsigned short half_t;
__device__ __forceinline__ unsigned pk2h(float a, float b) { const h16x2 v = {(_Float16)a, (_Float16)b}; return __builtin_bit_cast(unsigned, v); }
__device__ __forceinline__ u32x4 pack8h(const float (&v)[8]) { u32x4 w; w.x = pk2h(v[0], v[1]); w.y = pk2h(v[2], v[3]); w.z = pk2h(v[4], v[5]); w.w = pk2h(v[6], v[7]); return w; }
__device__ __forceinline__ void unpack8h(u32x4 w, float (&v)[8]) { const h16x8 h = __builtin_bit_cast(h16x8, w);
#pragma unroll
    for (int i = 0; i < 8; ++i) v[i] = (float)h[i]; }
__device__ __forceinline__ f32x4 unpack4h(u32x2 w) { typedef _Float16 h16x4 __attribute__((ext_vector_type(4))); const h16x4 h = __builtin_bit_cast(h16x4, w); return (f32x4){(float)h[0], (float)h[1], (float)h[2], (float)h[3]}; }
constexpr float W8_SCALE = 1024.f, W8_INV = 1.f / 1024.f;
constexpr float H8_SCALE = 32.f, H8_INV = 1.f / 32.f;
constexpr float QSCALE = 0.08838834764831845f * 1.4426950408889634f;
constexpr float O8_SCALE = 64.f, O8_INV = 1.f / 64.f;
constexpr float WQR_SCALE = 64.f, MV8_SCALE = 8.f, W1_SCALE = 16.f, W2_SCALE = 64.f, P8_SCALE = 256.f;
__device__ __forceinline__ unsigned pk4_fp8(float a, float b, float c, float d) { int w = 0; w = __builtin_amdgcn_cvt_pk_fp8_f32(a, b, w, false); w = __builtin_amdgcn_cvt_pk_fp8_f32(c, d, w, true); return (unsigned)w; }
__device__ __forceinline__ u32x2 pack8_fp8(const float (&v)[8]) { u32x2 w; w.x = pk4_fp8(v[0], v[1], v[2], v[3]); w.y = pk4_fp8(v[4], v[5], v[6], v[7]); return w; }
__device__ __forceinline__ u32x4 widen8(u32x2 p0, u32x2 p1) {
    const auto x = __builtin_amdgcn_permlane16_swap(p0.x, p1.x, false, false); const auto y = __builtin_amdgcn_permlane16_swap(p0.y, p1.y, false, false);
    return (u32x4){x[0], y[0], x[1], y[1]};
}
__device__ __forceinline__ float sum4_fp8(unsigned w) { return (__builtin_amdgcn_cvt_f32_fp8((int)w, 0) + __builtin_amdgcn_cvt_f32_fp8((int)w, 1)) + (__builtin_amdgcn_cvt_f32_fp8((int)w, 2) + __builtin_amdgcn_cvt_f32_fp8((int)w, 3)); }
#define LDS_WAIT() asm volatile("s_waitcnt lgkmcnt(0)" ::: "memory")
#define VM_WAIT() asm volatile("s_waitcnt vmcnt(0)" ::: "memory")

#define XB_TMO      128
#define XB_XCNT(j)  (256  + 64 * (j))
#define XB_XSUB(j)  (1280 + 64 * (j))
#define XB_XGEN(j)  (2304 + 64 * (j))
#define XB_TOP      3328
#define XB_TOPGEN   3392
#define XCD_BAR_WORDS 3456
#define XB_SPIN_CAP (1u << 18)
static_assert(CW_BAR + XCD_BAR_WORDS <= CW_VEC, "CTL map");
__device__ __forceinline__ unsigned xb_ld(unsigned* p)              { return __hip_atomic_load(p, __ATOMIC_RELAXED, __HIP_MEMORY_SCOPE_AGENT); }
__device__ __forceinline__ unsigned xb_add(unsigned* p, unsigned v) { return __hip_atomic_fetch_add(p, v, __ATOMIC_RELAXED, __HIP_MEMORY_SCOPE_AGENT); }
__device__ __forceinline__ unsigned xb_xcc_id() { return (unsigned)__builtin_amdgcn_s_getreg((3 << 11) | 20) & 0xFu; }
#define XB_SPIN(cond, bar) do { unsigned _sp = 0; while (cond) { __builtin_amdgcn_s_sleep(1); \
    if ((++_sp & 255u) == 0u) { if (xb_ld(&(bar)[XB_TMO])) break; if (_sp > XB_SPIN_CAP) { atomicAdd(&(bar)[XB_TMO], 1u); break; } } } } while (0)
struct XcdBarrier { unsigned* bar; unsigned x; volatile LAS unsigned* st; };
__device__ __forceinline__ XcdBarrier xcd_barrier_post(unsigned* bar, volatile LAS unsigned* st) {
    XcdBarrier b; b.bar = bar; b.x = xb_xcc_id(); b.st = st;
    if (threadIdx.x == 0) (void)xb_add(&bar[XB_XCNT(b.x)], 1u);
    return b;
}
__device__ __forceinline__ void xcd_barrier_complete(unsigned* bar, unsigned x, unsigned& nloc, unsigned& nx) {
    const unsigned G = gridDim.x * gridDim.y * gridDim.z;
    unsigned sum, cnt, mine, sp = 0u;
    for (;;) {
        sum = 0u; cnt = 0u; mine = 0u;
#pragma unroll
        for (unsigned j = 0; j < 16; ++j) { const unsigned c = xb_ld(&bar[XB_XCNT(j)]); sum += c; cnt += (c > 0u) ? 1u : 0u; mine = (j == x) ? c : mine; }
        if (sum == G) break;
        __builtin_amdgcn_s_sleep(1);
        if ((++sp & 255u) == 0u) { if (xb_ld(&bar[XB_TMO])) break; if (sp > XB_SPIN_CAP) { atomicAdd(&bar[XB_TMO], 1u); break; } }
    }
    nloc = mine > 0u ? mine : 1u; nx = cnt > 0u ? cnt : 1u;
}
__device__ __forceinline__ void xcd_barrier(const XcdBarrier& b, const int wv) {
    asm volatile("s_waitcnt vmcnt(0)" ::: "memory");
    __syncthreads();
    if (wv == 0 && lane_id() == 0) {
        unsigned* bar = b.bar; unsigned bx_ = b.x;
        asm volatile("" : "+s"(bar), "+s"(bx_));
        __builtin_amdgcn_s_waitcnt(0);
        unsigned nloc = b.st[0], nx = b.st[1];
        if (nloc == 0u) { xcd_barrier_complete(bar, bx_, nloc, nx); b.st[0] = nloc; b.st[1] = nx; }
        const unsigned old = xb_add(&bar[XB_XSUB(bx_)], 1u);
        const unsigned gen = old / nloc;
        if (old + 1u == (gen + 1u) * nloc) {
            __builtin_amdgcn_fence(__ATOMIC_RELEASE, "agent");
            asm volatile("s_waitcnt vmcnt(0)" ::: "memory");
            const unsigned og = xb_add(&bar[XB_TOP], 1u);
            const unsigned tg = og / nx;
            if (og + 1u == (tg + 1u) * nx) xb_add(&bar[XB_TOPGEN], 1u);
            else XB_SPIN(xb_ld(&bar[XB_TOPGEN]) == tg, bar);
            __builtin_amdgcn_fence(__ATOMIC_ACQUIRE, "agent");
            xb_add(&bar[XB_XGEN(bx_)], 1u);
            asm volatile("s_waitcnt vmcnt(0)" ::: "memory");
        } else {
            XB_SPIN(xb_ld(&bar[XB_XGEN(bx_)]) == gen, bar);
            __builtin_amdgcn_fence(__ATOMIC_ACQUIRE, "agent");
            asm volatile("s_waitcnt vmcnt(0)" ::: "memory");
        }
    }
    __syncthreads();
}

__device__ __forceinline__ void xcd_barrier_arrive(const XcdBarrier& b, const int wv) {
    asm volatile("s_waitcnt vmcnt(0)" ::: "memory");
    __syncthreads();
    if (wv == 0 && lane_id() == 0) {
        unsigned* bar = b.bar; unsigned bx_ = b.x;
        asm volatile("" : "+s"(bar), "+s"(bx_));
        __builtin_amdgcn_s_waitcnt(0);
        unsigned nloc = b.st[0], nx = b.st[1];
        if (nloc == 0u) { xcd_barrier_complete(bar, bx_, nloc, nx); b.st[0] = nloc; b.st[1] = nx; }
        const unsigned old = xb_add(&bar[XB_XSUB(bx_)], 1u);
        const unsigned gen = old / nloc;
        unsigned role = 0u, tg = 0u;
        if (old + 1u == (gen + 1u) * nloc) {
            __builtin_amdgcn_fence(__ATOMIC_RELEASE, "agent");
            asm volatile("s_waitcnt vmcnt(0)" ::: "memory");
            const unsigned og = xb_add(&bar[XB_TOP], 1u);
            tg = og / nx;
            if (og + 1u == (tg + 1u) * nx) { xb_add(&bar[XB_TOPGEN], 1u); role = 2u; } else role = 1u;
        }
        b.st[4] = gen; b.st[5] = role; b.st[6] = tg;
    }
}
__device__ __forceinline__ void xcd_barrier_wait(const XcdBarrier& b, const int wv) {
    if (wv == 0 && lane_id() == 0) {
        unsigned* bar = b.bar; unsigned bx_ = b.x;
        asm volatile("" : "+s"(bar), "+s"(bx_));
        const unsigned gen = b.st[4], role = b.st[5], tg = b.st[6];
        if (role) {
            if (role == 1u) XB_SPIN(xb_ld(&bar[XB_TOPGEN]) == tg, bar);
            __builtin_amdgcn_fence(__ATOMIC_ACQUIRE, "agent");
            xb_add(&bar[XB_XGEN(bx_)], 1u);
            asm volatile("s_waitcnt vmcnt(0)" ::: "memory");
        } else {
            XB_SPIN(xb_ld(&bar[XB_XGEN(bx_)]) == gen, bar);
            __builtin_amdgcn_fence(__ATOMIC_ACQUIRE, "agent");
            asm volatile("s_waitcnt vmcnt(0)" ::: "memory");
        }
    }
    __syncthreads();
}

namespace pg8 {
constexpr int BM = 256, BK = 64, HALF = 128, HTB = HALF * BK * 2, STAGE_BYTES = 8 * HTB, NXCD = 8, WGM = 8;
__host__ __device__ __forceinline__ int lds_byte(int r, int c) { const int st = (r >> 4) * 2 + (c >> 5), rr = r & 15, cc = c & 31, ob = rr * 64 + cc * 2; return st * 1024 + (ob ^ (((ob >> 9) & 1) << 5)); }
__host__ __device__ __forceinline__ void stage_rc(int b, int& R, int& C) { const int st = b / 1024, sb = b % 1024, swz = sb ^ (((sb >> 9) & 1) << 5); R = (st >> 1) * 16 + swz / 64; C = (st & 1) * 32 + (swz % 64) / 2; }
__host__ __device__ __forceinline__ int perm32(int rho) { const int n = rho >> 4, i = rho & 15; return 8 * (i >> 2) + 4 * n + (i & 3); }

struct Unit { int pm, pn; const char* A; const char* B; };

__device__ __forceinline__ void tile_of(int L, int nM, int nN, int& pm, int& pn) {
    const int nwg = nM * nN; int wgid = L;
    { const int q = nwg / NXCD, r = nwg % NXCD, xcd = wgid % NXCD, off = wgid / NXCD; wgid = (xcd < r ? xcd * (q + 1) : r * (q + 1) + (xcd - r) * q) + off; }
    const int nig = WGM * nN, gid = wgid / nig, fm = gid * WGM, gsz = (nM - fm) < WGM ? (nM - fm) : WGM;
    pm = fm + ((wgid % nig) % gsz); pn = (wgid % nig) / gsz;
}

template <class T, class = void> struct HasPre { static constexpr bool value = false; };
template <class T> struct HasPre<T, decltype((void)T::kPre)> { static constexpr bool value = true; };
template <bool FP8 = false, class Epi, class Sched>
__device__ __forceinline__ void gemm_phase(LAS unsigned char* lds, const int wv, const int K, const int lda, const int ldb, const Sched& S, const Epi& E) {
    int tid = wv * 64 + lane_id(); asm volatile("" : "+v"(tid));
    const int wid = __builtin_amdgcn_readfirstlane(tid >> 6), lane = tid & 63, wr = wid >> 2, wc = wid & 3, fr = lane & 15, fq = lane >> 4;
    const int nt = K / BK;
    unsigned voffA, voffB;
    { int R, C; stage_rc(tid * 16, R, C); const int Rb = 64 * (R >> 5) + 8 * ((R >> 2) & 3) + 4 * ((R >> 4) & 1) + (R & 3); voffA = (unsigned)(R * lda + C) * 2u; voffB = (unsigned)(Rb * ldb + C) * 2u; }
    const size_t qstepA = (size_t)64 * lda * 2, qstepB = (size_t)128 * ldb * 2;
    const size_t kstep = (size_t)(BK * 2);
    const size_t hstepA = (size_t)HALF * lda * 2, hstepB = (size_t)32 * ldb * 2;
    const unsigned ldsw = (unsigned)wid * 1024u;
    const unsigned ldsbase = (unsigned)(uintptr_t)lds + ldsw;
    const int aoff = lds_byte(wr * 64 + fr, fq * 8), boff = lds_byte(wc * 32 + fr, fq * 8);
#define PG8_SA(b, h) (((b) * 2 + (h)) * HTB)
#define PG8_SB(b, h) ((4 + (b) * 2 + (h)) * HTB)
#define PG8_STAGE_(bufoff, gbase, voff, qstep) do { _Pragma("unroll") for (int _i = 0; _i < 2; ++_i) { \
        asm volatile("s_mov_b32 m0, %2\n\ts_nop 0\n\tglobal_load_lds_dwordx4 %0, %1" \
            :: "v"(voff), "s"((const char*)(gbase) + (_i ? (qstep) : (size_t)0)), "s"(ldsbase + (unsigned)((bufoff) + _i * 8192)) : "memory", "m0"); } } while (0)
#define PG8_STAGE(bufoff, gbase, voff) PG8_STAGE_(bufoff, gbase, voff, voff##_q)
#define voffA_q qstepA
#define voffB_q qstepB
#define PG8_LDA(dst, b, h) do { _Pragma("unroll") for (int m = 0; m < 4; ++m) _Pragma("unroll") for (int k = 0; k < 2; ++k) dst[m][k] = *(const LAS bf16x8*)(lds + PG8_SA(b, h) + aoff + m * 2048 + k * 1024); } while (0)
#define PG8_LDB(dst, b, h) do { _Pragma("unroll") for (int n = 0; n < 2; ++n) _Pragma("unroll") for (int k = 0; k < 2; ++k) dst[n][k] = *(const LAS bf16x8*)(lds + PG8_SB(b, h) + boff + n * 2048 + k * 1024); } while (0)
#define PG8_CAT8(x0, x1) __builtin_shufflevector(__builtin_bit_cast(i32x4, x0), __builtin_bit_cast(i32x4, x1), 0, 1, 2, 3, 4, 5, 6, 7)
#define PG8_MMA(ai, bj, At, Bt) do { __builtin_amdgcn_s_setprio(1); _Pragma("unroll") for (int m = 0; m < 4; ++m) _Pragma("unroll") for (int n = 0; n < 2; ++n) { \
        if constexpr (FP8) acc[ai][bj][m][n] = __builtin_amdgcn_mfma_scale_f32_16x16x128_f8f6f4(PG8_CAT8(Bt[n][0], Bt[n][1]), PG8_CAT8(At[m][0], At[m][1]), acc[ai][bj][m][n], 0, 0, 0, 0x7f7f7f7f, 0, 0x7f7f7f7f); \
        else { _Pragma("unroll") for (int k = 0; k < 2; ++k) acc[ai][bj][m][n] = __builtin_amdgcn_mfma_f32_16x16x32_bf16(Bt[n][k], At[m][k], acc[ai][bj][m][n], 0, 0, 0); } } \
        __builtin_amdgcn_s_setprio(0); } while (0)
#define PG8_WAIT_V(n) asm volatile("s_waitcnt vmcnt(" #n ")" ::: "memory")
#define PG8_WAIT_L(n) asm volatile("s_waitcnt lgkmcnt(" #n ")" ::: "memory")
#define PG8_BAR __builtin_amdgcn_s_barrier()
#define PG8_SCHED __builtin_amdgcn_sched_barrier(0)
    Unit cur, nxt; int ui = 0;
    if (!S.next(0, cur)) return;
    if constexpr (HasPre<Epi>::value) E.prefetch(cur, wid, lane);
    f32x4 acc[2][2][4][2];
#pragma unroll
    for (int a = 0; a < 2; ++a)
#pragma unroll
        for (int b = 0; b < 2; ++b)
#pragma unroll
            for (int m = 0; m < 4; ++m)
#pragma unroll
                for (int n = 0; n < 2; ++n) acc[a][b][m][n] = (f32x4){0.f, 0.f, 0.f, 0.f};
    bf16x8 At[4][2], B0[2][2], B1[2][2];
    const char* cA = cur.A; const char* cB = cur.B;
    PG8_STAGE(PG8_SB(0, 0), cB, voffB); PG8_STAGE(PG8_SB(0, 1), cB + hstepB, voffB); PG8_STAGE(PG8_SA(0, 0), cA, voffA); PG8_STAGE(PG8_SA(0, 1), cA + hstepA, voffA);
    if (wr == 1) PG8_BAR;
    PG8_WAIT_V(2); PG8_BAR;
    PG8_STAGE(PG8_SB(1, 0), cB + kstep, voffB); PG8_STAGE(PG8_SA(1, 0), cA + kstep, voffA); PG8_STAGE(PG8_SB(1, 1), cB + hstepB + kstep, voffB);
    PG8_WAIT_V(6); PG8_BAR;
    for (;;) {
        const bool has_next = S.next(ui + 1, nxt);
        const char* nA = has_next ? nxt.A : cA; const char* nB = has_next ? nxt.B : cB;
#pragma unroll 1
        for (int t = 0; t < nt; t += 2) {
            const bool last = (t == nt - 2);
            const char* a1 = cA + (size_t)(t + 1) * kstep;
            const char* a2 = last ? nA : cA + (size_t)(t + 2) * kstep; const char* b2 = last ? nB : cB + (size_t)(t + 2) * kstep;
            const char* a3 = a2 + kstep; const char* b3 = b2 + kstep;
            PG8_LDB(B0, 0, 0); PG8_LDB(B1, 0, 1); PG8_SCHED; PG8_LDA(At, 0, 0); PG8_STAGE(PG8_SA(1, 1), a1 + hstepA, voffA);
            PG8_WAIT_V(8); PG8_WAIT_L(0); PG8_BAR; PG8_MMA(0, 0, At, B0); PG8_MMA(0, 1, At, B1); PG8_BAR; PG8_SCHED;
            PG8_LDA(At, 0, 1); PG8_STAGE(PG8_SB(0, 0), b2, voffB); PG8_STAGE(PG8_SB(0, 1), b2 + hstepB, voffB); PG8_STAGE(PG8_SA(0, 0), a2, voffA);
            PG8_WAIT_V(8); PG8_WAIT_L(0); PG8_BAR; PG8_MMA(1, 0, At, B0); PG8_MMA(1, 1, At, B1); PG8_BAR; PG8_SCHED;
            PG8_LDB(B0, 1, 0); PG8_LDB(B1, 1, 1); PG8_SCHED; PG8_LDA(At, 1, 0); PG8_STAGE(PG8_SA(0, 1), a2 + hstepA, voffA);
            PG8_WAIT_V(8); PG8_WAIT_L(0); PG8_BAR; PG8_MMA(0, 0, At, B0); PG8_MMA(0, 1, At, B1); PG8_BAR; PG8_SCHED;
            PG8_LDA(At, 1, 1); PG8_STAGE(PG8_SB(1, 0), b3, voffB); PG8_STAGE(PG8_SB(1, 1), b3 + hstepB, voffB); PG8_STAGE(PG8_SA(1, 0), a3, voffA);
            PG8_WAIT_V(8); PG8_WAIT_L(0); PG8_BAR; PG8_MMA(1, 0, At, B0); PG8_MMA(1, 1, At, B1); PG8_BAR; PG8_SCHED;
        }
        if (wr == 0) PG8_BAR;
        E(acc, cur, wr, wc, fr, fq, lane);
        if constexpr (HasPre<Epi>::value) { if (has_next) E.prefetch(nxt, wid, lane); }
        if (!has_next) break;
#pragma unroll
        for (int a = 0; a < 2; ++a)
#pragma unroll
            for (int b = 0; b < 2; ++b)
#pragma unroll
                for (int m = 0; m < 4; ++m)
#pragma unroll
                    for (int n = 0; n < 2; ++n) acc[a][b][m][n] = (f32x4){0.f, 0.f, 0.f, 0.f};
        cur = nxt; cA = nA; cB = nB; ++ui;
        if (wr == 1) PG8_BAR;
    }
    PG8_WAIT_V(0);
    PG8_BAR;
#undef PG8_SA
#undef PG8_SB
#undef PG8_STAGE
#undef PG8_STAGE_
#undef voffA_q
#undef voffB_q
#undef PG8_LDA
#undef PG8_LDB
#undef PG8_MMA
#undef PG8_CAT8
#undef PG8_WAIT_V
#undef PG8_WAIT_L
#undef PG8_BAR
#undef PG8_SCHED
}

struct OrdStd {
    int nM, nN, G, c; const char* A; const char* B; size_t astep, bstep; int ashift, acolb;
    __device__ __forceinline__ bool next(int i, Unit& u) const { const int L = i * G + c; if (L >= nM * nN) return false; tile_of(L, nM, nN, u.pm, u.pn);
        u.A = A + (size_t)u.pm * astep + (size_t)((u.pn >> ashift) * acolb); u.B = B + (size_t)u.pn * bstep; return true; }
};
struct OrdQKV8 {
    int G, c; const char* A; const char* B;
    __device__ __forceinline__ bool next(int i, Unit& u) const { const int x = c & 7, e = (c >> 3) + i * (G >> 3); int j, n;
        if (x & 1) { if (e < 144) { j = e % 6; n = e / 6; } else if (e < 160) { j = 6 + ((e - 144) & 1); n = (e - 144) >> 1; } else return false; }
        else { if (e >= 192) return false; j = e & 7; n = e >> 3; }
        u.pm = 8 * x + j; u.pn = n; u.A = A + (size_t)u.pm * (256 * D) + 0; u.B = B + (size_t)n * (256 * D); return true; }
};
struct OrdQKVTail {
    int G, c; const char* A; const char* B;
    __device__ __forceinline__ bool next(int i, Unit& u) const { const int x = c & 7, r = c >> 3; if (i > 0 || !(x & 1) || r >= 32) return false;
        u.pm = 8 * x + 6 + (r & 1); u.pn = 8 + (r >> 1); u.A = A + (size_t)u.pm * (256 * D * 2); u.B = B + (size_t)u.pn * (256 * D * 2); return true; }
};
struct OrdS {
    int G, c; const char* A; const char* B;
    __device__ __forceinline__ bool next(int i, Unit& u) const { const int L = i * G + c; if (L >= 256) return false; tile_of(L, 64, 4, u.pm, u.pn);
        u.A = A + (size_t)u.pm * (256 * D * 2) + (size_t)u.pn * 1024; u.B = B + (size_t)(u.pm >> 4) * (256 * D * 2) + (size_t)u.pn * 1024; return true; }
};
struct OrdPV {
    int G, c; const char* A; const char* B;
    __device__ __forceinline__ bool next(int i, Unit& u) const { const int L = i * G + c; if (L >= 512) return false; tile_of(L, 64, 8, u.pm, u.pn);
        u.A = A + (size_t)u.pm * (256 * 1024 * 2) + (size_t)(u.pn >> 1) * 512; u.B = B + (size_t)(u.pm >> 4) * (D * 256 * 2) + (size_t)u.pn * (256 * 256 * 2); return true; }
};
struct OrdPV2 {
    int G, c; const char* A; const char* B;
    __device__ __forceinline__ bool next(int i, Unit& u) const { if (c >= 256 || i >= 2) return false; int h; tile_of(c, 64, 4, u.pm, h); u.pn = 2 * h + i;
        u.A = A + (size_t)u.pm * (256 * 1024 * 2) + (size_t)h * 512; u.B = B + (size_t)(u.pm >> 4) * (D * 256 * 2) + (size_t)u.pn * (256 * 256 * 2); return true; }
};
struct OrdMemKV {
    int G, c; const char* memb; const char* wt;
    __device__ __forceinline__ bool next(int i, Unit& u) const { const int L = i * G + c; if (L >= 256) return false; const int layer = L >> 6, r = L & 63;
        const char* w = wt + (size_t)layer * (4096 * (size_t)D * 2);
        if (r < 32) { const int tp = r & 3, pn = r >> 2; u.pm = layer * 64 + tp; u.pn = pn; u.A = memb + (size_t)tp * (256 * D * 2); u.B = w + (size_t)pn * (256 * D * 2); }
        else { const int q = r - 32, b = q & 3, vp = q >> 2; u.pm = layer * 64 + 32 + vp; u.pn = b; u.A = w + (size_t)(D + 256 * vp) * (D * 2); u.B = memb + (size_t)b * (256 * D * 2); }
        return true; }
};

__device__ __forceinline__ void wave_stats_load(const float* st, int row0, int lane, bool idn, f32x4 (&v)[2][4]) {
    if (idn) return;
#pragma unroll
    for (int j = 0; j < 2; ++j)
#pragma unroll
        for (int m = 0; m < 4; ++m) v[j][m] = *(const f32x4*)(st + (size_t)((unsigned)(row0 + 128 * j + 16 * m + (lane >> 2)) * 16u + (unsigned)(4 * (lane & 3))));
}
__device__ __forceinline__ void wave_stats_fin(const f32x4 (&v)[2][4], int lane, bool idn, float (&mu)[2][4], float (&rs)[2][4]) {
    if (idn) {
#pragma unroll
        for (int j = 0; j < 2; ++j)
#pragma unroll
            for (int m = 0; m < 4; ++m) { mu[j][m] = 0.f; rs[j][m] = 1.f; }
        return; }
    float invd = 1.f / D, eps = LN_EPS; asm volatile("" : "+s"(invd), "+s"(eps));
    const int a1 = (lane ^ 1) << 2, a2 = (lane ^ 2) << 2;
#pragma unroll
    for (int j = 0; j < 2; ++j)
#pragma unroll
        for (int m = 0; m < 4; ++m) {
            float s = v[j][m][0] + v[j][m][2], q = v[j][m][1] + v[j][m][3];
            s += __builtin_bit_cast(float, __builtin_amdgcn_ds_bpermute(a1, __builtin_bit_cast(int, s))); q += __builtin_bit_cast(float, __builtin_amdgcn_ds_bpermute(a1, __builtin_bit_cast(int, q)));
            s += __builtin_bit_cast(float, __builtin_amdgcn_ds_bpermute(a2, __builtin_bit_cast(int, s))); q += __builtin_bit_cast(float, __builtin_amdgcn_ds_bpermute(a2, __builtin_bit_cast(int, q)));
            const float mm = s * invd, var = q * invd - mm * mm;
            mu[j][m] = mm; rs[j][m] = __builtin_amdgcn_rsqf(var + eps);
        }
}
#define EPI_OPAQUE int pm = u.pm, pn = u.pn, ln_ = lane_id(); (void)lane; asm volatile("" : "+s"(pm), "+s"(pn), "+v"(ln_)); const int fr = ln_ & 15, fq = ln_ >> 4; (void)fr_; (void)fq_; \
        int rl = 64 * wr + fr;
#define EPI_ROWLOOP_BEGIN _Pragma("unroll") for (int ai = 0; ai < 2; ++ai) _Pragma("unroll") for (int m = 0; m < 4; ++m) { \
        asm volatile("" : "+v"(rl)); const float mr = shl(mu[ai][m], 4 * fr), rr = shl(rs[ai][m], 4 * fr);
#define EPI_ROWLOOP_END asm volatile("" ::: "memory"); rl += (m == 3) ? 80 : 16; }

struct EpiQKV {
    const float* st; bool idn; const float* uvec; const float* cvec;
    bf16_t* qkv; bf16_t* kvs; float* okp; float* oks;
    __device__ __forceinline__ void operator()(const f32x4 (&acc)[2][2][4][2], const Unit& u, int wr, int wc, int fr_, int fq_, int lane) const {
        EPI_OPAQUE
        const int which = pn >> 3; const bool smp = (pm == 64), tail = (!smp) && ((pm & 15) >= 14);
        f32x4 sv_[2][4]; wave_stats_load(st, pm * 256 + wr * 64, ln_, idn, sv_);
#define STATS_FIN float mu[2][4], rs[2][4]; wave_stats_fin(sv_, ln_, idn, mu, rs);
        const int colb = pn * 256 + wc * 64 + 8 * fq;
        f32x4 uu[2][2], cc[2][2];
#pragma unroll
        for (int bj = 0; bj < 2; ++bj)
#pragma unroll
            for (int n = 0; n < 2; ++n) { if (idn) { uu[bj][n] = (f32x4){0.f, 0.f, 0.f, 0.f}; cc[bj][n] = uu[bj][n]; }
                else { uu[bj][n] = *(const f32x4*)(uvec + colb + 32 * bj + 4 * n); cc[bj][n] = *(const f32x4*)(cvec + colb + 32 * bj + 4 * n); } }
        STATS_FIN
#undef STATS_FIN
        EPI_ROWLOOP_BEGIN
            const unsigned r = (unsigned)pm * 256u + (unsigned)rl;
            const float nrm = -rr * mr;
#pragma unroll
            for (int bj = 0; bj < 2; ++bj) {
                float v[8];
#pragma unroll
                for (int n = 0; n < 2; ++n)
#pragma unroll
                    for (int e = 0; e < 4; ++e) v[4 * n + e] = __builtin_fmaf(rr, acc[ai][bj][m][n][e], __builtin_fmaf(nrm, uu[bj][n][e], cc[bj][n][e]));
                const int col = colb + 32 * bj;
                *(u32x4*)(qkv + (size_t)(r * 6144u + (unsigned)col)) = pack8(v);
                if (which) {
                    const int colh = col - 2048 * which;
                    if (smp) { const int b = rl >> 5, t = rl & 31;
                        *(u32x4*)(kvs + (size_t)((unsigned)(((which - 1) * SBAT + b) * KVROWS + 512 + t) * (unsigned)D + (unsigned)colh)) = pack8(v);
                        float* o = oks + (size_t)(which - 1) * (O_AVS - O_AKS) + (size_t)((unsigned)rl * (unsigned)D + (unsigned)colh);
                        *(f32x4*)o = (f32x4){v[0], v[1], v[2], v[3]}; *(f32x4*)(o + 4) = (f32x4){v[4], v[5], v[6], v[7]}; }
                    else if (tail) { const int b = pm >> 4, pos = (pm & 15) * 256 + rl - 3584;
                        float* o = okp + (size_t)(which - 1) * (O_AVP - O_AKP) + (size_t)((unsigned)(b * 512 + pos) * (unsigned)D + (unsigned)colh);
                        *(f32x4*)o = (f32x4){v[0], v[1], v[2], v[3]}; *(f32x4*)(o + 4) = (f32x4){v[4], v[5], v[6], v[7]}; }
                }
            }
        EPI_ROWLOOP_END
    }
};
struct EpiNone { __device__ __forceinline__ void operator()(const f32x4 (&acc)[2][2][4][2], const Unit& u, int wr, int wc, int fr_, int fq_, int lane) const {
#pragma unroll
        for (int a = 0; a < 2; ++a)
#pragma unroll
            for (int b = 0; b < 2; ++b)
#pragma unroll
                for (int m = 0; m < 4; ++m)
#pragma unroll
                    for (int n = 0; n < 2; ++n) asm volatile("" :: "v"(acc[a][b][m][n])); } };
struct EpiQKV8 {
    const float* st; bool idn; const float* uvec; const float* cvec; bf16_t* qkv;
    __device__ __forceinline__ void operator()(const f32x4 (&acc)[2][2][4][2], const Unit& u, int wr, int wc, int fr_, int fq_, int lane) const {
        EPI_OPAQUE
        float kw = W8_INV; asm volatile("" : "+s"(kw));
        const float qs = 1.0f + (QSCALE - 1.0f) * (float)(pn < 8 ? 1 : 0);
        f32x4 sv_[2][4]; wave_stats_load(st, pm * 256 + wr * 64, ln_, idn, sv_);
        const int colb = pn * 256 + wc * 64 + 8 * fq;
        f32x4 uu[2][2], cc[2][2];
#pragma unroll
        for (int bj = 0; bj < 2; ++bj)
#pragma unroll
            for (int n = 0; n < 2; ++n) { if (idn) { uu[bj][n] = (f32x4){0.f, 0.f, 0.f, 0.f}; cc[bj][n] = uu[bj][n]; }
                else { uu[bj][n] = *(const f32x4*)(uvec + colb + 32 * bj + 4 * n); cc[bj][n] = *(const f32x4*)(cvec + colb + 32 * bj + 4 * n); } }
        float mu[2][4], rs[2][4]; wave_stats_fin(sv_, ln_, idn, mu, rs);
        EPI_ROWLOOP_BEGIN
            const unsigned r = (unsigned)pm * 256u + (unsigned)rl;
            const float rw = rr * kw * qs, nrm = -rr * mr * qs;
#pragma unroll
            for (int bj = 0; bj < 2; ++bj) {
                float v[8];
#pragma unroll
                for (int n = 0; n < 2; ++n)
#pragma unroll
                    for (int e = 0; e < 4; ++e) v[4 * n + e] = __builtin_fmaf(rw, acc[ai][bj][m][n][e], __builtin_fmaf(nrm, uu[bj][n][e], cc[bj][n][e] * qs));
                *(u32x4*)(qkv + (size_t)(r * 6144u + (unsigned)(colb + 32 * bj))) = pack8(v);
            }
        EPI_ROWLOOP_END
    }
};
struct EpiLinBf16 {
    const float* st; const float* uvec; const float* cvec; bf16_t* out; float ascale;
    __device__ __forceinline__ void operator()(const f32x4 (&acc)[2][2][4][2], const Unit& u, int wr, int wc, int fr_, int fq_, int lane) const {
        EPI_OPAQUE
        float as_ = ascale; asm volatile("" : "+s"(as_));
        f32x4 sv_[2][4]; wave_stats_load(st, pm * 256 + wr * 64, ln_, false, sv_);
#define STATS_FIN float mu[2][4], rs[2][4]; wave_stats_fin(sv_, ln_, false, mu, rs);
        const int colb = pn * 256 + wc * 64 + 8 * fq;
        f32x4 uu[2][2], cc[2][2];
#pragma unroll
        for (int bj = 0; bj < 2; ++bj)
#pragma unroll
            for (int n = 0; n < 2; ++n) { uu[bj][n] = *(const f32x4*)(uvec + colb + 32 * bj + 4 * n); cc[bj][n] = *(const f32x4*)(cvec + colb + 32 * bj + 4 * n); }
        STATS_FIN
#undef STATS_FIN
        EPI_ROWLOOP_BEGIN
            const unsigned eo = ((unsigned)pm * 256u + (unsigned)rl) * (unsigned)D + (unsigned)colb;
            const float rw = rr * as_, rm = rr * mr;
#pragma unroll
            for (int bj = 0; bj < 2; ++bj) {
                float v[8];
#pragma unroll
                for (int n = 0; n < 2; ++n)
#pragma unroll
                    for (int e = 0; e < 4; ++e) v[4 * n + e] = __builtin_fmaf(rw, acc[ai][bj][m][n][e], __builtin_fmaf(-rm, uu[bj][n][e], cc[bj][n][e]));
                *(u32x4*)(out + (size_t)(eo + 32u * bj)) = pack8(v);
            }
        EPI_ROWLOOP_END
    }
};
struct EpiFfnIn {
    static constexpr bool kPre = true;
    const float* st; const float* uvec; const float* cvec; unsigned char* H; LAS char* lv; mutable int wpar, rpar, cpm;
    __device__ __forceinline__ void prefetch(const Unit& u, int wid, int lane) const {
        const float* src = wid < 4 ? uvec : cvec;
        const unsigned vo = (unsigned)(u.pn * 256 + (wid & 3) * 64 + lane) * 4u;
        const unsigned dst = (unsigned)(uintptr_t)lv + (unsigned)wpar * 2048u + (unsigned)wid * 256u;
        asm volatile("s_mov_b32 m0, %2\n\ts_nop 0\n\tglobal_load_lds_dword %0, %1" :: "v"(vo), "s"(src), "s"(dst) : "memory", "m0");
        wpar ^= 1;
    }
    __device__ __forceinline__ void operator()(const f32x4 (&acc)[2][2][4][2], const Unit& u, int wr, int wc, int fr_, int fq_, int lane) const {
        EPI_OPAQUE
        float kw = W8_INV, kh = H8_SCALE, lim = 448.f; asm volatile("" : "+s"(kw), "+s"(kh), "+v"(lim));
        const float nlim = -lim; float nl2e = -LOG2E; asm volatile("" : "+s"(nl2e));
        LAS f32x2* tabs = (LAS f32x2*)(lv + 4096);
        if (cpm != pm) {
            f32x4 sv_[2][4]; wave_stats_load(st, pm * 256 + wr * 64, ln_, false, sv_);
            float mu[2][4], rs[2][4]; wave_stats_fin(sv_, ln_, false, mu, rs);
            asm volatile("s_waitcnt lgkmcnt(0)" ::: "memory"); __builtin_amdgcn_s_barrier();
            if (wc == 0 && (ln_ & 3) == 0) {
#pragma unroll
                for (int j = 0; j < 2; ++j)
#pragma unroll
                    for (int m = 0; m < 4; ++m) tabs[128 * j + 64 * wr + 16 * m + (ln_ >> 2)] = (f32x2){mu[j][m], rs[j][m]}; }
            asm volatile("s_waitcnt lgkmcnt(0)" ::: "memory"); __builtin_amdgcn_s_barrier(); asm volatile("" ::: "memory");
            cpm = pm;
        }
        LAS const f32x4* vb = (LAS const f32x4*)(lv + rpar * 2048); rpar ^= 1;
        const int cq = wc * 16 + 2 * fq;
        f32x4 uu[2][2], cc[2][2];
#pragma unroll
        for (int bj = 0; bj < 2; ++bj)
#pragma unroll
            for (int n = 0; n < 2; ++n) { uu[bj][n] = vb[cq + 8 * bj + n]; cc[bj][n] = vb[64 + cq + 8 * bj + n]; }
#pragma unroll
        for (int n = 0; n < 2; ++n) cc[1][n] = cc[1][n] * kh;
#pragma unroll
        for (int ai = 0; ai < 2; ++ai)
#pragma unroll
            for (int m = 0; m < 4; ++m) { asm volatile("" : "+v"(rl));
            const f32x2 ms_ = tabs[128 * ai + 64 * wr + 16 * m + fr]; const float mr = ms_[0], rr = ms_[1];
            const float rw = rr * kw, rm = rr * mr, rwu = rw * kh, rmu = rm * kh;
            float v[8];
#pragma unroll
            for (int n = 0; n < 2; ++n) {
#pragma unroll
                for (int e = 0; e < 4; ++e) { const float g = __builtin_fmaf(rw, acc[ai][0][m][n][e], __builtin_fmaf(-rm, uu[0][n][e], cc[0][n][e]));
                    const float inv = __builtin_amdgcn_rcpf(1.0f + __builtin_amdgcn_exp2f(g * nl2e));
                    const float up = __builtin_fmaf(rwu, acc[ai][1][m][n][e], __builtin_fmaf(-rmu, uu[1][n][e], cc[1][n][e]));
                    v[4 * n + e] = __builtin_amdgcn_fmed3f(g * up * inv, nlim, lim); }
            }
            if (PROBE_ID != 413 || H) *(u32x2*)(H + (size_t)(((unsigned)pm * 256u + (unsigned)rl) * (unsigned)DFF + (unsigned)(pn * 128 + wc * 32 + 8 * fq))) = pack8_fp8(v);
            else asm volatile("" :: "v"(v[0]), "v"(v[1]), "v"(v[2]), "v"(v[3]), "v"(v[4]), "v"(v[5]), "v"(v[6]), "v"(v[7]));
        EPI_ROWLOOP_END
    }
};
template <bool POOL, bool Z8 = false> struct EpiRes {
    const float* st_old; float* st_new; bool idn; const float* xp; const float* xs; half_t* zf; bf16_t* zb; const float* g; const float* b; const float* psc; LAS f32x2* red; float ascale; half_t* zfo; unsigned char* z8x;
    __device__ __forceinline__ void operator()(const f32x4 (&acc)[2][2][4][2], const Unit& u, int wr, int wc, int fr_, int fq_, int lane) const {
        EPI_OPAQUE
        float as_ = ascale; asm volatile("" : "+s"(as_));
        f32x4 sv_[2][4]; wave_stats_load(st_old, pm * 256 + wr * 64, ln_, idn, sv_);
#define STATS_FIN float mu[2][4], rs[2][4]; wave_stats_fin(sv_, ln_, idn, mu, rs);
        const float* zo = pm < 64 ? xp + (size_t)pm * 256 * D : xs;
        const half_t* zoh = zf + (size_t)pm * 256 * D;
        const int colb = pn * 256 + wc * 64 + 8 * fq;
        f32x4 gA[2][2], bA[2][2], ps[2][2];
#pragma unroll
        for (int bj = 0; bj < 2; ++bj)
#pragma unroll
            for (int n = 0; n < 2; ++n) { const int c = colb + 32 * bj + 4 * n;
                if (idn) { gA[bj][n] = (f32x4){ALPHA, ALPHA, ALPHA, ALPHA}; bA[bj][n] = (f32x4){0.f, 0.f, 0.f, 0.f}; }
                else { gA[bj][n] = *(const f32x4*)(g + c) * ALPHA; bA[bj][n] = *(const f32x4*)(b + c) * ALPHA; }
                if (POOL) ps[bj][n] = *(const f32x4*)(psc + c); }
        u32x4 zq[8][2];
#define EPIRES_ZLOAD(gi) do { if (!idn) { _Pragma("unroll") for (int bj_ = 0; bj_ < 2; ++bj_) \
            zq[gi][bj_] = *(const u32x4*)(zoh + (size_t)((unsigned)(128 * ((gi) >> 2) + 64 * wr + 16 * ((gi) & 3) + fr) * (unsigned)D + (unsigned)(colb + 32 * bj_))); } } while (0)
        constexpr int ZPD = POOL ? 1 : 2;
        EPIRES_ZLOAD(0); if (ZPD > 1) EPIRES_ZLOAD(1);
        STATS_FIN
#undef STATS_FIN
        EPI_ROWLOOP_BEGIN
            if (4 * ai + m + ZPD < 8) EPIRES_ZLOAD(4 * ai + m + ZPD);
            const unsigned lo = (unsigned)rl * (unsigned)D + (unsigned)colb;
            const unsigned eo = (unsigned)pm * (256u * D) + lo;
            const float nmr = -mr * rr;
            float s = 0.f, q = 0.f;
#pragma unroll
            for (int bj = 0; bj < 2; ++bj) {
                float zz[8];
                if (idn) { const f32x4 z0 = *(const f32x4*)(zo + (size_t)(lo + 32u * bj)), z1 = *(const f32x4*)(zo + (size_t)(lo + 32u * bj + 4u));
#pragma unroll
                    for (int e = 0; e < 4; ++e) { zz[e] = z0[e]; zz[4 + e] = z1[e]; } }
                else unpack8h(zq[4 * ai + m][bj], zz);
                float v[8];
#pragma unroll
                for (int e = 0; e < 4; ++e) {
                    float a0 = acc[ai][bj][m][0][e] * as_, a1 = acc[ai][bj][m][1][e] * as_;
                    if (POOL) { a0 *= ps[bj][0][e]; a1 *= ps[bj][1][e]; }
                    v[e] = __builtin_fmaf(__builtin_fmaf(zz[e], rr, nmr), gA[bj][0][e], bA[bj][0][e] + a0);
                    v[4 + e] = __builtin_fmaf(__builtin_fmaf(zz[4 + e], rr, nmr), gA[bj][1][e], bA[bj][1][e] + a1);
                }
#pragma unroll
                for (int e = 0; e < 8; ++e) { s += v[e]; q += v[e] * v[e]; }
                *(u32x4*)(zfo + (size_t)(eo + 32u * bj)) = pack8h(v);
                if (Z8) *(u32x2*)((unsigned char*)zb + (size_t)(eo + 32u * bj)) = pack8_fp8(v);
                else { if (zb && (pm & 15) >= 14) *(u32x4*)(zb + (size_t)(eo + 32u * bj)) = pack8(v); if (z8x) *(u32x2*)(z8x + (size_t)(eo + 32u * bj)) = pack8_fp8(v); }
            }
            s += shx(s, 16); s += shx(s, 32); q += shx(q, 16); q += shx(q, 32);
            if (fq == 0) red[((wr * 4 + wc) * 128 + 64 * ai + 16 * m + fr)] = (f32x2){s, q};
        EPI_ROWLOOP_END
        asm volatile("s_waitcnt lgkmcnt(0)" ::: "memory"); __builtin_amdgcn_s_barrier(); asm volatile("" ::: "memory");
        if (ln_ < 32) { const int hrow = 32 * wc + ln_; f32x2 t = red[(wr * 4 + 0) * 128 + hrow];
            t += red[(wr * 4 + 1) * 128 + hrow]; t += red[(wr * 4 + 2) * 128 + hrow]; t += red[(wr * 4 + 3) * 128 + hrow];
            const int rrow = 128 * (hrow >> 6) + 64 * wr + (hrow & 63);
            *(f32x2*)(st_new + (size_t)(((unsigned)pm * 256u + (unsigned)rrow) * 16u + (unsigned)(pn * 2))) = t; }
        asm volatile("s_waitcnt lgkmcnt(0)" ::: "memory");
    }
};
#define EPI_PLAINLOOP_BEGIN _Pragma("unroll") for (int ai = 0; ai < 2; ++ai) _Pragma("unroll") for (int m = 0; m < 4; ++m) { asm volatile("" : "+v"(rl));
struct EpiS {
    float* S;
    __device__ __forceinline__ void operator()(const f32x4 (&acc)[2][2][4][2], const Unit& u, int wr, int wc, int fr_, int fq_, int lane) const {
        EPI_OPAQUE
        EPI_PLAINLOOP_BEGIN
            float* o = S + (size_t)(((unsigned)pm * 256u + (unsigned)rl) * 1024u + (unsigned)(pn * 256 + wc * 64 + 8 * fq));
#pragma unroll
            for (int bj = 0; bj < 2; ++bj) { *(f32x4*)(o + 32 * bj) = acc[ai][bj][m][0]; *(f32x4*)(o + 32 * bj + 4) = acc[ai][bj][m][1]; }
        EPI_ROWLOOP_END
    }
};
struct EpiSoftP {
    bf16_t* P; LAS float* tab;
    __device__ __forceinline__ void operator()(f32x4 (&acc)[2][2][4][2], const Unit& u, int wr, int wc, int fr_, int fq_, int lane) const {
        EPI_OPAQUE
        float c2 = 0.04419417382415922f * LOG2E; asm volatile("" : "+s"(c2));
        LAS float* t0 = tab + (wr * 4) * 128; LAS float* t1 = tab + 1024 + (wr * 4) * 128;
#pragma unroll
        for (int ai = 0; ai < 2; ++ai)
#pragma unroll
            for (int m = 0; m < 4; ++m) { float mx = acc[ai][0][m][0][0];
#pragma unroll
                for (int bj = 0; bj < 2; ++bj)
#pragma unroll
                    for (int n = 0; n < 2; ++n)
#pragma unroll
                        for (int e = 0; e < 4; ++e) mx = fmaxf(mx, acc[ai][bj][m][n][e]);
                mx = fmaxf(mx, shx(mx, 16)); mx = fmaxf(mx, shx(mx, 32));
                if (fq == 0) t0[wc * 128 + 64 * ai + 16 * m + fr] = mx; }
        asm volatile("s_waitcnt lgkmcnt(0)" ::: "memory"); __builtin_amdgcn_s_barrier(); asm volatile("" ::: "memory");
#pragma unroll
        for (int ai = 0; ai < 2; ++ai)
#pragma unroll
            for (int m = 0; m < 4; ++m) { const int hr = 64 * ai + 16 * m + fr;
                const float mx = fmaxf(fmaxf(t0[hr], t0[128 + hr]), fmaxf(t0[256 + hr], t0[384 + hr])); float s = 0.f;
#pragma unroll
                for (int bj = 0; bj < 2; ++bj)
#pragma unroll
                    for (int n = 0; n < 2; ++n)
#pragma unroll
                        for (int e = 0; e < 4; ++e) { const float p = __builtin_amdgcn_exp2f((acc[ai][bj][m][n][e] - mx) * c2); acc[ai][bj][m][n][e] = p; s += p; }
                s += shx(s, 16); s += shx(s, 32);
                if (fq == 0) t1[wc * 128 + hr] = s; }
        asm volatile("s_waitcnt lgkmcnt(0)" ::: "memory"); __builtin_amdgcn_s_barrier(); asm volatile("" ::: "memory");
        EPI_PLAINLOOP_BEGIN
            const int hr = 64 * ai + 16 * m + fr;
            const float inv = __builtin_amdgcn_rcpf((t1[hr] + t1[128 + hr]) + (t1[256 + hr] + t1[384 + hr]));
            bf16_t* o = P + (size_t)(((unsigned)pm * 256u + (unsigned)rl) * 1024u + (unsigned)(pn * 256 + wc * 64 + 8 * fq));
#pragma unroll
            for (int bj = 0; bj < 2; ++bj) { const f32x4 a = acc[ai][bj][m][0] * inv, c = acc[ai][bj][m][1] * inv; const float v[8] = {a[0], a[1], a[2], a[3], c[0], c[1], c[2], c[3]};
                *(u32x4*)(o + 32 * bj) = pack8(v); }
        EPI_ROWLOOP_END
    }
};
struct EpiO8 {
    unsigned char* out;
    __device__ __forceinline__ void operator()(const f32x4 (&acc)[2][2][4][2], const Unit& u, int wr, int wc, int fr_, int fq_, int lane) const {
        EPI_OPAQUE
        float ko = O8_SCALE; asm volatile("" : "+s"(ko));
        EPI_PLAINLOOP_BEGIN
            unsigned char* o = out + (size_t)(((unsigned)pm * 256u + (unsigned)rl) * (unsigned)D + (unsigned)(pn * 256 + wc * 64 + 8 * fq));
#pragma unroll
            for (int bj = 0; bj < 2; ++bj) { const f32x4 a = acc[ai][bj][m][0] * ko, c = acc[ai][bj][m][1] * ko; const float v[8] = {a[0], a[1], a[2], a[3], c[0], c[1], c[2], c[3]};
                *(u32x2*)(o + 32 * bj) = pack8_fp8(v); }
        EPI_ROWLOOP_END
    }
};
struct EpiMemKV {
    bf16_t* mkp; bf16_t* mvtp; float* ok; float* ov;
    __device__ __forceinline__ void operator()(const f32x4 (&acc)[2][2][4][2], const Unit& u, int wr, int wc, int fr_, int fq_, int lane) const {
        EPI_OPAQUE
        const int layer = pm >> 6, r6 = pm & 63;
        EPI_PLAINLOOP_BEGIN
#pragma unroll
            for (int bj = 0; bj < 2; ++bj) { const f32x4 a = acc[ai][bj][m][0], c = acc[ai][bj][m][1]; const float v[8] = {a[0], a[1], a[2], a[3], c[0], c[1], c[2], c[3]};
                const int cl = 32 * bj + wc * 64 + 8 * fq;
                if (r6 < 32) { const unsigned eo = (unsigned)(layer * 1024 + r6 * 256 + rl) * (unsigned)D + (unsigned)(pn * 256 + cl);
                    *(u32x4*)(mkp + (size_t)eo) = pack8(v);
                    float* o = ok + (size_t)eo; *(f32x4*)o = a; *(f32x4*)(o + 4) = c; }
                else { const int vcol = (r6 - 32) * 256 + rl, bb = pn;
                    *(u32x4*)(mvtp + (size_t)((unsigned)((layer * NB + bb) * D + vcol) * 256u + (unsigned)cl)) = pack8(v);
                    float* o = ov + (size_t)((unsigned)((layer * NB + bb) * 256 + cl) * (unsigned)D + (unsigned)vcol);
#pragma unroll
                    for (int e = 0; e < 8; ++e) o[(size_t)e * D] = v[e]; }
            }
        EPI_ROWLOOP_END
    }
};

struct OrdMemKV2 {
    int G, c; const char* memb; const char* wt;
    __device__ __forceinline__ bool next(int i, Unit& u) const { const int L = i * G + c; if (L >= 256) return false; const int layer = L >> 6, r = L & 63, tp = r & 3, pn = r >> 2;
        u.pm = layer * 4 + tp; u.pn = pn; u.A = memb + (size_t)tp * (256 * D * 2); u.B = wt + (size_t)layer * (4096 * (size_t)D * 2) + (size_t)pn * (256 * D * 2); return true; }
};
struct EpiMemKV2 {
    unsigned char* k8; unsigned char* v8; float* ok; float* ov;
    __device__ __forceinline__ void operator()(const f32x4 (&acc)[2][2][4][2], const Unit& u, int wr, int wc, int fr_, int fq_, int lane) const {
        EPI_OPAQUE
        const int isv = pn >> 3; const float sc8 = 1.f + (MV8_SCALE - 1.f) * (float)isv;
        float* of = ok + (size_t)isv * (size_t)(ov - ok); unsigned char* o8 = k8 + (size_t)isv * (size_t)(v8 - k8);
        EPI_PLAINLOOP_BEGIN
            const unsigned eo = ((unsigned)pm * 256u + (unsigned)rl) * (unsigned)D + (unsigned)((pn & 7) * 256 + wc * 64 + 8 * fq);
#pragma unroll
            for (int bj = 0; bj < 2; ++bj) { const f32x4 a = acc[ai][bj][m][0], c = acc[ai][bj][m][1];
                float* o = of + (size_t)(eo + 32u * bj); *(f32x4*)o = a; *(f32x4*)(o + 4) = c;
                const float v[8] = {a[0] * sc8, a[1] * sc8, a[2] * sc8, a[3] * sc8, c[0] * sc8, c[1] * sc8, c[2] * sc8, c[3] * sc8};
                *(u32x2*)(o8 + (size_t)(eo + 32u * bj)) = pack8_fp8(v); }
        EPI_ROWLOOP_END
    }
};
struct OrdW12 {
    int G, c; const char* k8; const char* wqr; const char* wmo_; const char* v8;
    __device__ __forceinline__ bool next(int i, Unit& u) const { if (i >= 4) return false; const int v = (c & 7) * 128 + (c >> 3) + (G >> 3) * i; if (v >= 1024) return false;
        const int idx = v & 511, l = idx >> 7, b = (idx >> 5) & 3, h = (idx >> 3) & 3, t = idx & 7; u.pm = v; u.pn = t;
        if (v < 512) { u.A = k8 + ((size_t)(l * 1024 + b * 256) * D) + h * 512; u.B = wqr + ((size_t)(l * 2048 + t * 256) * D) + h * 512; }
        else { u.A = wmo_ + ((size_t)(l * 2048 + t * 256) * D) + h * 512; u.B = v8 + ((size_t)(l * 1024 + b * 256) * D) + h * 512; }
        return true; }
};
struct EpiW12 {
    unsigned char* w1_; unsigned char* w2_; float* u1; float* c1; const float* lg; const float* lb;
    __device__ __forceinline__ void operator()(const f32x4 (&acc)[2][2][4][2], const Unit& u, int wr, int wc, int fr_, int fq_, int lane) const {
        EPI_OPAQUE
        const int idx = pm & 511, l = idx >> 7, b = (idx >> 5) & 3, h = (idx >> 3) & 3, t = pn;
        if (pm < 512) {
            float k1 = W1_SCALE / WQR_SCALE, ki = 1.f / W1_SCALE; asm volatile("" : "+s"(k1), "+s"(ki));
            const int colb = t * 256 + wc * 64 + 8 * fq;
            f32x4 bg[2][2];
#pragma unroll
            for (int bj = 0; bj < 2; ++bj)
#pragma unroll
                for (int n = 0; n < 2; ++n) { const f32x4 gg = *(const f32x4*)(lg + (size_t)(l * 3) * D + colb + 32 * bj + 4 * n), bb = *(const f32x4*)(lb + (size_t)(l * 3) * D + colb + 32 * bj + 4 * n);
#pragma unroll
                    for (int e = 0; e < 4; ++e) bg[bj][n][e] = bb[e] * __builtin_amdgcn_rcpf(gg[e]) * ki; }
            EPI_PLAINLOOP_BEGIN
                const unsigned nrow = (unsigned)((l * NB + b) * 1024 + h * 256) + (unsigned)rl; float su = 0.f, sc = 0.f;
#pragma unroll
                for (int bj = 0; bj < 2; ++bj) { const f32x4 a = acc[ai][bj][m][0] * k1, c = acc[ai][bj][m][1] * k1; const float v[8] = {a[0], a[1], a[2], a[3], c[0], c[1], c[2], c[3]};
                    const u32x2 w = pack8_fp8(v); *(u32x2*)(w1_ + (size_t)(nrow * (unsigned)D + (unsigned)(colb + 32 * bj))) = w;
                    su += sum4_fp8(w.x) + sum4_fp8(w.y);
#pragma unroll
                    for (int e = 0; e < 4; ++e) sc += a[e] * bg[bj][0][e] + c[e] * bg[bj][1][e]; }
                su += shx(su, 16); su += shx(su, 32); sc += shx(sc, 16); sc += shx(sc, 32);
                if (fq == 0) { atomicAdd(u1 + nrow, su * ki); atomicAdd(c1 + nrow, sc); }
            EPI_ROWLOOP_END
        } else {
            float k2 = W2_SCALE / (W8_SCALE * MV8_SCALE); asm volatile("" : "+s"(k2));
            EPI_PLAINLOOP_BEGIN
                unsigned char* o = w2_ + (size_t)(((unsigned)((l * NB + b) * D + t * 256) + (unsigned)rl) * 1024u + (unsigned)(h * 256 + wc * 64 + 8 * fq));
#pragma unroll
                for (int bj = 0; bj < 2; ++bj) { const f32x4 a = acc[ai][bj][m][0] * k2, c = acc[ai][bj][m][1] * k2; const float v[8] = {a[0], a[1], a[2], a[3], c[0], c[1], c[2], c[3]};
                    *(u32x2*)(o + 32 * bj) = pack8_fp8(v); }
            EPI_ROWLOOP_END
        }
    }
};
struct OrdS8 {
    int G, c; const char* A; const char* B;
    __device__ __forceinline__ bool next(int i, Unit& u) const { const int L = i * G + c; if (L >= 256) return false; tile_of(L, 64, 4, u.pm, u.pn);
        u.A = A + (size_t)u.pm * (256 * D); u.B = B + ((size_t)((u.pm >> 4) * 1024 + u.pn * 256) * D); return true; }
};
struct OrdG2 {
    int G, c; const char* A; const char* B;
    __device__ __forceinline__ bool next(int i, Unit& u) const { const int L = i * G + c; if (L >= 512) return false; tile_of(L, 64, 8, u.pm, u.pn);
        u.A = A + (size_t)u.pm * (256 * 1024); u.B = B + ((size_t)((u.pm >> 4) * D + u.pn * 256) * 1024); return true; }
};
struct EpiSoftP8 {
    const float* st; const float* uvec; const float* cvec; unsigned char* P; LAS float* tab;
    __device__ __forceinline__ void operator()(f32x4 (&acc)[2][2][4][2], const Unit& u, int wr, int wc, int fr_, int fq_, int lane) const {
        EPI_OPAQUE
        float c2 = 0.04419417382415922f * LOG2E, ki = 1.f / W1_SCALE, kp = P8_SCALE; asm volatile("" : "+s"(c2), "+s"(ki), "+s"(kp));
        f32x4 sv_[2][4]; wave_stats_load(st, pm * 256 + wr * 64, ln_, false, sv_);
        const int colb = pn * 256 + wc * 64 + 8 * fq;
        const float* ub = uvec + (size_t)(pm >> 4) * 1024; const float* cb = cvec + (size_t)(pm >> 4) * 1024;
        f32x4 uu[2][2], cc[2][2];
#pragma unroll
        for (int bj = 0; bj < 2; ++bj)
#pragma unroll
            for (int n = 0; n < 2; ++n) { uu[bj][n] = *(const f32x4*)(ub + colb + 32 * bj + 4 * n); cc[bj][n] = *(const f32x4*)(cb + colb + 32 * bj + 4 * n); }
        float mu[2][4], rs[2][4]; wave_stats_fin(sv_, ln_, false, mu, rs);
        LAS float* t0 = tab + (wr * 4) * 128; LAS float* t1 = tab + 1024 + (wr * 4) * 128;
#pragma unroll
        for (int ai = 0; ai < 2; ++ai)
#pragma unroll
            for (int m = 0; m < 4; ++m) { const float mr = shl(mu[ai][m], 4 * fr), rr = shl(rs[ai][m], 4 * fr); const float rw = rr * ki * c2, nrm = -rr * mr * c2;
                float mx = -3.0e38f;
#pragma unroll
                for (int bj = 0; bj < 2; ++bj)
#pragma unroll
                    for (int n = 0; n < 2; ++n)
#pragma unroll
                        for (int e = 0; e < 4; ++e) { const float s = __builtin_fmaf(rw, acc[ai][bj][m][n][e], __builtin_fmaf(nrm, uu[bj][n][e], cc[bj][n][e] * c2)); acc[ai][bj][m][n][e] = s; mx = fmaxf(mx, s); }
                mx = fmaxf(mx, shx(mx, 16)); mx = fmaxf(mx, shx(mx, 32));
                if (fq == 0) t0[wc * 128 + 64 * ai + 16 * m + fr] = mx; }
        asm volatile("s_waitcnt lgkmcnt(0)" ::: "memory"); __builtin_amdgcn_s_barrier(); asm volatile("" ::: "memory");
#pragma unroll
        for (int ai = 0; ai < 2; ++ai)
#pragma unroll
            for (int m = 0; m < 4; ++m) { const int hr = 64 * ai + 16 * m + fr;
                const float mx = fmaxf(fmaxf(t0[hr], t0[128 + hr]), fmaxf(t0[256 + hr], t0[384 + hr])); float s = 0.f;
#pragma unroll
                for (int bj = 0; bj < 2; ++bj)
#pragma unroll
                    for (int n = 0; n < 2; ++n)
#pragma unroll
                        for (int e = 0; e < 4; ++e) { const float p = __builtin_amdgcn_exp2f(acc[ai][bj][m][n][e] - mx); acc[ai][bj][m][n][e] = p; s += p; }
                s += shx(s, 16); s += shx(s, 32);
                if (fq == 0) t1[wc * 128 + hr] = s; }
        asm volatile("s_waitcnt lgkmcnt(0)" ::: "memory"); __builtin_amdgcn_s_barrier(); asm volatile("" ::: "memory");
        EPI_PLAINLOOP_BEGIN
            const int hr = 64 * ai + 16 * m + fr;
            const float inv = kp * __builtin_amdgcn_rcpf((t1[hr] + t1[128 + hr]) + (t1[256 + hr] + t1[384 + hr]));
            unsigned char* o = P + (size_t)(((unsigned)pm * 256u + (unsigned)rl) * 1024u + (unsigned)(pn * 256 + wc * 64 + 8 * fq + 24 * (fq & 1)));
            u32x2 p8[2];
#pragma unroll
            for (int bj = 0; bj < 2; ++bj) { const f32x4 a = acc[ai][bj][m][0] * inv, c = acc[ai][bj][m][1] * inv; const float v[8] = {a[0], a[1], a[2], a[3], c[0], c[1], c[2], c[3]};
                p8[bj] = pack8_fp8(v); }
            *(u32x4*)o = widen8(p8[0], p8[1]);
        EPI_ROWLOOP_END
    }
};
}

__device__ __forceinline__ void tr_item(const float* W, int K, int N, int ldw, bf16_t* WT, LAS float* scr, int item, int lane, const float* g, const float* b, float* uv, float* cv, bool ileave, bool f8 = false, unsigned char* WT8 = nullptr, float* uv8 = nullptr, unsigned char* WR8 = nullptr) {
    const int nblk = N / 64, kb = item / nblk, nb = item % nblk, k0 = 64 * kb, n0 = 64 * nb;
#pragma unroll 16
    for (int kk = 0; kk < 64; ++kk) scr[kk * 65 + lane] = __builtin_nontemporal_load(W + (size_t)(k0 + kk) * ldw + n0 + lane);
    LDS_WAIT(); asm volatile("" ::: "memory");
    if (WR8) {
        const float sc = WQR_SCALE * g[k0 + lane]; const LAS float* s = scr + lane * 65; GAS u32x4* o8 = (GAS u32x4*)(WR8 + (size_t)(k0 + lane) * N + n0);
#pragma unroll
        for (int q = 0; q < 4; ++q) { u32x4 w;
#pragma unroll
            for (int e = 0; e < 4; ++e) w[e] = pk4_fp8(s[16 * q + 4 * e] * sc, s[16 * q + 4 * e + 1] * sc, s[16 * q + 4 * e + 2] * sc, s[16 * q + 4 * e + 3] * sc);
            o8[q] = w; } }
    const int c = lane & 7;
    float gk[8], bk[8];
    if (g) {
#pragma unroll
        for (int i = 0; i < 8; ++i) { gk[i] = g[k0 + 8 * c + i]; bk[i] = b[k0 + 8 * c + i]; } }
#pragma unroll
    for (int j = 0; j < 8; ++j) { const int nl = (lane >> 3) + 8 * j; const LAS float* s = scr + (8 * c) * 65 + nl;
        float w[8];
#pragma unroll
        for (int i = 0; i < 8; ++i) w[i] = s[i * 65];
        int n = n0 + nl, dr = n;
        if (ileave) { const int hc = (n < DFF) ? n : n - DFF, j = hc & 127; dr = 256 * (hc >> 7) + 64 * (j >> 5) + (j & 31) + ((n < DFF) ? 0 : 32); }
        float su = 0.f, sc = 0.f;
        if (g) {
#pragma unroll
            for (int i = 0; i < 8; ++i) { sc += bk[i] * w[i]; w[i] *= gk[i]; } }
        if (f8) { u32x2 o8; o8.x = pk4_fp8(w[0] * W8_SCALE, w[1] * W8_SCALE, w[2] * W8_SCALE, w[3] * W8_SCALE); o8.y = pk4_fp8(w[4] * W8_SCALE, w[5] * W8_SCALE, w[6] * W8_SCALE, w[7] * W8_SCALE);
            *(GAS u32x2*)((unsigned char*)WT + (size_t)dr * K + k0 + 8 * c) = o8;
            if (g) su = (sum4_fp8(o8.x) + sum4_fp8(o8.y)) * W8_INV; }
        else { u32x4 o; o.x = pk2(w[0], w[1]); o.y = pk2(w[2], w[3]); o.z = pk2(w[4], w[5]); o.w = pk2(w[6], w[7]);
        *(GAS u32x4*)(WT + (size_t)dr * K + k0 + 8 * c) = o;
        if (g) su = (bf2f(o.x & 0xffffu) + bf2f(o.x >> 16)) + (bf2f(o.y & 0xffffu) + bf2f(o.y >> 16)) + (bf2f(o.z & 0xffffu) + bf2f(o.z >> 16)) + (bf2f(o.w & 0xffffu) + bf2f(o.w >> 16)); }
        if (WT8) { u32x2 o8; o8.x = pk4_fp8(w[0] * W8_SCALE, w[1] * W8_SCALE, w[2] * W8_SCALE, w[3] * W8_SCALE); o8.y = pk4_fp8(w[4] * W8_SCALE, w[5] * W8_SCALE, w[6] * W8_SCALE, w[7] * W8_SCALE);
            *(GAS u32x2*)(WT8 + (size_t)dr * K + k0 + 8 * c) = o8;
            if (g) { float s8 = (sum4_fp8(o8.x) + sum4_fp8(o8.y)) * W8_INV; s8 += shx(s8, 1); s8 += shx(s8, 2); s8 += shx(s8, 4); if (c == 0 && uv8) atomicAdd(uv8 + dr, s8); } }
        if (g) {
            su += shx(su, 1); su += shx(su, 2); su += shx(su, 4);
            sc += shx(sc, 1); sc += shx(sc, 2); sc += shx(sc, 4);
            if (c == 0 && uv) { atomicAdd(uv + dr, su); atomicAdd(cv + dr, sc); }
        }
    }
    LDS_WAIT(); asm volatile("" ::: "memory");
}
__device__ __forceinline__ void cvt_row8(const float* src, unsigned char* dst8, int lane) {
    const GAS f32x4* s = (const GAS f32x4*)src + lane; GAS unsigned* o8 = (GAS unsigned*)dst8 + lane;
    f32x4 v[8];
#pragma unroll
    for (int j = 0; j < 8; ++j) v[j] = __builtin_nontemporal_load(s + 64 * j);
#pragma unroll
    for (int j = 0; j < 8; ++j) o8[64 * j] = pk4_fp8(v[j][0], v[j][1], v[j][2], v[j][3]);
}
__device__ __forceinline__ void cvt_row(const float* src, bf16_t* dst, int lane, unsigned char* dst8 = nullptr) {
    const GAS f32x4* s = (const GAS f32x4*)src + lane; GAS u32x2* o = (GAS u32x2*)dst + lane;
    f32x4 v[8];
#pragma unroll
    for (int j = 0; j < 8; ++j) v[j] = __builtin_nontemporal_load(s + 64 * j);
#pragma unroll
    for (int j = 0; j < 8; ++j) { u32x2 w; w.x = pk2(v[j][0], v[j][1]); w.y = pk2(v[j][2], v[j][3]); o[64 * j] = w; }
    if (dst8) { GAS unsigned* o8 = (GAS unsigned*)dst8 + lane;
#pragma unroll
        for (int j = 0; j < 8; ++j) o8[64 * j] = pk4_fp8(v[j][0], v[j][1], v[j][2], v[j][3]); }
}

namespace att {
constexpr int SHM_V = 64 * 128 * 2, SHM_K = 64 * 128 * 2;
constexpr int OFF_V = 0, OFF_K = 2 * SHM_V, OFF_WS = OFF_K + 2 * SHM_K, OFF_TBL = OFF_WS + NWAVES * 64 * 4, ATT_LDS = OFF_TBL + 1280;
static_assert(ATT_LDS <= RING_BYTES, "attention LDS");
#define KSWZ(row, colB) ((row) * 256 + ((colB) ^ (((row) & 15) << 4)))
__device__ __forceinline__ int v_st(int k, int c) { const int kk = (k & ~0xC) | ((k & 4) << 1) | ((k & 8) >> 1); return ((kk >> 3) * 4 + (c >> 5)) * 512 + ((kk & 7) * 32 + (c & 31)) * 2; }
__device__ __forceinline__ int v_rd_base(int lane) { return ((lane & 3) << 3) | (((lane >> 2) & 3) << 6) | (((lane >> 4) & 1) << 5) | (((lane >> 5) & 1) << 8); }
constexpr int v_rd_off(int d0, int ks, int half) { return d0 * 512 + ks * 4096 + half * 2048; }
__device__ __forceinline__ int crow(int r, int hi) { return (r & 3) + 8 * (r >> 2) + 4 * hi; }

template <int KB>
__device__ __forceinline__ void qkt(f32x16& p0, f32x16& p1, LAS const char* K_lds, int r32, int hi, const bf16x8* qr) {
    p0 = f32x16{}; p1 = f32x16{};
#pragma unroll
    for (int d0 = 0; d0 < 8; ++d0) { LAS const char* a = K_lds + KB * SHM_K + KSWZ(r32, (d0 * 16 + hi * 8) * 2);
        const bf16x8 b0 = *(LAS const bf16x8*)a;
        const bf16x8 b1 = *(LAS const bf16x8*)(a + 32 * 256);
        p0 = __builtin_amdgcn_mfma_f32_32x32x16_bf16(b0, qr[d0], p0, 0, 0, 0);
        p1 = __builtin_amdgcn_mfma_f32_32x32x16_bf16(b1, qr[d0], p1, 0, 0, 0); }
}
template <int VB>
__device__ __forceinline__ void pv_tile(f32x16* o, int vb0, bf16x8 pa0, bf16x8 pa1, bf16x8 pa2, bf16x8 pa3) {
#define TRRD(dst, off) asm volatile("ds_read_b64_tr_b16 %0, %1 offset:%2" : "=&v"(dst) : "v"(vb0), "i"(off) : "memory")
#define PV_D0(d0) do { s16x4 l0, l1, l2, l3, h0, h1, h2, h3; constexpr int b_ = OFF_V + VB * SHM_V + v_rd_off(d0, 0, 0); \
        TRRD(l0, b_); TRRD(h0, b_ + 2048); TRRD(l1, b_ + 4096); TRRD(h1, b_ + 6144); TRRD(l2, b_ + 8192); TRRD(h2, b_ + 10240); TRRD(l3, b_ + 12288); TRRD(h3, b_ + 14336); \
        asm volatile("s_waitcnt lgkmcnt(0)" ::: "memory"); __builtin_amdgcn_sched_barrier(0); \
        o[d0] = __builtin_amdgcn_mfma_f32_32x32x16_bf16((bf16x8){l0[0], l0[1], l0[2], l0[3], h0[0], h0[1], h0[2], h0[3]}, pa0, o[d0], 0, 0, 0);   \
        o[d0] = __builtin_amdgcn_mfma_f32_32x32x16_bf16((bf16x8){l1[0], l1[1], l1[2], l1[3], h1[0], h1[1], h1[2], h1[3]}, pa1, o[d0], 0, 0, 0);   \
        o[d0] = __builtin_amdgcn_mfma_f32_32x32x16_bf16((bf16x8){l2[0], l2[1], l2[2], l2[3], h2[0], h2[1], h2[2], h2[3]}, pa2, o[d0], 0, 0, 0);   \
        o[d0] = __builtin_amdgcn_mfma_f32_32x32x16_bf16((bf16x8){l3[0], l3[1], l3[2], l3[3], h3[0], h3[1], h3[2], h3[3]}, pa3, o[d0], 0, 0, 0); } while (0)
    PV_D0(0); PV_D0(1); PV_D0(2); PV_D0(3);
#undef PV_D0
#undef TRRD
}

__device__ __forceinline__ void attn_unit(LAS char* lds, const bf16_t* Qp, int qstride, const bf16_t* Kp, const bf16_t* Vp, int kvstride, unsigned char* Op,
                                          int T_lo, int T_hi, int cbase, int nact, bool smp, const float* relb, const int wv) {
    int tid = wv * 64 + lane_id(); asm volatile("" : "+v"(tid));
    const int wid = __builtin_amdgcn_readfirstlane(tid >> 6), lane = tid & 63, r32 = lane & 31, hi = lane >> 5;
    const bool wact = wid < nact;
    const int cw = cbase + (wid >> 1);
    LAS char* V_lds = lds + OFF_V; LAS char* K_lds = lds + OFF_K;
    LAS float* wsc = (LAS float*)(lds + OFF_WS) + wid * 64; LAS float* li_l = wsc; LAS float* al_l = wsc + 32;
    LAS float* tbl = (LAS float*)(lds + OFF_TBL);
    const int sr = tid >> 4, sc = (tid & 15) * 8, vst0 = v_st(sr, sc), vst1 = v_st(32 + sr, sc), kws = KSWZ(sr, sc * 2);
    const int vb0 = (int)(uintptr_t)lds + v_rd_base(lane);
    bf16x8 qr[8];
    if (wact) {
#pragma unroll
        for (int d0 = 0; d0 < 8; ++d0) qr[d0] = *(const bf16x8*)(Qp + (size_t)(wid * 32 + r32) * qstride + d0 * 16 + hi * 8);
    } else {
#pragma unroll
        for (int d0 = 0; d0 < 8; ++d0) qr[d0] = bf16x8{};
    }
    float m_reg = -1e30f, l_reg = 0.f; f32x16 o[4] = {};
    bf16x8 st_k0[2], st_k1[2], st_v0[2], st_v1[2];
#define ATT_LOAD(T, S) do { const size_t k0_ = (size_t)(T) * 64; \
        st_k0[S] = *(const bf16x8*)(Kp + (k0_ + sr) * kvstride + sc); st_k1[S] = *(const bf16x8*)(Kp + (k0_ + 32 + sr) * kvstride + sc); \
        st_v0[S] = *(const bf16x8*)(Vp + (k0_ + sr) * kvstride + sc); st_v1[S] = *(const bf16x8*)(Vp + (k0_ + 32 + sr) * kvstride + sc); } while (0)
#define ATT_WRITE(bf, S) do { *(LAS bf16x8*)(K_lds + (bf) * SHM_K + kws) = st_k0[S]; *(LAS bf16x8*)(K_lds + (bf) * SHM_K + kws + 32 * 256) = st_k1[S]; \
        *(LAS bf16x8*)(V_lds + (bf) * SHM_V + vst0) = st_v0[S]; *(LAS bf16x8*)(V_lds + (bf) * SHM_V + vst1) = st_v1[S]; } while (0)
    ATT_LOAD(T_lo, 0);
    if (T_lo + 1 < T_hi) ATT_LOAD(T_lo + 1, 1);
    __syncthreads();
    if (tid < 320) tbl[tid] = tid < NREL ? (relb[tid] - relb[NREL - 1]) * LOG2E : 0.f;
    ATT_WRITE(0, 0);
    __syncthreads();
    const int qi = 32 * (wid & 1) + r32;
#define ATT_STEP(T, BUF) do { \
        if ((T) + 2 < T_hi) ATT_LOAD((T) + 2, BUF); \
        if (wact && (T) >= cw - 8 && (T) <= cw) { \
            const int jt = (T) - (cw - 8); f32x16 p0, p1; \
            qkt<BUF>(p0, p1, K_lds, r32, hi, qr); \
            if (jt >= 6) { LAS const float* tp_ = tbl + (qi + 512 - 64 * jt - 4 * hi + 128 - 59);        \
                _Pragma("unroll") for (int r4 = 0; r4 < 4; ++r4) { \
                    _Pragma("unroll") for (int rr_ = 0; rr_ < 4; ++rr_) { const int r = 4 * r4 + rr_; const int c_ = (r & 3) + 8 * (r >> 2); \
                        p0[r] += tp_[59 - c_]; p1[r] += tp_[27 - c_]; } \
                    asm volatile("" ::: "memory"); } } \
            if (smp && (T) == 8) { _Pragma("unroll") for (int r = 0; r < 16; ++r) p1[r] = -__builtin_inff(); } \
            float pmax = p0[0]; \
            _Pragma("unroll") for (int r = 1; r < 16; ++r) pmax = fmaxf(pmax, p0[r]); \
            _Pragma("unroll") for (int r = 0; r < 16; ++r) pmax = fmaxf(pmax, p1[r]); \
            pmax = fmaxf(pmax, shx(pmax, 32)); \
            const float mn = (pmax - m_reg > 8.f) ? pmax : m_reg, alpha = __builtin_amdgcn_exp2f(m_reg - mn); m_reg = mn;     \
            float ps = 0.f; \
            _Pragma("unroll") for (int r = 0; r < 16; ++r) { p0[r] = __builtin_amdgcn_exp2f(p0[r] - mn); p1[r] = __builtin_amdgcn_exp2f(p1[r] - mn); ps += p0[r] + p1[r]; } \
            ps += shx(ps, 32); l_reg = l_reg * alpha + ps; \
            bf16x8 pa0, pa1, pa2, pa3; \
            ATT_PK4(p0, 0, pa0); ATT_PK4(p0, 8, pa1); ATT_PK4(p1, 0, pa2); ATT_PK4(p1, 8, pa3); \
            if (__any(alpha < 1.f)) { _Pragma("unroll") for (int d_ = 0; d_ < 4; ++d_) _Pragma("unroll") for (int r = 0; r < 16; ++r) o[d_][r] *= alpha; }     \
            pv_tile<BUF>(o, vb0, pa0, pa1, pa2, pa3); \
        } \
        if ((T) + 1 < T_hi) ATT_WRITE((BUF) ^ 1, (BUF) ^ 1); \
        __syncthreads(); } while (0)
#define ATT_PK4(P, B_, OUT) do { unsigned a0 = cvt_pk_bf16(P[B_+0], P[B_+1]), a1 = cvt_pk_bf16(P[B_+2], P[B_+3]);                          \
        unsigned b0 = cvt_pk_bf16(P[B_+4], P[B_+5]), b1 = cvt_pk_bf16(P[B_+6], P[B_+7]);                                             \
        auto r0 = __builtin_amdgcn_permlane32_swap(a0, b0, false, false); auto r1 = __builtin_amdgcn_permlane32_swap(a1, b1, false, false); \
        u32x4 w = {r0[0], r1[0], r0[1], r1[1]}; OUT = __builtin_bit_cast(bf16x8, w); } while (0)
    for (int T = T_lo; T < T_hi; T += 2) {
        ATT_STEP(T, 0);
        if (T + 1 < T_hi) ATT_STEP(T + 1, 1);
    }
#undef ATT_STEP
#undef ATT_PK4
#undef ATT_LOAD
#undef ATT_WRITE
    if (wact) {
        float ko = O8_SCALE; asm volatile("" : "+s"(ko));
        const float rli = ko * __builtin_amdgcn_rcpf(l_reg);
        int r32o = r32, hio = hi; asm volatile("" : "+v"(r32o), "+v"(hio));
        unsigned char* orow = Op + (size_t)((unsigned)(wid * 32 + r32o) * (unsigned)D + (unsigned)(16 * hio));
#pragma unroll
        for (int d0 = 0; d0 < 4; ++d0) {
            unsigned dw[4];
#pragma unroll
            for (int g = 0; g < 4; ++g) dw[g] = pk4_fp8(o[d0][4 * g] * rli, o[d0][4 * g + 1] * rli, o[d0][4 * g + 2] * rli, o[d0][4 * g + 3] * rli);
            const auto s02 = __builtin_amdgcn_permlane32_swap(dw[0], dw[2], false, false);
            const auto s13 = __builtin_amdgcn_permlane32_swap(dw[1], dw[3], false, false);
            const u32x4 w = {s02[0], s02[1], s13[0], s13[1]};
            *(u32x4*)(orow + d0 * 32) = w;
        }
    }
}
}

__device__ __forceinline__ void smem_attn_unit(LAS char* lds, const bf16_t* Q  , const bf16_t* Kc  ,
                                                const bf16_t* Vt  , unsigned char* O  , const int wv, const int half  ) {
    int tid = wv * 64 + lane_id(); asm volatile("" : "+v"(tid));
    const int wid = __builtin_amdgcn_readfirstlane(tid >> 6), lane = tid & 63, r32 = lane & 31, hi = lane >> 5;
    LAS float* smax = (LAS float*)lds;
    LAS float* ssum = smax + 256;
    LAS bf16_t* Pl = (LAS bf16_t*)(lds + 2048);
    constexpr int PLD = 264;
    LAS char* Ql = lds + 32768;
    f32x16 s = {};
    const bf16_t* kp = Kc + (size_t)(32 * wid + r32) * D + hi * 8;
    bf16x8 kf[32];
#pragma unroll
    for (int ks = 0; ks < 32; ++ks) kf[ks] = *(const bf16x8*)(kp + ks * 16);
    bf16x8 qst[4];
    { const int qr_ = tid >> 4, qc_ = tid & 15;
#pragma unroll
        for (int j = 0; j < 4; ++j) qst[j] = *(const bf16x8*)(Q + (size_t)qr_ * D + (qc_ + 16 * j) * 8);
        __syncthreads();
#pragma unroll
        for (int j = 0; j < 4; ++j) *(LAS bf16x8*)(Ql + qr_ * 1024 + (((qc_ + 16 * j) ^ (qr_ & 15)) << 4)) = qst[j];
    }
    __syncthreads();
#pragma unroll
    for (int ks = 0; ks < 32; ++ks) { const bf16x8 b = *(LAS const bf16x8*)(Ql + r32 * 1024 + (((2 * ks + hi) ^ (r32 & 15)) << 4));
        s = __builtin_amdgcn_mfma_f32_32x32x16_bf16(kf[ks], b, s, 0, 0, 0); }
    const bf16_t* v0 = Vt + (size_t)(256 * half + 32 * wid + r32) * 256 + hi * 8;
    bf16x8 vf0[16];
#pragma unroll
    for (int ks = 0; ks < 16; ++ks) vf0[ks] = *(const bf16x8*)(v0 + ks * 16);
    constexpr float C2 = 0.04419417382415922f * LOG2E;
    float pmax = s[0];
#pragma unroll
    for (int r = 1; r < 16; ++r) pmax = fmaxf(pmax, s[r]);
    pmax = fmaxf(pmax, shx(pmax, 32));
    if (hi == 0) smax[wid * 32 + r32] = pmax;
    __syncthreads();
    float gm = smax[r32];
#pragma unroll
    for (int w = 1; w < 8; ++w) gm = fmaxf(gm, smax[w * 32 + r32]);
    float ps = 0.f;
#pragma unroll
    for (int r = 0; r < 16; ++r) { s[r] = __builtin_amdgcn_exp2f((s[r] - gm) * C2); ps += s[r]; }
    ps += shx(ps, 32);
    if (hi == 0) ssum[wid * 32 + r32] = ps;
    __syncthreads();
    float tot = 0.f;
#pragma unroll
    for (int w = 0; w < 8; ++w) tot += ssum[w * 32 + r32];
    const float inv = 1.0f / tot;
#pragma unroll
    for (int r = 0; r < 16; ++r) Pl[r32 * PLD + 32 * wid + att::crow(r, hi)] = (bf16_t)f2bf(s[r] * inv);
    __syncthreads();
    f32x16 o0 = {};
#pragma unroll
    for (int ks = 0; ks < 16; ++ks) { const bf16x8 a = *(LAS const bf16x8*)(Pl + r32 * PLD + ks * 16 + hi * 8);
        o0 = __builtin_amdgcn_mfma_f32_32x32x16_bf16(vf0[ks], a, o0, 0, 0, 0); }
    {
        unsigned char* orow = O + (size_t)r32 * D + 256 * half + 32 * wid + 16 * hi;
#pragma unroll
        for (int blk = 0; blk < 1; ++blk) { const f32x16& oo = o0; unsigned dw[4];
#pragma unroll
            for (int g = 0; g < 4; ++g) dw[g] = pk4_fp8(oo[4 * g] * O8_SCALE, oo[4 * g + 1] * O8_SCALE, oo[4 * g + 2] * O8_SCALE, oo[4 * g + 3] * O8_SCALE);
            const auto s02 = __builtin_amdgcn_permlane32_swap(dw[0], dw[2], false, false);
            const auto s13 = __builtin_amdgcn_permlane32_swap(dw[1], dw[3], false, false);
            const u32x4 w = {s02[0], s02[1], s13[0], s13[1]};
            *(u32x4*)(orow + 32 * blk) = w; }
    }
}


namespace sk {
struct SUnit { int cb, rb; };
struct SPre { float mu, rs; f32x4 q0, q1, q2, q3; };
template <bool UNEVEN = false>
__device__ __forceinline__ bool next_unit(int i, int ncb, int G, int bx, SUnit& u) {
    const int x = bx & 7, rank = bx >> 3, per = G >> 3, e = rank + i * per;
    if (UNEVEN) { const int j = e >> 3, lim = (x & 1) ? 8 : 16; if (j >= lim) return false; u.cb = 24 * (x >> 1) + ((x & 1) ? 16 : 0) + j; u.rb = e & 7; return true; }
    const int cb = x + 8 * (e >> 3);
    if (cb >= ncb) return false; u.cb = cb; u.rb = e & 7; return true;
}
__device__ __forceinline__ void row_stats(const float* sst, int rl, bool idn, float& mu, float& rs) {
    if (idn) { mu = 0.f; rs = 1.f; return; }
    const f32x4* p = (const f32x4*)(sst + (size_t)rl * 64); float s = 0.f, q = 0.f;
#pragma unroll
    for (int t = 0; t < 16; ++t) { const f32x4 v = p[t]; s += v[0] + v[2]; q += v[1] + v[3]; }
    mu = s * (1.f / D); rs = __builtin_amdgcn_rsqf(q * (1.f / D) - mu * mu + LN_EPS);
}
template <int MODE, bool FP8 = false, bool UNEVEN = false, class Epi>
__device__ __forceinline__ void skinny_phase(LAS char* lds, const int wv, const bf16_t* A  , int lda, const bf16_t* Bt, int ldb, int K, int ncb, int G, int bx, const Epi& E) {
    int tid = wv * 64 + lane_id(); asm volatile("" : "+v"(tid));
    const int wid = __builtin_amdgcn_readfirstlane(tid >> 6), lane = tid & 63, r32 = lane & 31, hi = lane >> 5;
    const int ngrp = K >> 6, g0 = (wid * ngrp) >> 3, g1 = ((wid + 1) * ngrp) >> 3, klo = g0 * 64, ksl = (g1 - g0) * 64;
    LAS f32x4* part = (LAS f32x4*)lds;
    constexpr int PF = FP8 ? 2 : 1;
    bf16x8 pa[PF][4], pb0[PF][4], pb1[PF][4];
#define SK_PTRS(u_) const int j1_ = ((u_).cb & 3) * 32 + r32; const int brow0_ = (MODE == 1) ? (((u_).cb >> 2) * 256 + 64 * (j1_ >> 5) + (j1_ & 31)) : ((u_).cb * 64 + r32), brow1_ = brow0_ + 32; \
        const bf16_t* ap = A + (size_t)((u_).rb * 32 + r32) * lda + klo + 8 * hi + ((MODE == 2) ? 512 * ((u_).cb >> 3) : 0); \
        const bf16_t* b0p = Bt + (size_t)brow0_ * ldb + klo + 8 * hi; const bf16_t* b1p = Bt + (size_t)brow1_ * ldb + klo + 8 * hi;
#define SK_PREFETCH_A() _Pragma("unroll") for (int g = 0; g < PF; ++g) if (g * 64 < ksl) { _Pragma("unroll") for (int s = 0; s < 4; ++s) pa[g][s] = *(const bf16x8*)(ap + g * 64 + 16 * s); }
#define SK_PREFETCH_B() _Pragma("unroll") for (int g = 0; g < PF; ++g) if (g * 64 < ksl) { _Pragma("unroll") for (int s = 0; s < 4; ++s) { \
            pb0[g][s] = *(const bf16x8*)(b0p + g * 64 + 16 * s); pb1[g][s] = *(const bf16x8*)(b1p + g * 64 + 16 * s); } }
    constexpr bool AREG = FP8 && MODE == 1;
#define SK_CAT8(x0, x1) __builtin_shufflevector(__builtin_bit_cast(i32x4, x0), __builtin_bit_cast(i32x4, x1), 0, 1, 2, 3, 4, 5, 6, 7)
#define SK_MMA(a, b0, b1) do { if constexpr (FP8) { _Pragma("unroll") for (int s = 0; s < 4; s += 2) { \
            acc0 = __builtin_amdgcn_mfma_scale_f32_32x32x64_f8f6f4(SK_CAT8(b0[s], b0[s + 1]), SK_CAT8(a[s], a[s + 1]), acc0, 0, 0, 0, 0x7f7f7f7f, 0, 0x7f7f7f7f); \
            acc1 = __builtin_amdgcn_mfma_scale_f32_32x32x64_f8f6f4(SK_CAT8(b1[s], b1[s + 1]), SK_CAT8(a[s], a[s + 1]), acc1, 0, 0, 0, 0x7f7f7f7f, 0, 0x7f7f7f7f); } } \
        else { _Pragma("unroll") for (int s = 0; s < 4; ++s) { acc0 = __builtin_amdgcn_mfma_f32_32x32x16_bf16(b0[s], a[s], acc0, 0, 0, 0); acc1 = __builtin_amdgcn_mfma_f32_32x32x16_bf16(b1[s], a[s], acc1, 0, 0, 0); } } } while (0)
    SUnit u; bool have = next_unit<UNEVEN>(0, ncb, G, bx, u);
    LAS float* stab = (LAS float*)(lds + 65536);
    if (have) { SK_PTRS(u) SK_PREFETCH_A() SK_PREFETCH_B()
        if (tid < 32) { float mu_, rs_; row_stats(E.stat_src(), u.rb * 32 + tid, E.stat_idn(), mu_, rs_); stab[2 * tid] = mu_; stab[2 * tid + 1] = rs_; }
        __syncthreads(); }
    for (int i = 0; have; ++i) {
        SUnit un; const bool hn = next_unit<UNEVEN>(i + 1, ncb, G, bx, un);
        const int n = tid & 31, m4 = (tid >> 5) & 7, blk = tid >> 8;
        const SPre P = E.pre(u, n, m4, blk, stab);
        f32x16 acc0 = {}, acc1 = {};
#pragma unroll
        for (int g = 0; g < PF; ++g) if (g * 64 < ksl) SK_MMA(pa[g], pb0[g], pb1[g]);
        if (!AREG && ksl > PF * 64) { SK_PTRS(u)
#pragma unroll 1
            for (int k = PF * 64; k < ksl; k += PF * 64) {
#pragma unroll
                for (int g = 0; g < PF; ++g) if (g == 0 || k + g * 64 < ksl) {
#pragma unroll
                    for (int s = 0; s < 4; ++s) { pa[g][s] = *(const bf16x8*)(ap + k + g * 64 + 16 * s); pb0[g][s] = *(const bf16x8*)(b0p + k + g * 64 + 16 * s); pb1[g][s] = *(const bf16x8*)(b1p + k + g * 64 + 16 * s); } }
#pragma unroll
                for (int g = 0; g < PF; ++g) if (g == 0 || k + g * 64 < ksl) SK_MMA(pa[g], pb0[g], pb1[g]); } }
        if (hn) { SK_PTRS(un) if (!AREG) { SK_PREFETCH_A() } SK_PREFETCH_B() }
        __syncthreads();
#pragma unroll
        for (int r4 = 0; r4 < 4; ++r4) { const int m4w = 2 * r4 + hi;
            part[((wid * 2 + 0) * 8 + m4w) * 32 + r32] = (f32x4){acc0[4 * r4], acc0[4 * r4 + 1], acc0[4 * r4 + 2], acc0[4 * r4 + 3]};
            part[((wid * 2 + 1) * 8 + m4w) * 32 + r32] = (f32x4){acc1[4 * r4], acc1[4 * r4 + 1], acc1[4 * r4 + 2], acc1[4 * r4 + 3]}; }
        __syncthreads();
        f32x4 v0 = part[((0 * 2 + blk) * 8 + m4) * 32 + n], v1 = {0.f, 0.f, 0.f, 0.f};
#pragma unroll
        for (int w = 1; w < 8; ++w) v0 += part[((w * 2 + blk) * 8 + m4) * 32 + n];
        if (MODE == 1) { v1 = part[((0 * 2 + 1) * 8 + m4) * 32 + n];
#pragma unroll
            for (int w = 1; w < 8; ++w) v1 += part[((w * 2 + 1) * 8 + m4) * 32 + n]; }
        E(v0, v1, P, u, n, m4, blk, tid);
        u = un; have = hn;
    }
#undef SK_PTRS
#undef SK_PREFETCH_A
#undef SK_PREFETCH_B
#undef SK_CAT8
#undef SK_MMA
}
struct SEpiNone {
    __device__ __forceinline__ const float* stat_src() const { return nullptr; } __device__ __forceinline__ bool stat_idn() const { return true; }
    __device__ __forceinline__ SPre pre(const SUnit& u, int n, int m4, int blk, LAS const float* stab) const { SPre P = {}; return P; }
    __device__ __forceinline__ void operator()(f32x4 v, f32x4 v1, const SPre& P, const SUnit& u, int n, int m4, int blk, int tid) const { asm volatile("" :: "v"(v), "v"(v1)); }
};
struct SEpiQKV {
    const float* sst; bool idn; const float* uvec; const float* cvec; bf16_t* qkv; bf16_t* kvs; float* oks;
    __device__ __forceinline__ const float* stat_src() const { return sst; } __device__ __forceinline__ bool stat_idn() const { return idn; }
    __device__ __forceinline__ SPre pre(const SUnit& u, int n, int m4, int blk, LAS const float* stab) const { SPre P = {}; const int rl = u.rb * 32 + n, col = u.cb * 64 + 32 * blk + 4 * m4;
        if (!idn) { P.q0 = *(const f32x4*)(uvec + col); P.q1 = *(const f32x4*)(cvec + col); } P.mu = stab[2 * n]; P.rs = stab[2 * n + 1]; return P; }
    __device__ __forceinline__ void operator()(f32x4 v, f32x4, const SPre& P, const SUnit& u, int n, int m4, int blk, int tid) const {
        const int rl = u.rb * 32 + n, col = u.cb * 64 + 32 * blk + 4 * m4, which = col >> 11;
        if (!idn) v = (v - P.q0 * P.mu) * P.rs + P.q1;
        if (!which) v = v * QSCALE;
        u32x2 w; w.x = cvt_pk_bf16(v[0], v[1]); w.y = cvt_pk_bf16(v[2], v[3]);
        *(u32x2*)(qkv + (size_t)(MP + rl) * 6144 + col) = w;
        if (which) { const int colh = col - 2048 * which, b = rl >> 5, t = rl & 31;
            *(u32x2*)(kvs + ((size_t)((which - 1) * SBAT + b) * KVROWS + 512 + t) * D + colh) = w;
            *(f32x4*)(oks + (size_t)(which - 1) * (O_AVS - O_AKS) + (size_t)rl * D + colh) = v; }
    }
};
struct SEpiLin {
    const float* sst; const float* uvec; const float* cvec; bf16_t* out; float ascale;
    __device__ __forceinline__ const float* stat_src() const { return sst; } __device__ __forceinline__ bool stat_idn() const { return false; }
    __device__ __forceinline__ SPre pre(const SUnit& u, int n, int m4, int blk, LAS const float* stab) const { SPre P = {}; const int rl = u.rb * 32 + n, col = u.cb * 64 + 32 * blk + 4 * m4;
        P.q0 = *(const f32x4*)(uvec + col); P.q1 = *(const f32x4*)(cvec + col); P.mu = stab[2 * n]; P.rs = stab[2 * n + 1]; return P; }
    __device__ __forceinline__ void operator()(f32x4 v, f32x4, const SPre& P, const SUnit& u, int n, int m4, int blk, int tid) const {
        const int rl = u.rb * 32 + n, col = u.cb * 64 + 32 * blk + 4 * m4;
        v = (v * ascale - P.q0 * P.mu) * P.rs + P.q1;
        u32x2 w; w.x = cvt_pk_bf16(v[0], v[1]); w.y = cvt_pk_bf16(v[2], v[3]);
        *(u32x2*)(out + (size_t)(MP + rl) * D + col) = w;
    }
};
struct SEpiFfnIn {
    const float* sst; const float* uvec; const float* cvec; unsigned char* H;
    __device__ __forceinline__ const float* stat_src() const { return sst; } __device__ __forceinline__ bool stat_idn() const { return false; }
    __device__ __forceinline__ SPre pre(const SUnit& u, int n, int m4, int blk, LAS const float* stab) const { SPre P = {}; const int rl = u.rb * 32 + n, j0 = (u.cb & 3) * 32 + 4 * m4, rg = (u.cb >> 2) * 256 + 64 * (j0 >> 5) + (j0 & 31), ru = rg + 32;
        P.q0 = *(const f32x4*)(uvec + rg); P.q1 = *(const f32x4*)(cvec + rg); P.q2 = *(const f32x4*)(uvec + ru); P.q3 = *(const f32x4*)(cvec + ru); P.mu = stab[2 * n]; P.rs = stab[2 * n + 1]; return P; }
    __device__ __forceinline__ void operator()(f32x4 g, f32x4 up, const SPre& P, const SUnit& u, int n, int m4, int blk, int tid) const {
        if (blk) return;
        const int rl = u.rb * 32 + n;
        float kw = W8_INV, kh = H8_SCALE, lim = 448.f; asm volatile("" : "+s"(kw), "+s"(kh), "+v"(lim));
        const float nlim = -lim;
        g = (g * kw - P.q0 * P.mu) * P.rs + P.q1; up = ((up * kw - P.q2 * P.mu) * P.rs + P.q3) * kh;
        f32x4 h;
#pragma unroll
        for (int e = 0; e < 4; ++e) h[e] = __builtin_amdgcn_fmed3f(g[e] * up[e] * __builtin_amdgcn_rcpf(1.0f + __builtin_amdgcn_exp2f(-g[e] * LOG2E)), nlim, lim);
        *(unsigned*)(H + (size_t)(MP + rl) * DFF + u.cb * 32 + 4 * m4) = pk4_fp8(h[0], h[1], h[2], h[3]);
    }
};
template <bool POOL, bool Z8 = false> struct SEpiRes {
    const float* sst_old; float* sst_new; bool idn; const float* xs; half_t* zf; bf16_t* zb; const float* g; const float* b; const float* psc; LAS f32x2* red; float ascale; half_t* zfo;
    __device__ __forceinline__ const float* stat_src() const { return sst_old; } __device__ __forceinline__ bool stat_idn() const { return idn; }
    __device__ __forceinline__ SPre pre(const SUnit& u, int n, int m4, int blk, LAS const float* stab) const { SPre P = {}; const int rl = u.rb * 32 + n, row = MP + rl, col = u.cb * 64 + 32 * blk + 4 * m4;
        P.q0 = idn ? *(const f32x4*)(xs + (size_t)rl * D + col) : unpack4h(*(const u32x2*)(zf + (size_t)row * D + col));
        if (!idn) { P.q1 = *(const f32x4*)(g + col); P.q2 = *(const f32x4*)(b + col); }
        if (POOL) P.q3 = *(const f32x4*)(psc + col);
        P.mu = stab[2 * n]; P.rs = stab[2 * n + 1]; return P; }
    __device__ __forceinline__ void operator()(f32x4 a, f32x4, const SPre& P, const SUnit& u, int n, int m4, int blk, int tid) const {
        const int rl = u.rb * 32 + n, row = MP + rl, col = u.cb * 64 + 32 * blk + 4 * m4;
        a = a * ascale;
        if (POOL) a = a * P.q3;
        f32x4 v;
        if (idn) v = P.q0 * ALPHA + a; else v = ((P.q0 - P.mu) * P.rs * P.q1 + P.q2) * ALPHA + a;
        { u32x2 wh; wh.x = pk2h(v[0], v[1]); wh.y = pk2h(v[2], v[3]); *(u32x2*)(zfo + (size_t)row * D + col) = wh; }
        if (Z8) *(unsigned*)((unsigned char*)zb + (size_t)row * D + col) = pk4_fp8(v[0], v[1], v[2], v[3]);
        else { u32x2 w; w.x = cvt_pk_bf16(v[0], v[1]); w.y = cvt_pk_bf16(v[2], v[3]); *(u32x2*)(zb + (size_t)row * D + col) = w; }
        red[(m4 + 8 * blk) * 32 + n] = (f32x2){(v[0] + v[1]) + (v[2] + v[3]), (v[0] * v[0] + v[1] * v[1]) + (v[2] * v[2] + v[3] * v[3])};
        __syncthreads();
        if (tid < 32) { f32x2 t = red[tid];
#pragma unroll
            for (int j = 1; j < 16; ++j) t += red[j * 32 + tid];
            *(f32x2*)(sst_new + (size_t)(u.rb * 32 + tid) * 64 + u.cb * 2) = t; }
    }
};
}

struct Args { const float* in[20]; float* out; unsigned char* ws; };
enum { I_XP = 0, I_XS, I_CAK, I_CAV, I_SPOOL, I_CMK, I_CMV, I_MEMP, I_WQKV, I_WAO, I_RELB, I_WPOOL, I_PSC, I_WMQ, I_WMKV, I_WMO, I_WFI, I_WFO, I_LNG, I_LNB };

__global__ void __launch_bounds__(NTHR, 2) mk_fwd(Args args) {
    extern __shared__ __attribute__((aligned(16))) unsigned char lds_raw[];
    LAS unsigned char* lds = (LAS unsigned char*)lds_raw;
    const int G = gridDim.x, bx = blockIdx.x;
    const bool skf = ((blockIdx.x >> 3) & 1) != 0;
    const int wv = __builtin_amdgcn_readfirstlane((int)(threadIdx.x >> 6));
#define PHASE_IDS int tid = wv * 64 + lane_id(); asm volatile("" : "+v"(tid)); const int lane = tid & 63, wave = wv; (void)lane; (void)wave;
#define CAS __attribute__((address_space(4)))
#define PHASE_PTRS CAS const char* ka_ = (CAS const char*)__builtin_amdgcn_kernarg_segment_ptr(); asm volatile("" : "+s"(ka_)); \
    unsigned char* const ws = *(unsigned char* const CAS*)(ka_ + 168); float* const out = *(float* const CAS*)(ka_ + 160); (void)out; \
    float* const vec = (float*)(ws + WS_CTL); (void)vec;
#define IN(k) (((const float* const CAS*)ka_)[k])
#define wqkv ((bf16_t*)(ws + WS_WQKV))
#define wqkv8 (ws + WS_WQKV8)
#define wao (ws + WS_WAO)
#define wpool ((bf16_t*)(ws + WS_WPOOL))
#define wmq (ws + WS_WMQ)
#define wmkv ((bf16_t*)(ws + WS_WMKV))
#define wmo (ws + WS_WMO)
#define wfi (ws + WS_WFI)
#define wfo (ws + WS_WFO)
#define z8 (ws + WS_Z8)
#define zf ((half_t*)(ws + WS_ZF))
#define zb ((bf16_t*)(ws + WS_ZB))
#define qkv ((bf16_t*)(ws + WS_BIG))
#define qm ((bf16_t*)(ws + WS_QM))
#define Sb ((float*)(ws + WS_S))
#define Pb ((bf16_t*)(ws + WS_P))
#define Hb (ws + WS_H)
#define ob ((bf16_t*)(ws + WS_OB))
#define ob8 (ws + WS_OB)
#define kvs ((bf16_t*)(ws + WS_KVS))
#define mks ((bf16_t*)(ws + WS_MKS))
#define mvts ((bf16_t*)(ws + WS_MVTS))
#define memb ((bf16_t*)(ws + WS_MEMB))
#define mkp ((bf16_t*)(ws + WS_MKP))
#define mk8 (ws + WS_MK8)
#define mv8 (ws + WS_MV8)
#define wqr8 (ws + WS_WQR8)
#define w1 (ws + WS_W1)
#define w2 (ws + WS_W2)
#define Pb8 (ws + WS_P)
#define mvtp ((bf16_t*)(ws + WS_MVTP))
#define stA ((float*)(ws + WS_ST))
#define stB ((float*)(ws + WS_ST + ST_BYTES))
#define sstA ((float*)(ws + WS_SST))
#define sstB ((float*)(ws + WS_SST + SST_BYTES))
#define lng IN(I_LNG)
#define lnb IN(I_LNB)
    static_assert(sizeof(Args) == 176, "kernarg layout: in[20] at 0, out at 160, ws at 168");
    volatile LAS unsigned* misc = (volatile LAS unsigned*)(lds + MISC_OFF);
    if (threadIdx.x < 64) misc[threadIdx.x] = 0u;
    __syncthreads();
    const XcdBarrier bar = xcd_barrier_post((unsigned*)(args.ws + WS_CTL) + CW_BAR, misc + 8);
    LAS f32x2* const red = (LAS f32x2*)(lds + RED_OFF);
    LAS f32x2* const sred = (LAS f32x2*)(lds + RED_OFF);

    if (PH(0)) for (int rep_ = 0; rep_ < NREP(100); ++rep_) { PHASE_PTRS
        PHASE_IDS
        float* const vecw = rep_ ? nullptr : vec;
        LAS float* scr = (LAS float*)(lds + wave * 16640);
        const int gw = bx * NWAVES + wave, NGW = G * NWAVES;
        constexpr int I_QKV = (D / 64) * (6144 / 64), I_SQ = (D / 64) * (D / 64), I_POOLG = (512 / 64) * (512 / 64), I_MKV = (D / 64) * (4096 / 64),
                      I_FI = (D / 64) * (2 * DFF / 64), I_FO = (DFF / 64) * (D / 64), I_CMVT = (256 / 64) * (D / 64);
        constexpr int N0 = 2 * I_QKV, N1 = N0 + 2 * I_SQ, N2 = N1 + 8 * I_POOLG, N3 = N2 + 4 * I_SQ, N4 = N3 + 4 * I_MKV, N5 = N4 + 4 * I_SQ, N6 = N5 + 4 * I_FI,
                      N7 = N6 + 4 * I_FO, N8 = N7 + 32 * I_CMVT;
        for (int it = gw; it < N8; it += NGW) {
            if (it < N0) { const int l = it / I_QKV, r = it % I_QKV; const bool f = (l == 1);
                tr_item(IN(I_WQKV) + (size_t)l * D * 6144, D, 6144, 6144, wqkv + (size_t)l * 6144 * D, scr, r, lane, f ? lng + (1 * 3 + 2) * D : nullptr, f ? lnb + (1 * 3 + 2) * D : nullptr, vecw ? vecw + V_QKV_U : nullptr, vecw ? vecw + V_QKV_C : nullptr, false, false, wqkv8 + (size_t)l * 6144 * D, vecw ? vecw + V_QKV8_U : nullptr); }
            else if (it < N1) { const int l = (it - N0) / I_SQ, r = (it - N0) % I_SQ;
                tr_item(IN(I_WAO) + (size_t)l * D * D, D, D, D, (bf16_t*)(wao + (size_t)l * D * D), scr, r, lane, nullptr, nullptr, nullptr, nullptr, false, true); }
            else if (it < N2) { const int pg = (it - N1) / I_POOLG, r = (it - N1) % I_POOLG;
                tr_item(IN(I_WPOOL) + (size_t)pg * 512 * 512, 512, 512, 512, wpool + (size_t)pg * 512 * 512, scr, r, lane, nullptr, nullptr, nullptr, nullptr, false); }
            else if (it < N3) { const int l = (it - N2) / I_SQ, r = (it - N2) % I_SQ;
                tr_item(IN(I_WMQ) + (size_t)l * D * D, D, D, D, (bf16_t*)(wmq + (size_t)l * D * D), scr, r, lane, lng + (l * 3 + 0) * D, lnb + (l * 3 + 0) * D, vecw ? vecw + V_MQ_U + l * D : nullptr, vecw ? vecw + V_MQ_C + l * D : nullptr, false, true, nullptr, nullptr, wqr8 + (size_t)l * D * D); }
            else if (it < N4) { const int l = (it - N3) / I_MKV, r = (it - N3) % I_MKV;
                tr_item(IN(I_WMKV) + (size_t)l * D * 4096, D, 4096, 4096, wmkv + (size_t)l * 4096 * D, scr, r, lane, nullptr, nullptr, nullptr, nullptr, false); }
            else if (it < N5) { const int l = (it - N4) / I_SQ, r = (it - N4) % I_SQ;
                tr_item(IN(I_WMO) + (size_t)l * D * D, D, D, D, (bf16_t*)(wmo + (size_t)l * D * D), scr, r, lane, nullptr, nullptr, nullptr, nullptr, false, true); }
            else if (it < N6) { const int l = (it - N5) / I_FI, r = (it - N5) % I_FI;
                tr_item(IN(I_WFI) + (size_t)l * D * 2 * DFF, D, 2 * DFF, 2 * DFF, (bf16_t*)(wfi + (size_t)l * 2 * DFF * D), scr, r, lane, lng + (l * 3 + 1) * D, lnb + (l * 3 + 1) * D, vecw ? vecw + V_FI_U + l * 2 * DFF : nullptr, vecw ? vecw + V_FI_C + l * 2 * DFF : nullptr, true, true); }
            else if (it < N7) { const int l = (it - N6) / I_FO, r = (it - N6) % I_FO;
                tr_item(IN(I_WFO) + (size_t)l * DFF * D, DFF, D, D, (bf16_t*)(wfo + (size_t)l * D * DFF), scr, r, lane, nullptr, nullptr, nullptr, nullptr, false, true); }
            else { const int lb = (it - N7) / I_CMVT, r = (it - N7) % I_CMVT;
                tr_item(IN(I_CMV) + (size_t)lb * 256 * D, 256, D, D, mvts + (size_t)lb * D * 256, scr, r, lane, nullptr, nullptr, nullptr, nullptr, false); }
        }
        constexpr int R0 = MP, R1 = R0 + MS, R2 = R1 + NB * NMEM, R3 = R2 + 2 * SBAT * 512, R4 = R3 + 2 * SBAT * 512, R5 = R4 + 4 * SBAT * NMEM, R6 = R5 + 2 * 2 * SBAT * 32, R7 = R6;
        for (int rw = gw; rw < R7; rw += NGW) {
            if (rw < R0) { if (((rw >> 8) & 15) >= 14) cvt_row(IN(I_XP) + (size_t)rw * D, zb + (size_t)rw * D, lane, z8 + (size_t)rw * D); else cvt_row8(IN(I_XP) + (size_t)rw * D, z8 + (size_t)rw * D, lane); }
            else if (rw < R1) cvt_row(IN(I_XS) + (size_t)(rw - R0) * D, zb + (size_t)rw * D, lane);
            else if (rw < R2) cvt_row(IN(I_MEMP) + (size_t)(rw - R1) * D, memb + (size_t)(rw - R1) * D, lane);
            else if (rw < R3) { const int q = rw - R2, ab = q >> 9, t = q & 511, a = ab >> 3, b = ab & 7;
                cvt_row(IN(I_CAK) + (size_t)q * D, kvs + ((size_t)((a * 2 + 0) * SBAT + b) * KVROWS + t) * D, lane); }
            else if (rw < R4) { const int q = rw - R3, ab = q >> 9, t = q & 511, a = ab >> 3, b = ab & 7;
                cvt_row(IN(I_CAV) + (size_t)q * D, kvs + ((size_t)((a * 2 + 1) * SBAT + b) * KVROWS + t) * D, lane); }
            else if (rw < R5) { const int q = rw - R4; cvt_row(IN(I_CMK) + (size_t)q * D, mks + (size_t)q * D, lane); }
            else if (rw >= R6) { const int q = rw - R6, l = q >> 11, zd = q & 2047;
                const float sc = WQR_SCALE * lng[(size_t)(l * 3) * D + zd]; const GAS f32x4* s = (const GAS f32x4*)(IN(I_WMQ) + (size_t)q * D) + lane; GAS unsigned* o8 = (GAS unsigned*)(wqr8 + (size_t)q * D) + lane;
#pragma unroll
                for (int j = 0; j < 8; ++j) { const f32x4 v = s[64 * j] * sc; o8[64 * j] = pk4_fp8(v[0], v[1], v[2], v[3]); } }
            else { const int q = rw - R5, akb = q >> 5, t = q & 31;
                GAS u32x2* o = (GAS u32x2*)(kvs + ((size_t)akb * KVROWS + 544 + t) * D) + lane;
#pragma unroll
                for (int j = 0; j < 8; ++j) o[64 * j] = (u32x2){0u, 0u}; }
        }
    }
    xcd_barrier(bar, wv);

    if (PH(1)) for (int rep_ = 0; rep_ < NREP(101); ++rep_) { PHASE_PTRS
        pg8::OrdMemKV2 S{G, bx, (const char*)memb, (const char*)wmkv};
        pg8::EpiMemKV2 E{mk8, mv8, out + O_MKP, out + O_MVP};
        pg8::gemm_phase(lds, wv, D, D, D, S, E);
    }
    xcd_barrier(bar, wv);
    if (PH(1)) { PHASE_PTRS
        pg8::OrdW12 S{G, bx, (const char*)mk8, (const char*)wqr8, (const char*)wmo, (const char*)mv8};
        pg8::EpiW12 E{w1, w2, vec + V_S1_U, vec + V_S1_C, lng, lnb};
        pg8::gemm_phase<true>(lds, wv, 256, D / 2, D / 2, S, E);
    }
    xcd_barrier(bar, wv);

    for (int layer = 0; layer < DEPTH; ++layer) {
        if (PROBE_ID == 120) for (int xb_ = 0; xb_ < 10; ++xb_) xcd_barrier(bar, wv);
        const int a = layer >> 1;
        const int s0 = 3 * layer;
#define st_in (((s0 - 1) & 1) ? stB : stA)
#define st_0 ((s0 & 1) ? stB : stA)
#define st_1 (((s0 + 1) & 1) ? stB : stA)
#define st_2 (((s0 + 2) & 1) ? stB : stA)
#define sst_in (((s0 - 1) & 1) ? sstB : sstA)
#define sst_0 ((s0 & 1) ? sstB : sstA)
#define sst_1 (((s0 + 1) & 1) ? sstB : sstA)
#define sst_2 (((s0 + 2) & 1) ? sstB : sstA)
        const bool idn = (layer == 0);
#define g_in (lng + (size_t)((layer - 1) * 3 + 2) * D)
#define b_in (lnb + (size_t)((layer - 1) * 3 + 2) * D)
        if ((layer & 1) == 0) {
            if (PH(2)) for (int rep_ = 0; rep_ < NREP(102); ++rep_) { PHASE_PTRS
                pg8::OrdQKV8 S8{G, bx, (const char*)z8, (const char*)(wqkv8 + (size_t)a * 6144 * D)};
                pg8::EpiQKV8 E8{st_in, idn, vec + V_QKV8_U, vec + V_QKV_C, qkv};
                pg8::OrdQKVTail St{G, bx, (const char*)zb, (const char*)(wqkv + (size_t)a * 6144 * D)};
                pg8::EpiQKV Et{st_in, idn, vec + V_QKV_U, vec + V_QKV_C, qkv, kvs + (size_t)a * 2 * SBAT * KVROWS * D,
                               out + O_AKP + (size_t)a * NB * 512 * D, out + O_AKS + (size_t)a * MS * D};
                sk::SEpiQKV Es{sst_in, idn, vec + V_QKV_U, vec + V_QKV_C, qkv, kvs + (size_t)a * 2 * SBAT * KVROWS * D, out + O_AKS + (size_t)a * MS * D};
                _Pragma("unroll 1") for (int pass_ = 0; pass_ < 2; ++pass_) {
                    if ((pass_ == 0) != skf) { pg8::gemm_phase<true>(lds, wv, D / 2, D / 2, D / 2, S8, E8); pg8::gemm_phase(lds, wv, D, D, D, St, Et); }
                    else { for (int srep_ = 0; srep_ < ((PROBE_ID == 300) ? 2 : 1); ++srep_) sk::skinny_phase<0, false, true>((LAS char*)lds, wv, zb + (size_t)MP * D, D, wqkv + (size_t)a * 6144 * D, D, D, 6144 / 64, G, bx, Es); __syncthreads(); }
                }
            }
            xcd_barrier(bar, wv);
            if (PH(3)) for (int rep_ = 0; rep_ < NREP(103); ++rep_) { PHASE_PTRS
                const float* relb = IN(I_RELB) + (size_t)a * NHEAD * NREL;
                const bf16_t* kvsa = kvs + (size_t)a * 2 * SBAT * KVROWS * D;
                for (int it = 0; ; ++it) {
                    int U;
                    if (G != 256) { U = bx + it * G; if (U >= 1152) break; }
                    else if (it < 3) U = bx + 256 * it;
                    else if (it == 3) U = bx < 128 ? 768 + bx : 1024 + (bx - 128);
                    else if (it == 4 && bx >= 128) U = 896 + (bx - 128);
                    else break;
                    const bf16_t *Qp, *Kp, *Vp; unsigned char* Op; int kvst, T_lo, T_hi, cbase, nact, h; bool smp = false;
                    if (U < 1024) { int bh, qb; if (U < 896) { bh = U & 63; qb = 2 + (U >> 6); } else { bh = (U - 896) & 63; qb = 1 - ((U - 896) >> 6); }
                        const int b = bh >> 4; h = bh & 15;
                        const bf16_t* base = qkv + (size_t)b * SEQ * 6144 + h * HD;
                        Qp = base + (size_t)qb * 256 * 6144; Kp = base + 2048; Vp = base + 4096; kvst = 6144; Op = ob8 + ((size_t)b * SEQ + qb * 256) * D + h * HD;
                        T_lo = 4 * qb - 8 < 0 ? 0 : 4 * qb - 8; T_hi = 4 * qb + 4; cbase = 4 * qb; nact = 8; }
                    else { const int v = U - 1024, b = v >> 4; h = v & 15; smp = true;
                        Qp = qkv + (size_t)(MP + b * ST) * 6144 + h * HD; Kp = kvsa + (size_t)(0 * SBAT + b) * KVROWS * D + h * HD; Vp = kvsa + (size_t)(1 * SBAT + b) * KVROWS * D + h * HD;
                        kvst = D; Op = ob8 + (size_t)(MP + b * ST) * D + h * HD; T_lo = 0; T_hi = 9; cbase = 8; nact = 1; }
                    att::attn_unit((LAS char*)lds, Qp, 6144, Kp, Vp, kvst, Op, T_lo, T_hi, cbase, nact, smp, relb + h * NREL, wv);
                }
            }
            xcd_barrier(bar, wv);
            if (PH(4)) for (int rep_ = 0; rep_ < NREP(204); ++rep_) { PHASE_PTRS const bool dry_ = (NREP(204) == 2 && rep_ == 0); half_t* const zfo_ = dry_ ? (half_t*)(ws + WS_DUMMY) : zf; bf16_t* const zlo_ = dry_ ? (bf16_t*)(ws + WS_DUMMY + (size_t)M * D * 4) : (bf16_t*)z8; float* const stn_ = dry_ ? (float*)(ws + WS_DUMMY + (size_t)M * D * 4 + (size_t)MPAD * D * 2) : st_0; float* const sstn_ = dry_ ? (float*)(ws + WS_DUMMY + (size_t)M * D * 4 + (size_t)MPAD * D * 2 + ST_BYTES) : sst_0;
                pg8::OrdStd S{MP / 256, D / 256, G, bx, (const char*)ob8, (const char*)(wao + (size_t)a * D * D), (size_t)256 * D, (size_t)256 * D, 0, 0};
                pg8::EpiRes<false, true> E{st_in, stn_, idn, IN(I_XP), IN(I_XS), zf, zlo_, g_in, b_in, nullptr, red, W8_INV * O8_INV, zfo_, nullptr};
                sk::SEpiRes<false, true> Es{sst_in, sstn_, idn, IN(I_XS), zf, zlo_, g_in, b_in, nullptr, sred, W8_INV * O8_INV, zfo_};
                _Pragma("unroll 1") for (int pass_ = 0; pass_ < 2; ++pass_) {
                    if ((pass_ == 0) != skf) { pg8::gemm_phase<true>(lds, wv, D / 2, D / 2, D / 2, S, E); }
                    else { sk::skinny_phase<0, true>((LAS char*)lds, wv, (const bf16_t*)(ob8 + (size_t)MP * D), D / 2, (const bf16_t*)(wao + (size_t)a * D * D), D / 2, D / 2, D / 64, G, bx, Es); __syncthreads(); }
                }
            }
            xcd_barrier(bar, wv);
        } else {
            const int p = layer >> 1;
            if (PH(5)) for (int rep_ = 0; rep_ < NREP(105); ++rep_) { PHASE_PTRS
                PHASE_IDS
                LAS float* stl = (LAS float*)lds;
                const int col = 4 * tid;
                const f32x4 gq = *(const f32x4*)(g_in + col), bq = *(const f32x4*)(b_in + col);
                for (int U = bx; U < 1040; U += G) {
                    const bool smp = U >= 1024;
                    const int b = smp ? (U - 1024) >> 1 : U >> 8, t0 = smp ? ((U - 1024) & 1) * 16 : (U & 255) * 16;
                    const size_t row0 = smp ? (size_t)MP + b * ST + t0 : (size_t)b * SEQ + t0;
                    __syncthreads();
                    if (tid < 31) { const int t = t0 - 15 + tid;
                        if (t >= 0) { const f32x4* pp = smp ? (const f32x4*)(sst_in + (size_t)(b * ST + t) * 64) : (const f32x4*)(st_in + (row0 + (tid - 15)) * 16); float s = 0.f, q = 0.f;
                            const int np = smp ? 16 : 4;
                            for (int k = 0; k < np; ++k) { const f32x4 v = pp[k]; s += v[0] + v[2]; q += v[1] + v[3]; }
                            const float mm = s * (1.f / D), var = q * (1.f / D) - mm * mm; stl[2 * tid] = mm; stl[2 * tid + 1] = __builtin_amdgcn_rsqf(var + LN_EPS); } }
                    __syncthreads();
                    const float* spool = IN(I_SPOOL) + ((size_t)(p * SBAT + b) * 15) * D + col;
                    const half_t* zrow = zf + row0 * D + col;
                    bf16_t* urow = ob + row0 * D + col;
                    float* prow = smp ? out + O_PS + ((size_t)(p * SBAT + b) * 15) * D + col : out + O_PP + ((size_t)(p * NB + b) * 15) * D + col;
                    const bool wout = smp ? (t0 == 16) : (t0 == SEQ - 16);
#define POOL_BODY(W) do { f32x4 xv[15 + (W)]; \
                        _Pragma("unroll") for (int i = 0; i < 15 + (W); ++i) { const int tr = i - ((W) - 1), t = t0 + tr;            \
                            if (t >= 0) xv[i] = unpack4h(*(const u32x2*)(zrow + (ptrdiff_t)tr * D)); \
                            else if (smp) xv[i] = *(const f32x4*)(spool + (ptrdiff_t)(15 + t) * D); \
                            else xv[i] = (f32x4){0.f, 0.f, 0.f, 0.f}; } \
                        _Pragma("unroll") for (int i = 0; i < 15 + (W); ++i) { const int tr = i - ((W) - 1), t = t0 + tr; \
                            if (t >= 0) { const float mm = stl[2 * (tr + 15)], rr = stl[2 * (tr + 15) + 1]; xv[i] = (xv[i] - mm) * rr * gq + bq; } } \
                        f32x4 s = {0.f, 0.f, 0.f, 0.f}; \
                        _Pragma("unroll") for (int i = 0; i < (W) - 1; ++i) s += xv[i]; \
                        _Pragma("unroll") for (int t = 0; t < 16; ++t) { s += xv[t + (W) - 1]; \
                            const int cnt = smp ? (W) : ((t0 + t + 1 < (W)) ? t0 + t + 1 : (W)); \
                            const f32x4 uo = s * (1.0f / (float)cnt) - xv[t + (W) - 1]; \
                            u32x2 wv; wv.x = pk2(uo[0], uo[1]); wv.y = pk2(uo[2], uo[3]); \
                            *(u32x2*)(urow + (size_t)t * D) = wv; \
                            if (wout && t >= 1) *(f32x4*)(prow + (size_t)(t - 1) * D) = xv[t + (W) - 1]; \
                            s -= xv[t]; } } while (0)
                    const int wsel = tid >> 7;
                    if (wsel == 0) POOL_BODY(2); else if (wsel == 1) POOL_BODY(4); else if (wsel == 2) POOL_BODY(8); else POOL_BODY(16);
#undef POOL_BODY
                }
            }
            xcd_barrier(bar, wv);
            if (PH(6)) for (int rep_ = 0; rep_ < NREP(204); ++rep_) { PHASE_PTRS const bool dry_ = (NREP(204) == 2 && rep_ == 0); half_t* const zfo_ = dry_ ? (half_t*)(ws + WS_DUMMY) : zf; bf16_t* const zlo_ = dry_ ? (bf16_t*)(ws + WS_DUMMY + (size_t)M * D * 4) : (bf16_t*)z8; float* const stn_ = dry_ ? (float*)(ws + WS_DUMMY + (size_t)M * D * 4 + (size_t)MPAD * D * 2) : st_0; float* const sstn_ = dry_ ? (float*)(ws + WS_DUMMY + (size_t)M * D * 4 + (size_t)MPAD * D * 2 + ST_BYTES) : sst_0;
                pg8::OrdStd S{MP / 256, D / 256, G, bx, (const char*)ob, (const char*)(wpool + (size_t)p * D * 512), (size_t)256 * D * 2, (size_t)256 * 512 * 2, 1, 512 * 2};
                pg8::EpiRes<true, true> E{st_in, stn_, false, nullptr, nullptr, zf, zlo_, g_in, b_in, IN(I_PSC) + (size_t)p * D, red, 1.f, zfo_, nullptr};
                sk::SEpiRes<true, true> Es{sst_in, sstn_, false, nullptr, zf, zlo_, g_in, b_in, IN(I_PSC) + (size_t)p * D, sred, 1.f, zfo_};
                _Pragma("unroll 1") for (int pass_ = 0; pass_ < 2; ++pass_) {
                    if ((pass_ == 0) != skf) { pg8::gemm_phase(lds, wv, 512, D, 512, S, E); }
                    else { sk::skinny_phase<2>((LAS char*)lds, wv, ob + (size_t)MP * D, D, wpool + (size_t)p * D * 512, 512, 512, D / 64, G, bx, Es); __syncthreads(); }
                }
            }
            xcd_barrier(bar, wv);
        }
        if (PH(7)) for (int rep_ = 0; rep_ < NREP(107); ++rep_) { PHASE_PTRS
            pg8::OrdS8 S{G, bx, (const char*)z8, (const char*)(w1 + (size_t)layer * NB * 1024 * D)};
            pg8::EpiSoftP8 E{st_0, vec + V_S1_U + layer * NB * 1024, vec + V_S1_C + layer * NB * 1024, Pb8, (LAS float*)(lds + RED_OFF)};
            sk::SEpiLin Es{sst_0, vec + V_MQ_U + layer * D, vec + V_MQ_C + layer * D, qm, W8_INV};
            _Pragma("unroll 1") for (int pass_ = 0; pass_ < 2; ++pass_) {
                if ((pass_ == 0) != skf) { pg8::gemm_phase<true>(lds, wv, D / 2, D / 2, D / 2, S, E); }
                else { sk::skinny_phase<0, true>((LAS char*)lds, wv, (const bf16_t*)(z8 + (size_t)MP * D), D / 2, (const bf16_t*)(wmq + (size_t)layer * D * D), D / 2, D / 2, D / 64, G, bx, Es); __syncthreads(); }
            }
        }
        xcd_barrier(bar, wv);
        if (PH(11)) for (int rep_ = 0; rep_ < NREP(211); ++rep_) { PHASE_PTRS const bool dry_ = (NREP(211) == 2 && rep_ == 0); half_t* const zfo_ = dry_ ? (half_t*)(ws + WS_DUMMY) : zf; bf16_t* const zlo_ = dry_ ? (bf16_t*)(ws + WS_DUMMY + (size_t)M * D * 4) : (bf16_t*)z8; float* const stn_ = dry_ ? (float*)(ws + WS_DUMMY + (size_t)M * D * 4 + (size_t)MPAD * D * 2) : st_1;
            pg8::OrdG2 S{G, bx, (const char*)Pb8, (const char*)(w2 + (size_t)layer * NB * D * 1024)};
            pg8::EpiRes<false, true> E{st_0, stn_, false, nullptr, nullptr, zf, zlo_, lng + (size_t)(layer * 3 + 0) * D, lnb + (size_t)(layer * 3 + 0) * D, nullptr, red, 1.f / (P8_SCALE * W2_SCALE), zfo_, nullptr};
            pg8::gemm_phase<true>(lds, wv, 512, 512, 512, S, E);
            if (rep_ == NREP(211) - 1) for (int U = bx; U < 64; U += G) { const int b = U >> 3, h = (U >> 1) & 3;
                smem_attn_unit((LAS char*)lds, qm + (size_t)(MP + b * ST) * D + h * MHD, mks + ((size_t)(layer * SBAT + b) * NMEM) * D + h * MHD,
                               mvts + ((size_t)(layer * SBAT + b) * D + h * MHD) * 256, ob8 + (size_t)(MP + b * ST) * D + h * MHD, wv, U & 1); }
        }
        xcd_barrier(bar, wv);
        if (PH(11)) { PHASE_PTRS
            sk::SEpiRes<false, true> Es{sst_0, sst_1, false, nullptr, zf, (bf16_t*)z8, lng + (size_t)(layer * 3 + 0) * D, lnb + (size_t)(layer * 3 + 0) * D, nullptr, sred, W8_INV * O8_INV, zf};
            sk::skinny_phase<0, true>((LAS char*)lds, wv, (const bf16_t*)(ob8 + (size_t)MP * D), D / 2, (const bf16_t*)(wmo + (size_t)layer * D * D), D / 2, D / 2, D / 64, G, bx, Es);
        }
        xcd_barrier_arrive(bar, wv);
        if (PH(12)) for (int rep_ = 0; rep_ < NREP(112); ++rep_) { PHASE_PTRS
            pg8::OrdStd S{MP / 256, 2 * DFF / 256, G, bx, (const char*)z8, (const char*)(wfi + (size_t)layer * 2 * DFF * D), (size_t)256 * D, (size_t)256 * D, 0, 0};
            pg8::EpiFfnIn E{st_1, vec + V_FI_U + layer * 2 * DFF, vec + V_FI_C + layer * 2 * DFF, Hb, (LAS char*)(lds + RED_OFF), 0, 0, -1};
            sk::SEpiFfnIn Es{sst_1, vec + V_FI_U + layer * 2 * DFF, vec + V_FI_C + layer * 2 * DFF, Hb};
            if (PROBE_ID == 412) { pg8::EpiNone En; pg8::gemm_phase<true>(lds, wv, D / 2, D / 2, D / 2, S, En); }
            if (PROBE_ID == 421) { sk::SEpiNone Esn; sk::skinny_phase<1, true>((LAS char*)lds, wv, (const bf16_t*)(z8 + (size_t)MP * D), D / 2, (const bf16_t*)(wfi + (size_t)layer * 2 * DFF * D), D / 2, D / 2, DFF / 32, G, bx, Esn); __syncthreads(); }
            if (PROBE_ID == 422) { sk::skinny_phase<1, true>((LAS char*)lds, wv, (const bf16_t*)(z8 + (size_t)MP * D), D / 2, (const bf16_t*)(wfi + (size_t)layer * 2 * DFF * D), D / 2, D / 2, DFF / 32, G, bx, Es); __syncthreads(); }
            if (PROBE_ID == 413) { pg8::EpiFfnIn En{st_1, vec + V_FI_U + layer * 2 * DFF, vec + V_FI_C + layer * 2 * DFF, nullptr, (LAS char*)(lds + RED_OFF), 0, 0, -1}; pg8::gemm_phase<true>(lds, wv, D / 2, D / 2, D / 2, S, En); }
            pg8::gemm_phase<true>(lds, wv, D / 2, D / 2, D / 2, S, E);
            if (rep_ == 0) xcd_barrier_wait(bar, wv);
            {
                { for (int srep_ = 0; srep_ < ((PROBE_ID == 300) ? 2 : 1); ++srep_) sk::skinny_phase<1, true>((LAS char*)lds, wv, (const bf16_t*)(z8 + (size_t)MP * D), D / 2, (const bf16_t*)(wfi + (size_t)layer * 2 * DFF * D), D / 2, D / 2, DFF / 32, G, bx, Es); __syncthreads(); }
            }
        }
        xcd_barrier(bar, wv);
        if (PH(13)) for (int rep_ = 0; rep_ < NREP(213); ++rep_) { PHASE_PTRS const bool nxa = (layer == 1); const bool dry_ = (NREP(213) == 2 && rep_ == 0); half_t* const zfo_ = dry_ ? (half_t*)(ws + WS_DUMMY) : zf; bf16_t* const zlo_ = dry_ ? (bf16_t*)(ws + WS_DUMMY + (size_t)M * D * 4) : zb; float* const stn_ = dry_ ? (float*)(ws + WS_DUMMY + (size_t)M * D * 4 + (size_t)MPAD * D * 2) : st_2; float* const sstn_ = dry_ ? (float*)(ws + WS_DUMMY + (size_t)M * D * 4 + (size_t)MPAD * D * 2 + ST_BYTES) : sst_2;
            pg8::OrdStd S{MP / 256, D / 256, G, bx, (const char*)Hb, (const char*)(wfo + (size_t)layer * D * DFF), (size_t)256 * DFF, (size_t)256 * DFF, 0, 0};
            pg8::EpiRes<false> E{st_1, stn_, false, nullptr, nullptr, zf, nxa ? zlo_ : nullptr, lng + (size_t)(layer * 3 + 1) * D, lnb + (size_t)(layer * 3 + 1) * D, nullptr, red, W8_INV * H8_INV, zfo_, (nxa && !dry_) ? z8 : nullptr};
            sk::SEpiRes<false> Es{sst_1, sstn_, false, nullptr, zf, zlo_, lng + (size_t)(layer * 3 + 1) * D, lnb + (size_t)(layer * 3 + 1) * D, nullptr, sred, W8_INV * H8_INV, zfo_};
            _Pragma("unroll 1") for (int pass_ = 0; pass_ < 2; ++pass_) {
                if ((pass_ == 0) != skf) { pg8::gemm_phase<true>(lds, wv, DFF / 2, DFF / 2, DFF / 2, S, E); }
                else { sk::skinny_phase<0, true>((LAS char*)lds, wv, (const bf16_t*)(Hb + (size_t)MP * DFF), DFF / 2, (const bf16_t*)(wfo + (size_t)layer * D * DFF), DFF / 2, DFF / 2, D / 64, G, bx, Es); __syncthreads(); }
            }
        }
        xcd_barrier(bar, wv);
    }

    if (PH(14)) for (int rep_ = 0; rep_ < NREP(114); ++rep_) { PHASE_PTRS
        PHASE_IDS
        const float* gl = lng + (size_t)(3 * 3 + 2) * D; const float* bl = lnb + (size_t)(3 * 3 + 2) * D;
        f32x4 G0[4], G1[4], B0[4], B1[4];
#pragma unroll
        for (int j = 0; j < 4; ++j) { G0[j] = ((const f32x4*)gl)[2 * lane + 128 * j]; G1[j] = ((const f32x4*)gl)[2 * lane + 128 * j + 1]; B0[j] = ((const f32x4*)bl)[2 * lane + 128 * j]; B1[j] = ((const f32x4*)bl)[2 * lane + 128 * j + 1]; }
        u32x4 zc[4];
        { const int r0_ = bx * NWAVES + wave; if (r0_ < M) { const u32x4* zr = (const u32x4*)(zf + (size_t)r0_ * D) + lane;
#pragma unroll
            for (int j = 0; j < 4; ++j) zc[j] = zr[64 * j]; } }
        for (int r = bx * NWAVES + wave; r < M; r += G * NWAVES) {
            f32x4* yo = (f32x4*)(out + (size_t)r * D) + 2 * lane;
            u32x4 zn[4]; const int rn_ = r + G * NWAVES;
            if (rn_ < M) { const u32x4* zr = (const u32x4*)(zf + (size_t)rn_ * D) + lane;
#pragma unroll
                for (int j = 0; j < 4; ++j) zn[j] = zr[64 * j]; }
            float v[4][8]; float s = 0.f;
#pragma unroll
            for (int j = 0; j < 4; ++j) { unpack8h(zc[j], v[j]);
#pragma unroll
                for (int e = 0; e < 8; ++e) s += v[j][e]; }
            const float mean = wave_sum(s) * (1.f / D); float s2 = 0.f;
#pragma unroll
            for (int j = 0; j < 4; ++j)
#pragma unroll
                for (int e = 0; e < 8; ++e) { v[j][e] -= mean; s2 += v[j][e] * v[j][e]; }
            const float rstd = 1.0f / sqrtf(wave_sum(s2) * (1.f / D) + LN_EPS);
#pragma unroll
            for (int j = 0; j < 4; ++j) { yo[128 * j] = (f32x4){v[j][0], v[j][1], v[j][2], v[j][3]} * rstd * G0[j] + B0[j]; yo[128 * j + 1] = (f32x4){v[j][4], v[j][5], v[j][6], v[j][7]} * rstd * G1[j] + B1[j]; }
            if (rn_ < M) {
#pragma unroll
                for (int j = 0; j < 4; ++j) zc[j] = zn[j]; }
        }
    }
}

extern "C" void kernel_launch(void* const* d_in, const int* in_sizes, int n_in, void* d_out, int out_size, void* d_ws, size_t ws_size, hipStream_t stream) {
    static int grid = 0;
    if (grid == 0) {
        if (n_in != 20 || (size_t)out_size != O_END || ws_size < (PROBE_ID ? WS_END_PROBE : WS_END)) { fprintf(stderr, "kernel_launch: unexpected shapes (n_in %d, out %d vs %zu, ws %zu vs %zu)\n", n_in, out_size, (size_t)O_END, ws_size, (size_t)WS_END); grid = -1; return; }
        int dev = 0, cus = 0, per_cu = 0;
        if (hipGetDevice(&dev) != hipSuccess || hipDeviceGetAttribute(&cus, hipDeviceAttributeMultiprocessorCount, dev) != hipSuccess) { grid = -1; return; }
        if (hipFuncSetAttribute((const void*)mk_fwd, hipFuncAttributeMaxDynamicSharedMemorySize, LDS_BYTES) != hipSuccess) { fprintf(stderr, "kernel_launch: hipFuncSetAttribute failed\n"); grid = -1; return; }
        if (hipOccupancyMaxActiveBlocksPerMultiprocessor(&per_cu, (const void*)mk_fwd, NTHR, LDS_BYTES) != hipSuccess || per_cu < 1) { fprintf(stderr, "kernel_launch: occupancy query says %d\n", per_cu); }
        (void)hipGetLastError();
        grid = cus;
    }
    if (grid < 0) return;
    if (hipMemsetAsync((char*)d_ws + WS_CTL, 0, (((size_t)V_END * 4 + 4095) / 4096) * 4096, stream) != hipSuccess) return;
    Args a{};
    for (int i = 0; i < 20; ++i) a.in[i] = (const float*)d_in[i];
    a.out = (float*)d_out; a.ws = (unsigned char*)d_ws;
    hipLaunchKernelGGL(mk_fwd, dim3(grid), dim3(NTHR), LDS_BYTES, stream, a);
}
```
